# Optimizing an MI355X kernel written in HIP

```python
import math
import jax, jax.numpy as jnp
from jax import lax
import numpy as np

D_MODEL = 1024
BATCH = 1
SEQ = 16384
DEPTH = 1
DEC_BATCH = 8
DEC_SEQ = 32
PAST_LEN = 2048

CHUNK = 64
N_MEM = 256
MLA_HEADS = 8
Q_LORA = 384
KV_LORA = 256
QK_NOPE = 64
QK_ROPE = 32
V_HEAD = 64
MLA_WIDTH = MLA_HEADS * V_HEAD
MLA_SCALE = (QK_NOPE + QK_ROPE) ** -0.5
ROPE_THETA = 10000.0
Q_BLOCK = 128
LRU_WIDTH = 512
LRU_BLOCKS = 8
LRU_BLOCK = LRU_WIDTH // LRU_BLOCKS
CONV_W = 4
LRU_C = 8.0
MIX_WIDTH = MLA_WIDTH + LRU_WIDTH
IN_COLS = Q_LORA + KV_LORA + QK_ROPE + 2 * LRU_WIDTH
MEM_HEADS = 4
MEM_HEAD_DIM = D_MODEL // MEM_HEADS
D_FF = 2816
EPS = 1e-6

kernel_name = 'hybrid_mla_rglru_streaming_step'


def rmsnorm(x, g):
    xf = x.astype(jnp.float32)
    y = xf * lax.rsqrt(jnp.mean(xf * xf, axis=-1, keepdims=True) + EPS)
    return (y * g.astype(jnp.float32)).astype(x.dtype)


def swiglu(h, w1, w3, w2):
    return (jax.nn.silu(h @ w1) * (h @ w3)) @ w2


def rope_tables(pos):
    inv_freq = ROPE_THETA ** (-jnp.arange(0, QK_ROPE, 2, dtype=jnp.float32) / QK_ROPE)
    ang = pos.astype(jnp.float32)[:, None] * inv_freq[None, :]
    return jnp.cos(ang), jnp.sin(ang)


def apply_rope(x, cos, sin):
    x1, x2 = jnp.split(x, 2, axis=-1)
    shape = (cos.shape[0],) + (1,) * (x.ndim - 3) + (cos.shape[1],)
    c = cos.reshape(shape).astype(x.dtype)
    s = sin.reshape(shape).astype(x.dtype)
    return jnp.concatenate([x1 * c - x2 * s, x2 * c + x1 * s], axis=-1)


def mla_attend(q_nope, q_pe, k_nope, k_pe, v, mask):
    s = (jnp.einsum('bqhd,bkhd->bhqk', q_nope, k_nope)
         + jnp.einsum('bqhr,bkr->bhqk', q_pe, k_pe)).astype(jnp.float32) * MLA_SCALE
    if mask is not None:
        s = jnp.where(mask, s, -jnp.inf)
    p = jax.nn.softmax(s, axis=-1).astype(v.dtype)
    return jnp.einsum('bhqk,bkhd->bqhd', p, v)


def mla_prompt_attn(q_nope, q_pe, k_nope, k_pe, v):
    B, S = q_nope.shape[:2]
    nb = S // Q_BLOCK
    qn = q_nope.reshape(B, nb, Q_BLOCK, MLA_HEADS, QK_NOPE).transpose(1, 0, 2, 3, 4)
    qp = q_pe.reshape(B, nb, Q_BLOCK, MLA_HEADS, QK_ROPE).transpose(1, 0, 2, 3, 4)
    kchunk = jnp.arange(S) // CHUNK

    def block(args):
        qn_b, qp_b, bi = args
        qchunk = (bi * Q_BLOCK + jnp.arange(Q_BLOCK)) // CHUNK
        mask = kchunk[None, :] <= qchunk[:, None]
        return mla_attend(qn_b, qp_b, k_nope, k_pe, v, mask)

    out = lax.map(block, (qn, qp, jnp.arange(nb)))
    return out.transpose(1, 0, 2, 3, 4).reshape(B, S, MLA_WIDTH)


def causal_conv(xb, prev, w, b):
    T = xb.shape[1]
    xp = jnp.concatenate([prev, xb], axis=1)
    y = b + xp[:, 0:T] * w[0]
    for k in range(1, CONV_W):
        y = y + xp[:, k:k + T] * w[k]
    return y, xp[:, -(CONV_W - 1):]


def block_diag(x, w, b):
    B, T, _ = x.shape
    xh = x.reshape(B, T, LRU_BLOCKS, LRU_BLOCK)
    return (jnp.einsum('btgi,gij->btgj', xh, w) + b).reshape(B, T, LRU_WIDTH)


def rg_lru(xc, h0, w_a, b_a, w_x, b_x, lam):
    r = jax.nn.sigmoid(block_diag(xc, w_a, b_a).astype(jnp.float32))
    i = jax.nn.sigmoid(block_diag(xc, w_x, b_x).astype(jnp.float32))
    log_a = -LRU_C * r * jax.nn.softplus(-lam.astype(jnp.float32))
    a = jnp.exp(log_a)
    bterm = jnp.sqrt(-jnp.expm1(2.0 * log_a)) * i * xc.astype(jnp.float32)

    def comb(l, rr):
        a1, b1 = l
        a2, b2 = rr
        return a1 * a2, a2 * b1 + b2

    a_cum, b_cum = lax.associative_scan(comb, (a, bterm), axis=1)
    h = b_cum + a_cum * h0.astype(jnp.float32)[:, None, :]
    return h.astype(xc.dtype), h[:, -1].astype(h0.dtype)


def token_mix(h, pos, past_ckv, past_kpe, conv_prev, lru_h0, lw):
    B, T, _ = h.shape
    z = h @ lw['w_in']
    c_q, c_kv, k_pe, x_br, g_br = jnp.split(
        z, [Q_LORA, Q_LORA + KV_LORA, Q_LORA + KV_LORA + QK_ROPE,
            Q_LORA + KV_LORA + QK_ROPE + LRU_WIDTH], axis=-1)
    cos, sin = rope_tables(pos)
    c_kv = rmsnorm(c_kv, lw['kv_norm'])
    k_pe = apply_rope(k_pe, cos, sin)
    q = (rmsnorm(c_q, lw['q_norm']) @ lw['w_uq']).reshape(B, T, MLA_HEADS, QK_NOPE + QK_ROPE)
    q_nope = q[..., :QK_NOPE]
    q_pe = apply_rope(q[..., QK_NOPE:], cos, sin)
    if past_ckv is None:
        ckv_all, kpe_all = c_kv, k_pe
    else:
        ckv_all = jnp.concatenate([past_ckv, c_kv], axis=1)
        kpe_all = jnp.concatenate([past_kpe, k_pe], axis=1)
    S = ckv_all.shape[1]
    kv = (ckv_all @ lw['w_ukv']).reshape(B, S, MLA_HEADS, QK_NOPE + V_HEAD)
    k_nope, v = kv[..., :QK_NOPE], kv[..., QK_NOPE:]
    if past_ckv is None:
        attn = mla_prompt_attn(q_nope, q_pe, k_nope, kpe_all, v)
    else:
        attn = mla_attend(q_nope, q_pe, k_nope, kpe_all, v, None).reshape(B, T, MLA_WIDTH)
    xc, conv_state = causal_conv(x_br, conv_prev, lw['conv_w'], lw['conv_b'])
    h_lru, lru_state = rg_lru(xc, lru_h0, lw['lru_wa'], lw['lru_ba'], lw['lru_wx'],
                              lw['lru_bx'], lw['lru_lambda'])
    lru_out = jax.nn.gelu(g_br) * h_lru
    merged = jnp.concatenate([rmsnorm(attn, lw['attn_out_norm']),
                              rmsnorm(lru_out, lw['lru_out_norm'])], axis=-1)
    return merged @ lw['w_out'], (c_kv, k_pe, conv_state, lru_state)


def mem_kv(mem, g, w_mk, w_mv):
    m = rmsnorm(mem, g)
    B = m.shape[0]
    k = (m @ w_mk).reshape(B, N_MEM, MEM_HEADS, MEM_HEAD_DIM)
    v = (m @ w_mv).reshape(B, N_MEM, MEM_HEADS, MEM_HEAD_DIM)
    return k, v


def cross_attn(h, k, v, w_mq, w_mo):
    B, T, _ = h.shape
    q = (h @ w_mq).reshape(B, T, MEM_HEADS, MEM_HEAD_DIM)
    s = jnp.einsum('bqhd,bkhd->bhqk', q, k).astype(jnp.float32) * (MEM_HEAD_DIM ** -0.5)
    p = jax.nn.softmax(s, axis=-1).astype(v.dtype)
    o = jnp.einsum('bhqk,bkhd->bqhd', p, v).reshape(B, T, D_MODEL)
    return o @ w_mo


def layer(x, pos, mem_k, mem_v, past_ckv, past_kpe, conv_prev, lru_h0, lw):
    x = x + 0.5 * swiglu(rmsnorm(x, lw['ffn1_norm']), lw['ffn1_w1'], lw['ffn1_w3'], lw['ffn1_w2'])
    mix, st = token_mix(rmsnorm(x, lw['mix_norm']), pos, past_ckv, past_kpe, conv_prev, lru_h0, lw)
    x = x + mix
    x = x + cross_attn(rmsnorm(x, lw['xattn_norm']), mem_k, mem_v, lw['w_mq'], lw['w_mo'])
    x = x + 0.5 * swiglu(rmsnorm(x, lw['ffn2_norm']), lw['ffn2_w1'], lw['ffn2_w3'], lw['ffn2_w2'])
    return x, st


def setup_inputs(seed: int = 0) -> dict:
    key = jax.random.key(seed)
    ks = iter(jax.random.split(key, 64))
    L = DEPTH

    def nrm(shape, scale=1.0):
        return jax.random.normal(next(ks), shape, jnp.float32) * scale

    def gain(n):
        return 1.0 + nrm((L, n), 0.01)

    a0 = jax.random.uniform(next(ks), (L, LRU_WIDTH), jnp.float32, minval=0.9, maxval=0.999)
    return {
        'x_prompt': nrm((BATCH, SEQ, D_MODEL)),
        'x_sample': nrm((DEC_BATCH, DEC_SEQ, D_MODEL)),
        'mem_prompt': nrm((BATCH, N_MEM, D_MODEL)),
        'cache_mla_ckv': nrm((L, DEC_BATCH, PAST_LEN, KV_LORA)),
        'cache_mla_kpe': nrm((L, DEC_BATCH, PAST_LEN, QK_ROPE)),
        'state_conv': nrm((L, DEC_BATCH, CONV_W - 1, LRU_WIDTH)),
        'state_lru': nrm((L, DEC_BATCH, LRU_WIDTH), 0.5),
        'cache_mem_k': nrm((L, DEC_BATCH, N_MEM, MEM_HEADS, MEM_HEAD_DIM)),
        'cache_mem_v': nrm((L, DEC_BATCH, N_MEM, MEM_HEADS, MEM_HEAD_DIM)),
        'ffn1_norm': gain(D_MODEL),
        'ffn1_w1': nrm((L, D_MODEL, D_FF), D_MODEL ** -0.5),
        'ffn1_w3': nrm((L, D_MODEL, D_FF), D_MODEL ** -0.5),
        'ffn1_w2': nrm((L, D_FF, D_MODEL), D_FF ** -0.5),
        'mix_norm': gain(D_MODEL),
        'w_in': nrm((L, D_MODEL, IN_COLS), D_MODEL ** -0.5),
        'q_norm': gain(Q_LORA),
        'w_uq': nrm((L, Q_LORA, MLA_HEADS * (QK_NOPE + QK_ROPE)), Q_LORA ** -0.5),
        'kv_norm': gain(KV_LORA),
        'w_ukv': nrm((L, KV_LORA, MLA_HEADS * (QK_NOPE + V_HEAD)), KV_LORA ** -0.5),
        'conv_w': nrm((L, CONV_W, LRU_WIDTH), CONV_W ** -0.5),
        'conv_b': nrm((L, LRU_WIDTH), 0.01),
        'lru_wa': nrm((L, LRU_BLOCKS, LRU_BLOCK, LRU_BLOCK), LRU_BLOCK ** -0.5),
        'lru_ba': nrm((L, LRU_BLOCKS, LRU_BLOCK), 0.01),
        'lru_wx': nrm((L, LRU_BLOCKS, LRU_BLOCK, LRU_BLOCK), LRU_BLOCK ** -0.5),
        'lru_bx': nrm((L, LRU_BLOCKS, LRU_BLOCK), 0.01),
        'lru_lambda': jnp.log(a0) - jnp.log1p(-a0),
        'attn_out_norm': gain(MLA_WIDTH),
        'lru_out_norm': gain(LRU_WIDTH),
        'w_out': nrm((L, MIX_WIDTH, D_MODEL), MIX_WIDTH ** -0.5),
        'mem_norm': gain(D_MODEL),
        'xattn_norm': gain(D_MODEL),
        'w_mq': nrm((L, D_MODEL, D_MODEL), D_MODEL ** -0.5),
        'w_mk': nrm((L, D_MODEL, D_MODEL), D_MODEL ** -0.5),
        'w_mv': nrm((L, D_MODEL, D_MODEL), D_MODEL ** -0.5),
        'w_mo': nrm((L, D_MODEL, D_MODEL), D_MODEL ** -0.5),
        'ffn2_norm': gain(D_MODEL),
        'ffn2_w1': nrm((L, D_MODEL, D_FF), D_MODEL ** -0.5),
        'ffn2_w3': nrm((L, D_MODEL, D_FF), D_MODEL ** -0.5),
        'ffn2_w2': nrm((L, D_FF, D_MODEL), D_FF ** -0.5),
        'final_norm': 1.0 + nrm((D_MODEL,), 0.01),
    }


def reference(x_prompt, x_sample, mem_prompt, cache_mla_ckv, cache_mla_kpe, state_conv,
              state_lru, cache_mem_k, cache_mem_v, ffn1_norm, ffn1_w1, ffn1_w3, ffn1_w2,
              mix_norm, w_in, q_norm, w_uq, kv_norm, w_ukv, conv_w, conv_b, lru_wa, lru_ba,
              lru_wx, lru_bx, lru_lambda, attn_out_norm, lru_out_norm, w_out, mem_norm,
              xattn_norm, w_mq, w_mk, w_mv, w_mo, ffn2_norm, ffn2_w1, ffn2_w3, ffn2_w2,
              final_norm):
    B, S = x_prompt.shape[:2]
    past_len = cache_mla_ckv.shape[2]
    pos_p = jnp.arange(S)
    pos_s = past_len + jnp.arange(x_sample.shape[1])
    xp, xs = x_prompt, x_sample
    ckv_p, kpe_p, conv_p, lru_p, mk_p_l, mv_p_l = [], [], [], [], [], []
    ckv_s, kpe_s, conv_s, lru_s = [], [], [], []
    for l in range(DEPTH):
        lw = {
            'ffn1_norm': ffn1_norm[l], 'ffn1_w1': ffn1_w1[l], 'ffn1_w3': ffn1_w3[l],
            'ffn1_w2': ffn1_w2[l], 'mix_norm': mix_norm[l], 'w_in': w_in[l],
            'q_norm': q_norm[l], 'w_uq': w_uq[l], 'kv_norm': kv_norm[l], 'w_ukv': w_ukv[l],
            'conv_w': conv_w[l], 'conv_b': conv_b[l], 'lru_wa': lru_wa[l], 'lru_ba': lru_ba[l],
            'lru_wx': lru_wx[l], 'lru_bx': lru_bx[l], 'lru_lambda': lru_lambda[l],
            'attn_out_norm': attn_out_norm[l], 'lru_out_norm': lru_out_norm[l],
            'w_out': w_out[l], 'xattn_norm': xattn_norm[l], 'w_mq': w_mq[l], 'w_mo': w_mo[l],
            'ffn2_norm': ffn2_norm[l], 'ffn2_w1': ffn2_w1[l], 'ffn2_w3': ffn2_w3[l],
            'ffn2_w2': ffn2_w2[l],
        }
        mk_p, mv_p = mem_kv(mem_prompt, mem_norm[l], w_mk[l], w_mv[l])
        zero_conv = jnp.zeros((B, CONV_W - 1, LRU_WIDTH), xp.dtype)
        zero_lru = jnp.zeros((B, LRU_WIDTH), xp.dtype)
        xp, st_p = layer(xp, pos_p, mk_p, mv_p, None, None, zero_conv, zero_lru, lw)
        xs, st_s = layer(xs, pos_s, cache_mem_k[l], cache_mem_v[l], cache_mla_ckv[l],
                         cache_mla_kpe[l], state_conv[l], state_lru[l], lw)
        ckv_p.append(st_p[0]); kpe_p.append(st_p[1]); conv_p.append(st_p[2]); lru_p.append(st_p[3])
        mk_p_l.append(mk_p); mv_p_l.append(mv_p)
        ckv_s.append(st_s[0]); kpe_s.append(st_s[1]); conv_s.append(st_s[2]); lru_s.append(st_s[3])
    y_prompt = rmsnorm(xp, final_norm)
    y_sample = rmsnorm(xs, final_norm)
    return (y_prompt, y_sample,
            jnp.stack(ckv_p), jnp.stack(kpe_p), jnp.stack(conv_p), jnp.stack(lru_p),
            jnp.stack(mk_p_l), jnp.stack(mv_p_l),
            jnp.stack(ckv_s), jnp.stack(kpe_s), jnp.stack(conv_s), jnp.stack(lru_s))
```

```cpp
#include <hip/hip_runtime.h>
#include <hip/hip_cooperative_groups.h>
#include <cstdio>
#include <cstdint>
namespace cg = cooperative_groups;

#define LAS __attribute__((address_space(3)))
typedef unsigned short bf16_t;
typedef short bf16x8 __attribute__((ext_vector_type(8)));
typedef short s16x4 __attribute__((ext_vector_type(4)));
typedef float f32x4 __attribute__((ext_vector_type(4)));
typedef float f32x16 __attribute__((ext_vector_type(16)));
typedef unsigned u32x4 __attribute__((ext_vector_type(4)));
typedef unsigned u32x2 __attribute__((ext_vector_type(2)));

constexpr int TP = 16384, TS = 256, MT = TP + TS, DM = 1024, FF = 2816, QL = 384, KVL = 256, NBAT = 8, DSEQ = 32, PAST = 2048, SKV = PAST + DSEQ  ;
constexpr int VT_LD = 33152;
constexpr int VTS_LD = VT_LD;
constexpr float EPS = 1e-6f;
constexpr float LOG2E = 1.4426950408889634f;
constexpr float QSCALE = 0.10206207261596575f * LOG2E;
constexpr float XSCALE = 0.0625f * LOG2E;
constexpr int NTHR = 512, NWAVE = 8;
constexpr int LDS_BYTES = 147456;
constexpr int LDS_EPI = 131072;

constexpr size_t O_Y = 0, O_YS = 16777216, O_CKVP = 17039360, O_KPEP = 21233664, O_CONVP = 21757952, O_LRUP = 21759488,
                 O_MKP = 21760000, O_MVP = 22022144, O_CKVS = 22284288, O_KPES = 22349824, O_CONVS = 22358016, O_LRUS = 22370304;

constexpr size_t U64K = 65536;
constexpr size_t WS_SSQ = 0;
constexpr size_t WS_BAR = 466944;
constexpr size_t WS_ATOT = 16 * U64K, WS_BTOT = 32 * U64K;
constexpr size_t WS_W13_1 = 64 * U64K;
constexpr size_t WS_W2_1 = WS_W13_1 + 176 * U64K;
constexpr size_t WS_W13_2 = WS_W2_1 + 88 * U64K;
constexpr size_t WS_W2_2 = WS_W13_2 + 176 * U64K;
constexpr size_t WS_WIN = WS_W2_2 + 88 * U64K;
constexpr size_t WS_WUQ = WS_WIN + 56 * U64K;
constexpr size_t WS_WK = WS_WUQ + 9 * U64K;
constexpr size_t WS_WV = WS_WK + 4 * U64K;
constexpr size_t WS_WOUT = WS_WV + 4 * U64K;
constexpr size_t WS_WMQ = WS_WOUT + 32 * U64K;
constexpr size_t WS_WMKV = WS_WMQ + 32 * U64K;
constexpr size_t WS_WMO = WS_WMKV + 64 * U64K;
constexpr size_t WS_MEMB = 52 * 16 * U64K;
constexpr size_t WS_MKB = WS_MEMB + 8 * U64K, WS_MVTB = WS_MKB + 8 * U64K, WS_MVB = WS_MVTB + 8 * U64K, WS_CMKB = WS_MVB + 8 * U64K, WS_CMVTB = WS_CMKB + 64 * U64K;
constexpr size_t WS_XB = 62 * 16 * U64K;
constexpr size_t WS_HLOC = WS_XB, WS_ACUM = WS_XB + 260 * U64K;
constexpr size_t WS_R = 95 * 16 * U64K;
constexpr size_t WS_HID = WS_R;
constexpr size_t WS_CQ = WS_R;
constexpr size_t WS_CKVP = WS_CQ + 195 * U64K;
constexpr size_t WS_CKVS = WS_CKVP + 128 * U64K;
constexpr size_t WS_XBR = WS_CKVS + 130 * U64K;
constexpr size_t WS_MERGED = WS_R;
constexpr size_t WS_GG = WS_R + 720 * U64K;
constexpr size_t WS_Q = WS_GG + 260 * U64K;
constexpr size_t WS_KNP = WS_Q + 390 * U64K;
constexpr size_t WS_KNS = WS_KNP + 256 * U64K;
constexpr size_t WS_VTP = WS_KNS + 261 * U64K;
constexpr size_t WS_VTS = WS_VTP + 256 * U64K;
constexpr size_t WS_KPEP = WS_VTS + 262 * U64K;
constexpr size_t WS_KPES = WS_KPEP + 16 * U64K;
constexpr size_t WS_QM = WS_R + 768 * U64K;
constexpr size_t WS_END = WS_KPES + 17 * U64K;
constexpr size_t WS_ACC = 248 * 16 * U64K;
constexpr size_t WS_XSA = 253 * 16 * U64K, WS_XSB = 254 * 16 * U64K;
static_assert(WS_WMO + 32 * U64K <= WS_MEMB && WS_CMVTB + 64 * U64K <= WS_XB && WS_XB + 520 * U64K <= WS_R, "ws map 1");
static_assert(WS_XBR + 260 * U64K <= WS_GG && WS_END <= WS_ACC && WS_HID + (size_t)MT * FF * 2 <= 256u * 16 * U64K, "ws map 2");

__device__ __forceinline__ unsigned f2bf(float f) { unsigned u = __builtin_bit_cast(unsigned, f); return (u + 0x7fffu + ((u >> 16) & 1u)) >> 16; }
__device__ __forceinline__ unsigned pk2(float lo, float hi) { unsigned r; asm volatile("v_cvt_pk_bf16_f32 %0, %1, %2" : "=v"(r) : "v"(lo), "v"(hi)); return r; }
__device__ __forceinline__ float bf2f(unsigned short b) { return __builtin_bit_cast(float, (unsigned)b << 16); }
__device__ __forceinline__ float wave_sum(float v) {
#pragma unroll
    for (int o = 1; o < 64; o <<= 1) v += __shfl_xor(v, o);
    return v;
}
__device__ __forceinline__ void atomic_addf(float* p, float v) { __hip_atomic_fetch_add(p, v, __ATOMIC_RELAXED, __HIP_MEMORY_SCOPE_AGENT); }
__device__ __forceinline__ float sigmoidf_(float x) { return 1.f / (1.f + __expf(-x)); }
__device__ __forceinline__ float gelu_tanh(float v) { const float u = 1.5957691216057308f * (v + 0.044715f * v * v * v); return v / (1.f + __expf(-u)); }
__device__ __forceinline__ void rope_cs(int pos, int j, float& c, float& s) {
    const float inv = __builtin_amdgcn_exp2f(-0.8304820237218406f * (float)j);
    const float ang = (float)pos * inv;
    const float k = rintf(ang * 0.15915494309189535f);
    float r = fmaf(-k, 6.28125f, ang); r = fmaf(-k, 0.0019353071795864769f, r);
    c = __cosf(r); s = __sinf(r);
}
namespace pg8 {
#define PG8_LAS __attribute__((address_space(3)))
typedef unsigned short bf16_t;
typedef short bf16x8 __attribute__((ext_vector_type(8)));
typedef float f32x4 __attribute__((ext_vector_type(4)));
typedef unsigned u32x4 __attribute__((ext_vector_type(4)));
constexpr int BM = 256, BK = 64, HALF = 128, HTB = HALF * BK * 2  , STAGE_BYTES = 8 * HTB, NXCD = 8, WGM = 8;

__host__ __device__ __forceinline__ int lds_byte(int r, int c) { const int st = (r >> 4) * 2 + (c >> 5), rr = r & 15, cc = c & 31, ob = rr * 64 + cc * 2; return st * 1024 + (ob ^ (((ob >> 9) & 1) << 5)); }
__host__ __device__ __forceinline__ void stage_rc(int b, int& R, int& C) { const int st = b / 1024, sb = b % 1024, swz = sb ^ (((sb >> 9) & 1) << 5); R = (st >> 1) * 16 + swz / 64; C = (st & 1) * 32 + (swz % 64) / 2; }
__host__ __device__ __forceinline__ int perm32(int rho) { const int n = rho >> 4, i = rho & 15; return 8 * (i >> 2) + 4 * n + (i & 3); }

struct Unit { int pm, pn, kc; };
struct Gemm { const bf16_t* A; const bf16_t* Bt; int M, N, K, lda, ldb, kcb; };

struct StaticOrder {
    int nM, nN, nwg, G, c;
    __host__ __device__ void init(int M, int N, int G_, int c_) { nM = M / BM; nN = N / BM; nwg = nM * nN; G = G_; c = c_; }
    __host__ __device__ bool next(int i, Unit& u) const {
        const long L = (long)i * G + c; if (L >= nwg) return false;
        int wgid = (int)L; { const int q = nwg / NXCD, r = nwg % NXCD, xcd = wgid % NXCD, off = wgid / NXCD; wgid = (xcd < r ? xcd * (q + 1) : r * (q + 1) + (xcd - r) * q) + off; }
        const int nig = WGM * nN, gid = wgid / nig, fm = gid * WGM, gsz = (nM - fm) < WGM ? (nM - fm) : WGM;
        u.pm = fm + ((wgid % nig) % gsz); u.pn = (wgid % nig) / gsz; u.kc = 0; return true;
    }
    __device__ __forceinline__ void a_ready(const Unit&) const {}
    __device__ __forceinline__ void done(const Unit&) const {}
};

__device__ __forceinline__ unsigned cvt_pk_bf16(float lo, float hi) { unsigned r; asm volatile("v_cvt_pk_bf16_f32 %0, %1, %2" : "=v"(r) : "v"(lo), "v"(hi)); return r; }

struct Order {
    int nM, nN, nK, nwg, G, c, pmo;
    __device__ __forceinline__ void init(int M, int N, int G_, int blk, int rot, int pm_off = 0, int nK_ = 1) { nM = M / BM; nN = N / BM; nK = nK_; nwg = nM * nN * nK_; G = G_; c = (blk + G_ - (rot % G_)) % G_; pmo = pm_off; }
    __device__ __forceinline__ bool next(int i, Unit& u) const {
        const long L = (long)i * G + c; if (L >= nwg) return false;
        int wgid = (int)L; { const int q = nwg / NXCD, r = nwg % NXCD, xcd = wgid % NXCD, off = wgid / NXCD; wgid = (xcd < r ? xcd * (q + 1) : r * (q + 1) + (xcd - r) * q) + off; }
        u.kc = wgid % nK; wgid /= nK;
        const int nig = WGM * nN, gid = wgid / nig, fm = gid * WGM, gsz = (nM - fm) < WGM ? (nM - fm) : WGM;
        u.pm = pmo + fm + ((wgid % nig) % gsz); u.pn = (wgid % nig) / gsz; return true;
    }
    __device__ __forceinline__ void a_ready(const Unit&) const {}
    __device__ __forceinline__ void done(const Unit&) const {}
};

struct EpiAcc {
    static constexpr bool PERM = false, AFTER_DRAIN = false, MIDSCALE = false;
    float* ACC; const float* rs_in; float rs_invn; int kc_lim; float alpha;
    __device__ __forceinline__ void operator()(const f32x4 (&acc)[2][2][4][2], const Unit& u, int wr, int wc, int fr, int fq) const {
        const int col0 = u.pn * BM + wc * 32 + 4 * fq;
#pragma unroll
        for (int ai = 0; ai < 2; ++ai)
#pragma unroll
            for (int m = 0; m < 4; ++m) {
                const int rl = ai * HALF + wr * 64 + m * 16 + fr;
                float sc = alpha; if (rs_in && u.kc < kc_lim) sc *= rsqrtf(rs_in[TP + rl] * rs_invn + EPS);
#pragma unroll
                for (int bj = 0; bj < 2; ++bj)
#pragma unroll
                    for (int n = 0; n < 2; ++n) {
                        float* p = ACC + (size_t)rl * DM + col0 + bj * HALF + n * 16; const f32x4 v = acc[ai][bj][m][n] * sc;
                        atomic_addf(p, v[0]); atomic_addf(p + 1, v[1]); atomic_addf(p + 2, v[2]); atomic_addf(p + 3, v[3]);
                    }
            }
    }
};

struct EpiUp {
    static constexpr bool PERM = true, AFTER_DRAIN = false, MIDSCALE = false;
    bf16_t* H; const float* ssq;
    __device__ __forceinline__ void operator()(const f32x4 (&acc)[2][2][4][2], const Unit& u, int wr, int wc, int fr, int fq) const {
        const int col = u.pn * 128 + wc * 32 + 8 * fq;
#pragma unroll
        for (int ai = 0; ai < 2; ++ai)
#pragma unroll
            for (int m = 0; m < 4; ++m) {
                const int row = u.pm * BM + ai * HALF + wr * 64 + m * 16 + fr;
                const float r = rsqrtf(ssq[row] * (1.0f / 1024.0f) + EPS);
                unsigned w[4];
#pragma unroll
                for (int n = 0; n < 2; ++n) {
                    const f32x4 g = acc[ai][0][m][n] * r, uu = acc[ai][1][m][n] * r; float v[4];
#pragma unroll
                    for (int i = 0; i < 4; ++i) v[i] = g[i] * uu[i] / (1.f + __expf(-g[i]));
                    w[2 * n] = cvt_pk_bf16(v[0], v[1]); w[2 * n + 1] = cvt_pk_bf16(v[2], v[3]);
                }
                __builtin_nontemporal_store((u32x4){w[0], w[1], w[2], w[3]}, (u32x4*)(H + (size_t)row * FF + col));
            }
    }
};

struct EpiRes {
    static constexpr bool PERM = true, AFTER_DRAIN = false, MIDSCALE = false;
    bf16_t* XB; float* ssq_out; const float* rs_in; float rs_invn; float alpha;
    __device__ __forceinline__ void operator()(const f32x4 (&acc)[2][2][4][2], const Unit& u, int wr, int wc, int fr, int fq) const {
        const int col0 = u.pn * BM + wc * 32 + 8 * fq;
#pragma unroll
        for (int ai = 0; ai < 2; ++ai)
#pragma unroll
            for (int m = 0; m < 4; ++m) {
                const int row = u.pm * BM + ai * HALF + wr * 64 + m * 16 + fr;
                float sc = alpha; if (rs_in) sc *= rsqrtf(rs_in[row] * rs_invn + EPS);
                float sq = 0.f;
#pragma unroll
                for (int bj = 0; bj < 2; ++bj) {
                    bf16_t* p = XB + (size_t)row * DM + col0 + bj * HALF;
                    const u32x4 b = *(const u32x4*)p; float o[8];
#pragma unroll
                    for (int k = 0; k < 4; ++k) { o[2 * k] = __builtin_bit_cast(float, b[k] << 16); o[2 * k + 1] = __builtin_bit_cast(float, b[k] & 0xffff0000u); }
#pragma unroll
                    for (int k = 0; k < 4; ++k) { o[k] += acc[ai][bj][m][0][k] * sc; o[4 + k] += acc[ai][bj][m][1][k] * sc; }
#pragma unroll
                    for (int k = 0; k < 8; ++k) sq += o[k] * o[k];
                    *(u32x4*)p = (u32x4){cvt_pk_bf16(o[0], o[1]), cvt_pk_bf16(o[2], o[3]), cvt_pk_bf16(o[4], o[5]), cvt_pk_bf16(o[6], o[7])};
                }
                if (ssq_out) { sq += __shfl_xor(sq, 16); sq += __shfl_xor(sq, 32); if (fq == 0) atomic_addf(ssq_out + row, sq); }
            }
    }
};

struct EpiResMid : EpiRes {
    static constexpr bool MIDSCALE = true;
    const float* ssqa;
    __device__ __forceinline__ void midscale(f32x4 (&acc)[2][2][4][2], const Unit& u, int wr, int fr) const {
#pragma unroll
        for (int ai = 0; ai < 2; ++ai)
#pragma unroll
            for (int m = 0; m < 4; ++m) {
                const float f = rsqrtf(ssqa[u.pm * BM + ai * HALF + wr * 64 + m * 16 + fr] * (1.0f / 512.0f) + EPS);
#pragma unroll
                for (int bj = 0; bj < 2; ++bj)
#pragma unroll
                    for (int n = 0; n < 2; ++n) acc[ai][bj][m][n] *= f;
            }
    }
};

struct EpiStore {
    static constexpr bool PERM = true, AFTER_DRAIN = false, MIDSCALE = false;
    bf16_t* O; int ldc; const float* rs_in; float rs_invn; float scale;
    __device__ __forceinline__ void operator()(const f32x4 (&acc)[2][2][4][2], const Unit& u, int wr, int wc, int fr, int fq) const {
        const int col0 = u.pn * BM + wc * 32 + 8 * fq;
#pragma unroll
        for (int ai = 0; ai < 2; ++ai)
#pragma unroll
            for (int m = 0; m < 4; ++m) {
                const int row = u.pm * BM + ai * HALF + wr * 64 + m * 16 + fr;
                float sc = scale; if (rs_in) sc *= rsqrtf(rs_in[row] * rs_invn + EPS);
#pragma unroll
                for (int bj = 0; bj < 2; ++bj) {
                    const f32x4 v0 = acc[ai][bj][m][0] * sc, v1 = acc[ai][bj][m][1] * sc;
                    *(u32x4*)(O + (size_t)row * ldc + col0 + bj * HALF) = (u32x4){cvt_pk_bf16(v0[0], v0[1]), cvt_pk_bf16(v0[2], v0[3]), cvt_pk_bf16(v1[0], v1[1]), cvt_pk_bf16(v1[2], v1[3])};
                }
            }
    }
};

struct EpiMem {
    static constexpr bool PERM = false, AFTER_DRAIN = false, MIDSCALE = false;
    float* outk; float* outv; bf16_t* KB; bf16_t* VB;
    __device__ __forceinline__ void operator()(const f32x4 (&acc)[2][2][4][2], const Unit& u, int wr, int wc, int fr, int fq) const {
        const bool isv = u.pn >= 4; const int col0 = (u.pn & 3) * BM + wc * 32 + 4 * fq;
        float* of = isv ? outv : outk; bf16_t* ob = isv ? VB : KB;
#pragma unroll
        for (int ai = 0; ai < 2; ++ai)
#pragma unroll
            for (int m = 0; m < 4; ++m) {
                const int row = ai * HALF + wr * 64 + m * 16 + fr;
#pragma unroll
                for (int bj = 0; bj < 2; ++bj)
#pragma unroll
                    for (int n = 0; n < 2; ++n) {
                        const int col = col0 + bj * HALF + n * 16; const f32x4 o = acc[ai][bj][m][n];
                        *(f32x4*)(of + (size_t)row * DM + col) = o;
                        *(u32x2*)(ob + (size_t)row * DM + col) = (u32x2){cvt_pk_bf16(o[0], o[1]), cvt_pk_bf16(o[2], o[3])};
                    }
            }
    }
};

struct EpiQ {
    static constexpr bool PERM = false, AFTER_DRAIN = false, MIDSCALE = false;
    bf16_t* Q; const float* ssqq;
    __device__ __forceinline__ void operator()(const f32x4 (&acc)[2][2][4][2], const Unit& u, int wr, int wc, int fr, int fq) const {
#pragma unroll
        for (int ai = 0; ai < 2; ++ai)
#pragma unroll
            for (int m = 0; m < 4; ++m) {
                const int row = u.pm * BM + ai * HALF + wr * 64 + m * 16 + fr;
                const float sc = QSCALE * rsqrtf(ssqq[row] * (1.0f / 384.0f) + EPS);
                const int pos = row < TP ? row : PAST + ((row - TP) & 31);
#pragma unroll
                for (int bj = 0; bj < 2; ++bj) {
                    const int gidx = u.pn * 8 + bj * 4 + wc; const int c0 = gidx * 32 + 4 * fq;
                    f32x4 v0 = acc[ai][bj][m][0] * sc, v1 = acc[ai][bj][m][1] * sc;
                    if (gidx % 3 == 2) {
#pragma unroll
                        for (int i = 0; i < 4; ++i) { float c, s; rope_cs(pos, 4 * fq + i, c, s); const float a = v0[i], b = v1[i]; v0[i] = a * c - b * s; v1[i] = b * c + a * s; }
                    }
                    *(u32x2*)(Q + (size_t)row * 768 + c0) = (u32x2){cvt_pk_bf16(v0[0], v0[1]), cvt_pk_bf16(v0[2], v0[3])};
                    *(u32x2*)(Q + (size_t)row * 768 + c0 + 16) = (u32x2){cvt_pk_bf16(v1[0], v1[1]), cvt_pk_bf16(v1[2], v1[3])};
                }
            }
    }
};

struct EpiWin {
    static constexpr bool PERM = false, AFTER_DRAIN = false, MIDSCALE = false;
    const float* ssq1; const float* kvg; float* out; bf16_t* CQ; float* ssqq; bf16_t* CKVP; bf16_t* CKVS; bf16_t* KPEP; bf16_t* KPES; bf16_t* XBR; bf16_t* GG; LAS float* P;
    __device__ __forceinline__ void operator()(const f32x4 (&acc)[2][2][4][2], const Unit& u, int wr, int wc, int fr, int fq) const {
        const int pn = u.pn;
        if (pn == 0) {
#pragma unroll
            for (int ai = 0; ai < 2; ++ai)
#pragma unroll
                for (int m = 0; m < 4; ++m) {
                    const int row = u.pm * BM + ai * HALF + wr * 64 + m * 16 + fr;
                    const float r = rsqrtf(ssq1[row] * (1.0f / 1024.0f) + EPS);
                    float sq = 0.f;
#pragma unroll
                    for (int bj = 0; bj < 2; ++bj)
#pragma unroll
                        for (int n = 0; n < 2; ++n) { const f32x4 v = acc[ai][bj][m][n] * r; sq += (v[0] * v[0] + v[1] * v[1]) + (v[2] * v[2] + v[3] * v[3]); }
                    sq += __shfl_xor(sq, 16); sq += __shfl_xor(sq, 32);
                    if (fq == 0) P[(ai * HALF + wr * 64 + m * 16 + fr) * 4 + wc] = sq;
                }
            asm volatile("s_waitcnt lgkmcnt(0)" ::: "memory"); __builtin_amdgcn_s_barrier(); asm volatile("" ::: "memory");
#pragma unroll
            for (int ai = 0; ai < 2; ++ai)
#pragma unroll
                for (int m = 0; m < 4; ++m) {
                    const int rl = ai * HALF + wr * 64 + m * 16 + fr; const int row = u.pm * BM + rl;
                    const f32x4 pp = *(const LAS f32x4*)(P + rl * 4);
                    const float rk = rsqrtf(((pp[0] + pp[1]) + (pp[2] + pp[3])) * (1.0f / 256.0f) + EPS) * rsqrtf(ssq1[row] * (1.0f / 1024.0f) + EPS);
                    float* of; bf16_t* ob;
                    if (row < TP) { of = out + O_CKVP + (size_t)row * 256; ob = CKVP + (size_t)row * 256; }
                    else { const int rs = row - TP; of = out + O_CKVS + (size_t)rs * 256; ob = CKVS + (size_t)((rs >> 5) * SKV + PAST + (rs & 31)) * 256; }
#pragma unroll
                    for (int bj = 0; bj < 2; ++bj)
#pragma unroll
                        for (int n = 0; n < 2; ++n) {
                            const int col = bj * HALF + wc * 32 + n * 16 + 4 * fq;
                            const f32x4 o = acc[ai][bj][m][n] * rk * *(const f32x4*)(kvg + col);
                            *(f32x4*)(of + col) = o; *(u32x2*)(ob + col) = (u32x2){cvt_pk_bf16(o[0], o[1]), cvt_pk_bf16(o[2], o[3])};
                        }
                }
            asm volatile("s_waitcnt lgkmcnt(0)" ::: "memory"); __builtin_amdgcn_s_barrier(); asm volatile("" ::: "memory");
            return;
        }
#pragma unroll
        for (int ai = 0; ai < 2; ++ai)
#pragma unroll
            for (int m = 0; m < 4; ++m) {
                const int row = u.pm * BM + ai * HALF + wr * 64 + m * 16 + fr;
                const float r = rsqrtf(ssq1[row] * (1.0f / 1024.0f) + EPS);
                if (pn == 1 || pn == 2) {
                    float sq = 0.f;
#pragma unroll
                    for (int bj = 0; bj < 2; ++bj) {
                        if (pn == 2 && bj == 1) {
                            if (wc == 0) {
                                const int pos = row < TP ? row : PAST + ((row - TP) & 31);
                                f32x4 v0 = acc[ai][1][m][0] * r, v1 = acc[ai][1][m][1] * r;
#pragma unroll
                                for (int i = 0; i < 4; ++i) { float c, s; rope_cs(pos, 4 * fq + i, c, s); const float a = v0[i], b = v1[i]; v0[i] = a * c - b * s; v1[i] = b * c + a * s; }
                                float* of; bf16_t* ob;
                                if (row < TP) { of = out + O_KPEP + (size_t)row * 32; ob = KPEP + (size_t)row * 32; }
                                else { const int rs = row - TP; of = out + O_KPES + (size_t)rs * 32; ob = KPES + (size_t)((rs >> 5) * SKV + PAST + (rs & 31)) * 32; }
                                *(f32x4*)(of + 4 * fq) = v0; *(f32x4*)(of + 16 + 4 * fq) = v1;
                                *(u32x2*)(ob + 4 * fq) = (u32x2){cvt_pk_bf16(v0[0], v0[1]), cvt_pk_bf16(v0[2], v0[3])};
                                *(u32x2*)(ob + 16 + 4 * fq) = (u32x2){cvt_pk_bf16(v1[0], v1[1]), cvt_pk_bf16(v1[2], v1[3])};
                            }
                        } else {
#pragma unroll
                            for (int n = 0; n < 2; ++n) {
                                const int col = (pn - 1) * 256 + bj * HALF + wc * 32 + n * 16 + 4 * fq;
                                const f32x4 v = acc[ai][bj][m][n] * r;
                                *(u32x2*)(CQ + (size_t)row * QL + col) = (u32x2){cvt_pk_bf16(v[0], v[1]), cvt_pk_bf16(v[2], v[3])};
                                sq += (v[0] * v[0] + v[1] * v[1]) + (v[2] * v[2] + v[3] * v[3]);
                            }
                        }
                    }
                    sq += __shfl_xor(sq, 16); sq += __shfl_xor(sq, 32); if (fq == 0) atomic_addf(ssqq + row, sq);
                } else if (pn <= 4) {
                    float* cs = nullptr;
                    if (row < TP) { if (row >= TP - 3) cs = out + O_CONVP + (size_t)(row - (TP - 3)) * 512; }
                    else { const int rs = row - TP, t = rs & 31; if (t >= 29) cs = out + O_CONVS + (size_t)((rs >> 5) * 3 + (t - 29)) * 512; }
#pragma unroll
                    for (int bj = 0; bj < 2; ++bj)
#pragma unroll
                        for (int n = 0; n < 2; ++n) {
                            const int col = (pn - 3) * 256 + bj * HALF + wc * 32 + n * 16 + 4 * fq;
                            const f32x4 v = acc[ai][bj][m][n] * r;
                            *(u32x2*)(XBR + (size_t)row * 512 + col) = (u32x2){cvt_pk_bf16(v[0], v[1]), cvt_pk_bf16(v[2], v[3])};
                            if (cs) *(f32x4*)(cs + col) = v;
                        }
                } else {
#pragma unroll
                    for (int bj = 0; bj < 2; ++bj)
#pragma unroll
                        for (int n = 0; n < 2; ++n) {
                            const int col = (pn - 5) * 256 + bj * HALF + wc * 32 + n * 16 + 4 * fq;
                            const f32x4 v = acc[ai][bj][m][n] * r;
                            *(u32x2*)(GG + (size_t)row * 512 + col) = (u32x2){cvt_pk_bf16(gelu_tanh(v[0]), gelu_tanh(v[1])), cvt_pk_bf16(gelu_tanh(v[2]), gelu_tanh(v[3]))};
                        }
                }
            }
    }
};

template <class Epi, class Sched, bool ALIGN_EPI = false, bool SP2 = false>
__device__ __forceinline__ void gemm_phase(PG8_LAS unsigned char* lds, const Gemm g, const Sched& S, const Epi& E) {
    const int tid = threadIdx.x, wid = __builtin_amdgcn_readfirstlane(tid >> 6), lane = tid & 63, wr = wid >> 2, wc = wid & 3, fr = lane & 15, fq = lane >> 4;
    const int K = g.K, nt = K / BK;
    unsigned voffA[2], voffB[2];
#pragma unroll
    for (int i = 0; i < 2; ++i) { int R, C; stage_rc(tid * 16 + i * 8192, R, C); const int Rb = Epi::PERM ? ((R & ~31) + perm32(R & 31)) : R;
        voffA[i] = (unsigned)(R * g.lda + C) * 2u; voffB[i] = (unsigned)(Rb * g.ldb + C) * 2u; }
    const size_t kstep = (size_t)(BK * 2);
    const size_t hstepA = (size_t)HALF * g.lda * 2, hstepB = (size_t)HALF * g.ldb * 2;
    const size_t tstepA = 2 * hstepA, tstepB = 2 * hstepB;
    const unsigned ldsw = (unsigned)wid * 1024u;
    const int aoff = lds_byte(wr * 64 + fr, fq * 8), boff = lds_byte(wc * 32 + fr, fq * 8);
#define PG8_SA(b, h) (((b) * 2 + (h)) * HTB)
#define PG8_SB(b, h) ((4 + (b) * 2 + (h)) * HTB)
#define PG8_STAGE(bufoff, gbase, voff) do { _Pragma("unroll") for (int _i = 0; _i < 2; ++_i) \
        __builtin_amdgcn_global_load_lds((const unsigned*)((const char*)(gbase) + (voff)[_i]), (PG8_LAS unsigned*)(lds + (bufoff) + ldsw + _i * 8192), 16, 0, 0); } while (0)
#define PG8_LDA(dst, b, h) do { _Pragma("unroll") for (int m = 0; m < 4; ++m) _Pragma("unroll") for (int k = 0; k < 2; ++k) dst[m][k] = *(const PG8_LAS bf16x8*)(lds + PG8_SA(b, h) + aoff + m * 2048 + k * 1024); } while (0)
#define PG8_LDB(dst, b, h) do { _Pragma("unroll") for (int n = 0; n < 2; ++n) _Pragma("unroll") for (int k = 0; k < 2; ++k) dst[n][k] = *(const PG8_LAS bf16x8*)(lds + PG8_SB(b, h) + boff + n * 2048 + k * 1024); } while (0)
#define PG8_MMA(ai, bj, At, Bt) do { __builtin_amdgcn_s_setprio(1); _Pragma("unroll") for (int m = 0; m < 4; ++m) _Pragma("unroll") for (int n = 0; n < 2; ++n) _Pragma("unroll") for (int k = 0; k < 2; ++k) \
        acc[ai][bj][m][n] = __builtin_amdgcn_mfma_f32_16x16x32_bf16(Bt[n][k], At[m][k], acc[ai][bj][m][n], 0, 0, 0); __builtin_amdgcn_s_setprio(0); } while (0)
#define PG8_WAIT_V(n) asm volatile("s_waitcnt vmcnt(" #n ")" ::: "memory")
#define PG8_WAIT_L(n) asm volatile("s_waitcnt lgkmcnt(" #n ")" ::: "memory")
#define PG8_BAR __builtin_amdgcn_s_barrier()
#define PG8_SCHED __builtin_amdgcn_sched_barrier(0)
    Unit cur, nxt; int ui = 0;
    if (!S.next(0, cur)) return;
    f32x4 acc[2][2][4][2];
#pragma unroll
    for (int a = 0; a < 2; ++a)
#pragma unroll
        for (int b = 0; b < 2; ++b)
#pragma unroll
            for (int m = 0; m < 4; ++m)
#pragma unroll
                for (int n = 0; n < 2; ++n) acc[a][b][m][n] = (f32x4){0.f, 0.f, 0.f, 0.f};
    bf16x8 At[4][2], B0[2][2], B1[2][2];
    const char* cA = (const char*)g.A + (size_t)cur.pm * tstepA + (size_t)cur.kc * g.kcb; const char* cB = (const char*)g.Bt + (size_t)cur.pn * tstepB + (size_t)cur.kc * g.kcb;
    S.a_ready(cur);
    if constexpr (SP2) {
        PG8_STAGE(PG8_SB(0, 0), cB, voffB); PG8_STAGE(PG8_SB(0, 1), cB + hstepB, voffB); PG8_STAGE(PG8_SA(0, 0), cA, voffA); PG8_STAGE(PG8_SA(0, 1), cA + hstepA, voffA);
        if (wr == 1) PG8_BAR;
        PG8_WAIT_V(2); PG8_BAR;
        PG8_STAGE(PG8_SB(1, 0), cB + kstep, voffB); PG8_STAGE(PG8_SA(1, 0), cA + kstep, voffA); PG8_STAGE(PG8_SB(1, 1), cB + hstepB + kstep, voffB);
        PG8_WAIT_V(6); PG8_BAR;
    } else {
        PG8_STAGE(PG8_SB(0, 0), cB, voffB); PG8_STAGE(PG8_SA(0, 0), cA, voffA); PG8_STAGE(PG8_SB(0, 1), cB + hstepB, voffB); PG8_STAGE(PG8_SA(0, 1), cA + hstepA, voffA);
        if (wr == 1) PG8_BAR;
        PG8_WAIT_V(4); PG8_BAR;
        PG8_STAGE(PG8_SB(1, 0), cB + kstep, voffB); PG8_STAGE(PG8_SA(1, 0), cA + kstep, voffA); PG8_STAGE(PG8_SB(1, 1), cB + hstepB + kstep, voffB);
        PG8_WAIT_V(6); PG8_BAR;
    }
    for (;;) {
        const bool has_next = S.next(ui + 1, nxt);
        const char* nA = has_next ? (const char*)g.A + (size_t)nxt.pm * tstepA + (size_t)nxt.kc * g.kcb : cA; const char* nB = has_next ? (const char*)g.Bt + (size_t)nxt.pn * tstepB + (size_t)nxt.kc * g.kcb : cB;
_Pragma("unroll 1")
        for (int t = 0; t < nt; t += 2) {
            if constexpr (Epi::MIDSCALE) { if (t == nt / 2) E.midscale(acc, cur, wr, fr); }
            const bool last = (t == nt - 2);
            const char* a1 = cA + (size_t)(t + 1) * kstep;
            const char* a2 = last ? nA : cA + (size_t)(t + 2) * kstep; const char* b2 = last ? nB : cB + (size_t)(t + 2) * kstep;
            const char* a3 = a2 + kstep; const char* b3 = b2 + kstep;
            if (last && has_next) S.a_ready(nxt);
            if constexpr (SP2) {
            PG8_LDB(B0, 0, 0); PG8_LDB(B1, 0, 1); PG8_SCHED; PG8_LDA(At, 0, 0); PG8_STAGE(PG8_SA(1, 1), a1 + hstepA, voffA);
            PG8_WAIT_V(8); PG8_WAIT_L(0); PG8_BAR; PG8_MMA(0, 0, At, B0); PG8_MMA(0, 1, At, B1); PG8_BAR; PG8_SCHED;
            PG8_LDA(At, 0, 1); PG8_STAGE(PG8_SB(0, 0), b2, voffB); PG8_STAGE(PG8_SB(0, 1), b2 + hstepB, voffB); PG8_STAGE(PG8_SA(0, 0), a2, voffA);
            PG8_WAIT_V(8); PG8_WAIT_L(0); PG8_BAR; PG8_MMA(1, 0, At, B0); PG8_MMA(1, 1, At, B1); PG8_BAR; PG8_SCHED;
            PG8_LDB(B0, 1, 0); PG8_LDB(B1, 1, 1); PG8_SCHED; PG8_LDA(At, 1, 0); PG8_STAGE(PG8_SA(0, 1), a2 + hstepA, voffA);
            PG8_WAIT_V(8); PG8_WAIT_L(0); PG8_BAR; PG8_MMA(0, 0, At, B0); PG8_MMA(0, 1, At, B1); PG8_BAR; PG8_SCHED;
            PG8_LDA(At, 1, 1); PG8_STAGE(PG8_SB(1, 0), b3, voffB); PG8_STAGE(PG8_SB(1, 1), b3 + hstepB, voffB); PG8_STAGE(PG8_SA(1, 0), a3, voffA);
            PG8_WAIT_V(8); PG8_WAIT_L(0); PG8_BAR; PG8_MMA(1, 0, At, B0); PG8_MMA(1, 1, At, B1); PG8_BAR; PG8_SCHED;
            } else {
            PG8_LDB(B0, 0, 0); PG8_SCHED; PG8_LDA(At, 0, 0); PG8_STAGE(PG8_SA(1, 1), a1 + hstepA, voffA);
            PG8_WAIT_L(8); PG8_BAR; PG8_WAIT_L(0); PG8_MMA(0, 0, At, B0); PG8_BAR; PG8_SCHED;
            PG8_LDB(B1, 0, 1); PG8_STAGE(PG8_SB(0, 0), b2, voffB);
            PG8_BAR; PG8_WAIT_L(0); PG8_MMA(0, 1, At, B1); PG8_BAR;
            PG8_LDA(At, 0, 1); PG8_STAGE(PG8_SA(0, 0), a2, voffA);
            PG8_BAR; PG8_WAIT_L(0); PG8_MMA(1, 0, At, B0); PG8_BAR; PG8_SCHED;
            PG8_STAGE(PG8_SB(0, 1), b2 + hstepB, voffB);
            PG8_WAIT_V(6); PG8_BAR; PG8_MMA(1, 1, At, B1); PG8_BAR;
            PG8_LDB(B0, 1, 0); PG8_SCHED; PG8_LDA(At, 1, 0); PG8_STAGE(PG8_SA(0, 1), a2 + hstepA, voffA);
            PG8_WAIT_L(8); PG8_BAR; PG8_WAIT_L(0); PG8_MMA(0, 0, At, B0); PG8_BAR; PG8_SCHED;
            PG8_LDB(B1, 1, 1); PG8_STAGE(PG8_SB(1, 0), b3, voffB);
            PG8_BAR; PG8_WAIT_L(0); PG8_MMA(0, 1, At, B1); PG8_BAR;
            PG8_LDA(At, 1, 1); PG8_STAGE(PG8_SA(1, 0), a3, voffA);
            PG8_BAR; PG8_WAIT_L(0); PG8_MMA(1, 0, At, B0); PG8_BAR; PG8_SCHED;
            PG8_STAGE(PG8_SB(1, 1), b3 + hstepB, voffB);
            PG8_WAIT_V(6); PG8_BAR; PG8_MMA(1, 1, At, B1); PG8_BAR;
            }
        }
        if constexpr (ALIGN_EPI) { if (wr == 0) PG8_BAR; }
        if constexpr (!Epi::AFTER_DRAIN) { E(acc, cur, wr, wc, fr, fq); S.done(cur); }
        if (!has_next) break;
#pragma unroll
        for (int a = 0; a < 2; ++a)
#pragma unroll
            for (int b = 0; b < 2; ++b)
#pragma unroll
                for (int m = 0; m < 4; ++m)
#pragma unroll
                    for (int n = 0; n < 2; ++n) acc[a][b][m][n] = (f32x4){0.f, 0.f, 0.f, 0.f};
        cur = nxt; cA = nA; cB = nB; ++ui;
        if constexpr (ALIGN_EPI) { if (wr == 1) PG8_BAR; }
    }
    PG8_WAIT_V(0);
    if constexpr (!ALIGN_EPI) { if (wr == 0) PG8_BAR; }
    PG8_BAR;
    if constexpr (Epi::AFTER_DRAIN) { E.fused(acc, cur, wr, wc, fr, fq, lds, wid, lane); S.done(cur); }
#undef PG8_SA
#undef PG8_SB
#undef PG8_STAGE
#undef PG8_LDA
#undef PG8_LDB
#undef PG8_MMA
#undef PG8_WAIT_V
#undef PG8_WAIT_L
#undef PG8_BAR
#undef PG8_SCHED
}
}

#define MFMA32(a, b, c) __builtin_amdgcn_mfma_f32_32x32x16_bf16((a), (b), (c), 0, 0, 0)
__device__ __forceinline__ bf16x8 pack8(const f32x16& p, int b) {
    u32x4 w = (u32x4){pk2(p[b], p[b + 1]), pk2(p[b + 2], p[b + 3]), pk2(p[b + 4], p[b + 5]), pk2(p[b + 6], p[b + 7])};
    return __builtin_bit_cast(bf16x8, w);
}
__device__ __forceinline__ float max3f_(float a, float b, float c) { float r; asm("v_max3_f32 %0, %1, %2, %3" : "=v"(r) : "v"(a), "v"(b), "v"(c)); return r; }
__device__ __forceinline__ float max16(const f32x16& p) {
    float a = max3f_(p[0], p[1], p[2]), b = max3f_(p[3], p[4], p[5]);
    a = max3f_(a, p[6], p[7]); b = max3f_(b, p[8], p[9]); a = max3f_(a, p[10], p[11]); b = max3f_(b, p[12], p[13]);
    return max3f_(a, b, max3f_(p[14], p[15], p[15]));
}
__device__ __forceinline__ bf16x8 cat44(s16x4 a, s16x4 b) { return (bf16x8){a[0], a[1], a[2], a[3], b[0], b[1], b[2], b[3]}; }

struct MlaState { f32x16 o0, o1, negm; float l; };
typedef float f32x2p __attribute__((ext_vector_type(2)));
__device__ __forceinline__ void mla_softmax_pv_prep(MlaState& st, f32x16& p0, f32x16& p1, bf16x8 (&pb)[4], bool first) {
    float mx = fmaxf(max16(p0), max16(p1));
    { auto rr = __builtin_amdgcn_permlane32_swap(__builtin_bit_cast(unsigned, mx), __builtin_bit_cast(unsigned, mx), false, false);
      mx = fmaxf(__builtin_bit_cast(float, rr[0]), __builtin_bit_cast(float, rr[1])); }
    if (first || __any(mx > 8.0f)) {
        const float d = first ? mx : (mx > 8.0f ? mx : 0.f);
#pragma unroll
        for (int r = 0; r < 16; ++r) { p0[r] -= d; p1[r] -= d; st.negm[r] -= d; }
        if (!first) { const float f = __builtin_amdgcn_exp2f(-d); st.l *= f;
#pragma unroll
            for (int r = 0; r < 16; ++r) { st.o0[r] *= f; st.o1[r] *= f; } }
    }
    f32x2p ps = (f32x2p){0.f, 0.f};
#pragma unroll
    for (int r = 0; r < 16; r += 2) {
        p0[r] = __builtin_amdgcn_exp2f(p0[r]); p0[r + 1] = __builtin_amdgcn_exp2f(p0[r + 1]); p1[r] = __builtin_amdgcn_exp2f(p1[r]); p1[r + 1] = __builtin_amdgcn_exp2f(p1[r + 1]);
        ps += (f32x2p){p0[r], p0[r + 1]}; ps += (f32x2p){p1[r], p1[r + 1]};
    }
    st.l += ps[0] + ps[1];
    pb[0] = pack8(p0, 0); pb[1] = pack8(p0, 8); pb[2] = pack8(p1, 0); pb[3] = pack8(p1, 8);
}

constexpr int MLA_KROW = 208, MLA_VROW = 144, MLA_KT = 64 * MLA_KROW  , MLA_STAGE = MLA_KT + 64 * MLA_VROW  ;

__device__ __forceinline__ void mla_prompt_unit(LAS unsigned char* lds, int h, int qb, const bf16_t* __restrict__ Q, const bf16_t* __restrict__ KN, const bf16_t* __restrict__ KPE,
                                                const bf16_t* __restrict__ VT, bf16_t* MERGED, float* ssqa) {
    const int tid = threadIdx.x, lane = tid & 63, w = __builtin_amdgcn_readfirstlane(tid >> 6), r32 = lane & 31, hi = lane >> 5;
    const int q0 = qb * 256 + w * 32;
    bf16x8 qf[6];
    { const bf16_t* qp = Q + (size_t)(q0 + r32) * 768 + h * 96 + hi * 8;
#pragma unroll
      for (int s = 0; s < 6; ++s) qf[s] = *(const bf16x8*)(qp + 16 * s); }
    const int NT = 4 * qb + 4, mylast = 4 * qb + (w >> 1);
    MlaState st; st.l = 0.f;
#pragma unroll
    for (int r = 0; r < 16; ++r) { st.o0[r] = 0.f; st.o1[r] = 0.f; st.negm[r] = 0.f; }
    const int krow = tid >> 3, kch = tid & 7, prow = (tid & 255) >> 2, pch = tid & 3, vd = tid >> 3, vch = tid & 7;
    const bf16_t* ksrc = KN + (size_t)krow * 512 + h * 64 + kch * 8;
    const bf16_t* psrc = KPE + (size_t)prow * 32 + pch * 8;
    const bf16_t* vsrc = VT + (size_t)(h * 64 + vd) * VT_LD + vch * 8;
    const int kdst = krow * MLA_KROW + kch * 16, pdst = prow * MLA_KROW + 128 + pch * 16, vdst = MLA_KT + vd * MLA_VROW + (vch >> 1) * 32 + (vch & 1) * 8;
    u32x4 rk, rp, rv; rp = (u32x4){0, 0, 0, 0};
#define MLA_GLOAD(t) do { rk = *(const u32x4*)(ksrc + (size_t)(t) * 64 * 512); if (tid < 256) rp = *(const u32x4*)(psrc + (size_t)(t) * 64 * 32); rv = *(const u32x4*)(vsrc + (size_t)(t) * 64); } while (0)
#define MLA_LSTORE(b) do { LAS unsigned char* sb_ = lds + (b) * MLA_STAGE; *(LAS u32x4*)(sb_ + kdst) = rk; if (tid < 256) *(LAS u32x4*)(sb_ + pdst) = rp; \
        *(LAS u32x2*)(sb_ + vdst) = (u32x2){rv[0], rv[1]}; *(LAS u32x2*)(sb_ + vdst + 16) = (u32x2){rv[2], rv[3]}; } while (0)
    MLA_GLOAD(0); MLA_LSTORE(0); __syncthreads();
    for (int t = 0; t < NT; ++t) {
        const bool more = (t + 1 < NT);
        if (more) MLA_GLOAD(t + 1);
        if (t <= mylast) {
            const LAS unsigned char* sb = lds + (t & 1) * MLA_STAGE;
            const LAS unsigned char* kb = sb + r32 * MLA_KROW + hi * 16;
            bf16x8 ka[6], kc[6];
#pragma unroll
            for (int s = 0; s < 6; ++s) { ka[s] = *(const LAS bf16x8*)(kb + s * 32); kc[s] = *(const LAS bf16x8*)(kb + 32 * MLA_KROW + s * 32); }
            __builtin_amdgcn_sched_barrier(0);
            f32x16 p0 = st.negm, p1 = st.negm;
#pragma unroll
            for (int s = 0; s < 6; ++s) { p0 = MFMA32(ka[s], qf[s], p0); p1 = MFMA32(kc[s], qf[s], p1); }
            __builtin_amdgcn_sched_barrier(0);
            const LAS unsigned char* vb = sb + MLA_KT + r32 * MLA_VROW + hi * 16;
            bf16x8 va[4], vc[4];
#pragma unroll
            for (int s = 0; s < 4; ++s) {
                va[s] = *(const LAS bf16x8*)(vb + s * 32); vc[s] = *(const LAS bf16x8*)(vb + 32 * MLA_VROW + s * 32);
            }
            __builtin_amdgcn_sched_barrier(0);
            bf16x8 pb[4];
            mla_softmax_pv_prep(st, p0, p1, pb, t == 0);
#pragma unroll
            for (int s = 0; s < 4; ++s) { st.o0 = MFMA32(va[s], pb[s], st.o0); st.o1 = MFMA32(vc[s], pb[s], st.o1); }
        }
        if (more) MLA_LSTORE((t + 1) & 1);
        __syncthreads();
    }
#undef MLA_GLOAD
#undef MLA_LSTORE
    const float l = st.l + __shfl_xor(st.l, 32); const float inv = 1.f / l;
    const int row = q0 + r32; bf16_t* op = MERGED + (size_t)row * DM + h * 64 + 4 * hi; float sq = 0.f;
#pragma unroll
    for (int g = 0; g < 4; ++g) {
        const float a0 = st.o0[4 * g] * inv, a1 = st.o0[4 * g + 1] * inv, a2 = st.o0[4 * g + 2] * inv, a3 = st.o0[4 * g + 3] * inv;
        const float b0 = st.o1[4 * g] * inv, b1 = st.o1[4 * g + 1] * inv, b2 = st.o1[4 * g + 2] * inv, b3 = st.o1[4 * g + 3] * inv;
        *(u32x2*)(op + 8 * g) = (u32x2){pk2(a0, a1), pk2(a2, a3)}; *(u32x2*)(op + 32 + 8 * g) = (u32x2){pk2(b0, b1), pk2(b2, b3)};
        sq += (a0 * a0 + a1 * a1) + (a2 * a2 + a3 * a3) + (b0 * b0 + b1 * b1) + (b2 * b2 + b3 * b3);
    }
    sq += __shfl_xor(sq, 32); if (hi == 0) atomic_addf(ssqa + row, sq);
}

__device__ __forceinline__ void mla_sample_unit(LAS unsigned char* lds, int b, int h, const bf16_t* __restrict__ Q, const bf16_t* __restrict__ KN, const bf16_t* __restrict__ KPE,
                                                const bf16_t* __restrict__ VT, bf16_t* MERGED, float* ssqa) {
    const int tid = threadIdx.x, lane = tid & 63, w = __builtin_amdgcn_readfirstlane(tid >> 6), r32 = lane & 31, hi = lane >> 5;
    const int row = TP + b * 32 + r32;
    bf16x8 qf[6];
    { const bf16_t* qp = Q + (size_t)row * 768 + h * 96 + hi * 8;
#pragma unroll
      for (int s = 0; s < 6; ++s) qf[s] = *(const bf16x8*)(qp + 16 * s); }
    MlaState st; st.l = 0.f;
#pragma unroll
    for (int r = 0; r < 16; ++r) { st.o0[r] = 0.f; st.o1[r] = 0.f; st.negm[r] = 0.f; }
    bf16x8 ka[6], kc[6]; s16x4 va[8], vc[8];
#define MLS_LOAD(t_, KA, KC, VA, VC) do { const size_t kv0_ = (size_t)b * SKV + (t_) * 64; \
        const bf16_t* kp_ = KN + (kv0_ + r32) * 512 + h * 64 + hi * 8; const bf16_t* pp_ = KPE + (kv0_ + r32) * 32 + hi * 8; \
        _Pragma("unroll") for (int s_ = 0; s_ < 4; ++s_) { KA[s_] = *(const bf16x8*)(kp_ + 16 * s_); KC[s_] = *(const bf16x8*)(kp_ + 32 * 512 + 16 * s_); } \
        _Pragma("unroll") for (int s_ = 0; s_ < 2; ++s_) { KA[4 + s_] = *(const bf16x8*)(pp_ + 16 * s_); KC[4 + s_] = *(const bf16x8*)(pp_ + 32 * 32 + 16 * s_); } \
        const bf16_t* vp_ = VT + (size_t)(h * 64 + r32) * VTS_LD + kv0_ + 4 * hi; \
        _Pragma("unroll") for (int s_ = 0; s_ < 4; ++s_) { VA[2 * s_] = *(const s16x4*)(vp_ + 16 * s_); VA[2 * s_ + 1] = *(const s16x4*)(vp_ + 16 * s_ + 8); \
            VC[2 * s_] = *(const s16x4*)(vp_ + (size_t)32 * VTS_LD + 16 * s_); VC[2 * s_ + 1] = *(const s16x4*)(vp_ + (size_t)32 * VTS_LD + 16 * s_ + 8); } } while (0)
    for (int t = w; t < 33; t += 8) {
        MLS_LOAD(t, ka, kc, va, vc);
        __builtin_amdgcn_sched_barrier(0);
        f32x16 p0 = st.negm, p1 = st.negm;
        const bool tail = (t == 32);
#pragma unroll
        for (int s = 0; s < 6; ++s) { p0 = MFMA32(ka[s], qf[s], p0); if (!tail) p1 = MFMA32(kc[s], qf[s], p1); }
        if (tail) {
#pragma unroll
            for (int r = 0; r < 16; ++r) p1[r] = -1e30f;
        }
        bf16x8 pb[4];
        mla_softmax_pv_prep(st, p0, p1, pb, t == w);
#pragma unroll
        for (int s = 0; s < 4; ++s) {
            if (tail && s >= 2) break;
            st.o0 = MFMA32(cat44(va[2 * s], va[2 * s + 1]), pb[s], st.o0); st.o1 = MFMA32(cat44(vc[2 * s], vc[2 * s + 1]), pb[s], st.o1);
        }
    }
#undef MLS_LOAD
    LAS float* Lm = (LAS float*)lds; LAS float* Ll = Lm + 512; LAS float* LO = Lm + 1024;
    const float mref = -st.negm[0];
    Lm[w * 64 + lane] = mref;
    __syncthreads();
    float M = Lm[lane];
#pragma unroll
    for (int k = 1; k < 8; ++k) M = fmaxf(M, Lm[k * 64 + lane]);
    const float f = __builtin_amdgcn_exp2f(mref - M);
    Ll[w * 64 + lane] = st.l * f;
#pragma unroll
    for (int r = 0; r < 16; ++r) { LO[(w * 32 + r) * 64 + lane] = st.o0[r] * f; LO[(w * 32 + 16 + r) * 64 + lane] = st.o1[r] * f; }
    __syncthreads();
    float l = 0.f;
#pragma unroll
    for (int k = 0; k < 8; ++k) l += Ll[k * 64 + lane] + Ll[k * 64 + (lane ^ 32)];
    const float inv = 1.f / l;
    float v[4];
#pragma unroll
    for (int i = 0; i < 4; ++i) { float s = 0.f;
#pragma unroll
        for (int k = 0; k < 8; ++k) s += LO[(k * 32 + 4 * w + i) * 64 + lane];
        v[i] = s * inv; }
    *(u32x2*)(MERGED + (size_t)row * DM + h * 64 + 32 * (w >> 2) + 8 * (w & 3) + 4 * hi) = (u32x2){pk2(v[0], v[1]), pk2(v[2], v[3])};
    float sq = (v[0] * v[0] + v[1] * v[1]) + (v[2] * v[2] + v[3] * v[3]);
    sq += __shfl_xor(sq, 32); if (hi == 0) atomic_addf(ssqa + row, sq);
    __syncthreads();
}

template <class QF, class KF, class VF, class MID>
__device__ __forceinline__ void xattn_wave(QF qfrag, bf16_t* orow  , KF kfrag, VF vfrag, MID mid) {
    bf16x8 pb[16];
    float inv;
    {
        f32x16 S[4][2];
#pragma unroll
        for (int kt = 0; kt < 4; ++kt)
#pragma unroll
            for (int r = 0; r < 16; ++r) { S[kt][0][r] = 0.f; S[kt][1][r] = 0.f; }
#pragma unroll
        for (int s = 0; s < 16; ++s) {
            const bf16x8 qf = qfrag(s);
#pragma unroll
            for (int kt = 0; kt < 4; ++kt) { S[kt][0] = MFMA32(kfrag(kt, 0, s), qf, S[kt][0]); S[kt][1] = MFMA32(kfrag(kt, 1, s), qf, S[kt][1]); }
        }
        float mx = -1e30f;
#pragma unroll
        for (int kt = 0; kt < 4; ++kt) mx = fmaxf(mx, fmaxf(max16(S[kt][0]), max16(S[kt][1])));
        mx = fmaxf(mx, __shfl_xor(mx, 32));
        float l = 0.f;
#pragma unroll
        for (int kt = 0; kt < 4; ++kt) {
#pragma unroll
            for (int r = 0; r < 16; ++r) { S[kt][0][r] = __builtin_amdgcn_exp2f(S[kt][0][r] - mx); S[kt][1][r] = __builtin_amdgcn_exp2f(S[kt][1][r] - mx); l += S[kt][0][r] + S[kt][1][r]; }
            pb[4 * kt] = pack8(S[kt][0], 0); pb[4 * kt + 1] = pack8(S[kt][0], 8); pb[4 * kt + 2] = pack8(S[kt][1], 0); pb[4 * kt + 3] = pack8(S[kt][1], 8);
        }
        l += __shfl_xor(l, 32); inv = 1.f / l;
    }
    mid();
#pragma unroll 1
    for (int db = 0; db < 8; ++db) {
        f32x16 o;
#pragma unroll
        for (int r = 0; r < 16; ++r) o[r] = 0.f;
        bf16x8 vf[16];
#pragma unroll
        for (int s = 0; s < 16; ++s) vf[s] = vfrag(db, s);
        __builtin_amdgcn_sched_barrier(0);
#pragma unroll
        for (int s = 0; s < 16; ++s) o = MFMA32(vf[s], pb[s], o);
#pragma unroll
        for (int g = 0; g < 4; ++g)
            *(u32x2*)(orow + 32 * db + 8 * g) = (u32x2){pk2(o[4 * g] * inv, o[4 * g + 1] * inv), pk2(o[4 * g + 2] * inv, o[4 * g + 3] * inv)};
    }
}

constexpr int XA_KROW = 528, XA_VROW = 528;
__device__ __forceinline__ void xattn_unit(LAS unsigned char* lds, int rowbase, bool single, int h, bf16_t* QM, const bf16_t* __restrict__ MKB, const bf16_t* __restrict__ MVTB, const float* __restrict__ QACC, const float* __restrict__ ssq2) {
    const int tid = threadIdx.x, lane = tid & 63, w = __builtin_amdgcn_readfirstlane(tid >> 6), r32 = lane & 31, hi = lane >> 5;
#pragma unroll 4
    for (int it = 0; it < 16; ++it) { const int idx = it * 512 + tid, rw = idx >> 5, ch = idx & 31;
        *(LAS u32x4*)(lds + rw * XA_KROW + ch * 16) = *(const u32x4*)(MKB + (size_t)rw * DM + h * 256 + ch * 8); }
    __syncthreads();
    const int row = rowbase + (single ? 0 : w * 32) + r32;
    const LAS unsigned char* kb = lds + r32 * XA_KROW + hi * 16;
    const LAS unsigned char* vb = lds + r32 * XA_VROW + hi * 16;
    auto kfrag = [&](int kt, int half, int s) -> bf16x8 { return *(const LAS bf16x8*)(kb + (kt * 64 + half * 32) * XA_KROW + s * 32); };
    auto vfrag = [&](int db, int s) -> bf16x8 { return *(const LAS bf16x8*)(vb + db * 32 * XA_VROW + s * 32); };
    auto mid = [&]() {
        __syncthreads();
#pragma unroll 4
        for (int it = 0; it < 16; ++it) { const int idx = it * 512 + tid, d = idx >> 5, ch = idx & 31;
            const u32x4 v = *(const u32x4*)(MVTB + (size_t)(h * 256 + d) * 256 + ch * 8);
            LAS unsigned char* dp = lds + d * XA_VROW + (ch >> 1) * 32 + (ch & 1) * 8;
            *(LAS u32x2*)dp = (u32x2){v[0], v[1]}; *(LAS u32x2*)(dp + 16) = (u32x2){v[2], v[3]}; }
        __syncthreads();
    };
    if (!single) {
        const bf16_t* qrow = QM + (size_t)row * DM + h * 256 + hi * 8;
        auto qfrag = [&](int s) -> bf16x8 { return *(const bf16x8*)(qrow + 16 * s); };
        xattn_wave(qfrag, QM + (size_t)row * DM + h * 256 + 4 * hi, kfrag, vfrag, mid);
    } else if (w == 0) {
        const float* qrow = QACC + (size_t)(row - TP) * DM + h * 256 + hi * 8; const float sc = XSCALE * rsqrtf(ssq2[row] * (1.0f / 1024.0f) + EPS);
        auto qfrag = [&](int s) -> bf16x8 { const f32x4 a = *(const f32x4*)(qrow + 16 * s) * sc, b = *(const f32x4*)(qrow + 16 * s + 4) * sc;
            return __builtin_bit_cast(bf16x8, (u32x4){pk2(a[0], a[1]), pk2(a[2], a[3]), pk2(b[0], b[1]), pk2(b[2], b[3])}); };
        xattn_wave(qfrag, QM + (size_t)row * DM + h * 256 + 4 * hi, kfrag, vfrag, mid);
    } else mid();
    __syncthreads();
}
struct LruArgs { const bf16_t* XBR; const float* conv_w; const float* conv_b; const float* wa; const float* ba; const float* wx; const float* bx; const float* lam;
                 const float* state_conv; const float* state_lru; bf16_t* HLOC; bf16_t* ACUM; float* ATOT; float* BTOT; float* out; };
__device__ __forceinline__ void lru_l1_unit(LAS unsigned char* lds, int unit, const LruArgs& A) {
    const int c = threadIdx.x, g = __builtin_amdgcn_readfirstlane(c >> 6), j = c & 63, r32 = j & 31, hi = j >> 5;
    const bool samp = unit >= 256; const int b = unit - 256;
    const int row0 = samp ? TP + b * 32 : unit * 64; const int nt = samp ? 32 : 64;
    constexpr int XROW = 1040;
    LAS unsigned char* XCB = lds;
    LAS unsigned* PRE = (LAS unsigned*)(lds + 64 * XROW);
    const float w0 = A.conv_w[c], w1 = A.conv_w[512 + c], w2 = A.conv_w[1024 + c], w3 = A.conv_w[1536 + c], cb = A.conv_b[c];
    float xm3, xm2, xm1;
    if (samp) { xm3 = A.state_conv[(b * 3 + 0) * 512 + c]; xm2 = A.state_conv[(b * 3 + 1) * 512 + c]; xm1 = A.state_conv[(b * 3 + 2) * 512 + c]; }
    else if (unit > 0) { xm3 = bf2f(A.XBR[(size_t)(row0 - 3) * 512 + c]); xm2 = bf2f(A.XBR[(size_t)(row0 - 2) * 512 + c]); xm1 = bf2f(A.XBR[(size_t)(row0 - 1) * 512 + c]); }
    else { xm3 = 0.f; xm2 = 0.f; xm1 = 0.f; }
    {
        unsigned short xraw[64];
#pragma unroll
        for (int t = 0; t < 64; ++t) xraw[t] = (t < nt) ? A.XBR[(size_t)(row0 + t) * 512 + c] : (unsigned short)0;
#pragma unroll
        for (int t = 0; t < 64; ++t) {
            if (t < nt) {
                const float x0 = bf2f(xraw[t]);
                *(LAS bf16_t*)(XCB + t * XROW + c * 2) = (bf16_t)f2bf(cb + w0 * xm3 + w1 * xm2 + w2 * xm1 + w3 * x0);
                xm3 = xm2; xm2 = xm1; xm1 = x0;
            }
        }
    }
    bf16x8 bw[4][4];
#pragma unroll
    for (int nb = 0; nb < 4; ++nb)
#pragma unroll
        for (int ks = 0; ks < 4; ++ks) {
            const float* W = ((nb < 2) ? A.wa : A.wx) + g * 4096 + (16 * ks) * 64 + (nb & 1) * 32;
            const float* Wl = W + (8 * hi) * 64 + r32;
            bw[nb][ks] = __builtin_bit_cast(bf16x8, (u32x4){pk2(Wl[0], Wl[64]), pk2(Wl[128], Wl[192]), pk2(Wl[256], Wl[320]), pk2(Wl[384], Wl[448])});
        }
    const float bav = A.ba[c], bxv = A.bx[c];
    const float lamv = A.lam[c]; const float sp = log1pf(__expf(-lamv));
    float h = samp ? A.state_lru[b * 512 + c] : 0.f, Ac = 1.f;
    asm volatile("s_waitcnt lgkmcnt(0)" ::: "memory");
    for (int mb = 0; mb < (nt >> 5); ++mb) {
        f32x16 C0, C1, C2, C3;
#pragma unroll
        for (int r = 0; r < 16; ++r) { C0[r] = 0.f; C1[r] = 0.f; C2[r] = 0.f; C3[r] = 0.f; }
#pragma unroll
        for (int ks = 0; ks < 4; ++ks) {
            const bf16x8 a = *(const LAS bf16x8*)(XCB + (32 * mb + r32) * XROW + (g * 64 + 16 * ks + 8 * hi) * 2);
            C0 = MFMA32(a, bw[0][ks], C0); C1 = MFMA32(a, bw[1][ks], C1); C2 = MFMA32(a, bw[2][ks], C2); C3 = MFMA32(a, bw[3][ks], C3);
        }
#pragma unroll
        for (int r = 0; r < 16; ++r) { const int tl = (r & 3) + 8 * (r >> 2) + 4 * hi;
            PRE[tl * 512 + g * 64 + r32] = f2bf(C0[r]) | (f2bf(C2[r]) << 16); PRE[tl * 512 + g * 64 + 32 + r32] = f2bf(C1[r]) | (f2bf(C3[r]) << 16); }
        asm volatile("s_waitcnt lgkmcnt(0)" ::: "memory");
#pragma unroll 4
        for (int tl = 0; tl < 32; ++tl) {
            const int t = 32 * mb + tl;
            const unsigned u = PRE[tl * 512 + c];
            const float ra = __builtin_bit_cast(float, u << 16) + bav, ri = __builtin_bit_cast(float, u & 0xffff0000u) + bxv;
            const float xcv = bf2f(*(const LAS bf16_t*)(XCB + t * XROW + c * 2));
            const float rg = __builtin_amdgcn_rcpf(1.f + __builtin_amdgcn_exp2f(-LOG2E * ra)), ig = __builtin_amdgcn_rcpf(1.f + __builtin_amdgcn_exp2f(-LOG2E * ri));
            const float a = __builtin_amdgcn_exp2f((-8.0f * LOG2E) * rg * sp);
            const float bt = __builtin_amdgcn_sqrtf(fmaxf(1.f - a * a, 0.f)) * ig * xcv;
            h = a * h + bt; Ac *= a;
            A.HLOC[(size_t)(row0 + t) * 512 + c] = (bf16_t)f2bf(h); A.ACUM[(size_t)(row0 + t) * 512 + c] = (bf16_t)f2bf(Ac);
        }
        asm volatile("s_waitcnt lgkmcnt(0)" ::: "memory");
    }
    A.ATOT[unit * 512 + c] = Ac; A.BTOT[unit * 512 + c] = h;
    if (samp) A.out[O_LRUS + b * 512 + c] = h;
    __syncthreads();
}
__device__ __forceinline__ void lru_l3_unit(LAS unsigned char* lds, int unit, const bf16_t* __restrict__ HLOC, const bf16_t* __restrict__ ACUM, const bf16_t* __restrict__ GG,
                                            const float* __restrict__ ATOT, const float* __restrict__ BTOT, const float* __restrict__ gain, bf16_t* MERGED, float* out) {
    const int c = threadIdx.x, lane = c & 63, w = __builtin_amdgcn_readfirstlane(c >> 6);
    const bool samp = unit >= 256; const int row0 = samp ? TP + (unit - 256) * 32 : unit * 64; const int nt = samp ? 32 : 64;
    LAS float* HIN = (LAS float*)lds;
    float H = 0.f;
    if (!samp) {
#pragma unroll 32
        for (int k = 0; k < unit; ++k) H = ATOT[k * 512 + c] * H + BTOT[k * 512 + c];
        if (unit == 255) out[O_LRUP + c] = ATOT[255 * 512 + c] * H + BTOT[255 * 512 + c];
    }
    HIN[c] = H;
    __syncthreads();
    float hin[8], gn[8];
#pragma unroll
    for (int k = 0; k < 8; ++k) { hin[k] = HIN[lane * 8 + k]; gn[k] = gain[lane * 8 + k]; }
    for (int t0 = w; t0 < nt; t0 += 32) {
        u32x4 hl[4], ac[4], gg[4];
#pragma unroll
        for (int q = 0; q < 4; ++q) { const size_t off = (size_t)(row0 + t0 + 8 * q) * 512 + lane * 8;
            hl[q] = *(const u32x4*)(HLOC + off); ac[q] = *(const u32x4*)(ACUM + off); gg[q] = *(const u32x4*)(GG + off); }
#pragma unroll
        for (int q = 0; q < 4; ++q) {
            float v[8]; float sq = 0.f;
#pragma unroll
            for (int k = 0; k < 4; ++k) {
                const float h0 = __builtin_bit_cast(float, hl[q][k] << 16) + __builtin_bit_cast(float, ac[q][k] << 16) * hin[2 * k];
                const float h1 = __builtin_bit_cast(float, hl[q][k] & 0xffff0000u) + __builtin_bit_cast(float, ac[q][k] & 0xffff0000u) * hin[2 * k + 1];
                v[2 * k] = __builtin_bit_cast(float, gg[q][k] << 16) * h0; v[2 * k + 1] = __builtin_bit_cast(float, gg[q][k] & 0xffff0000u) * h1;
                sq += v[2 * k] * v[2 * k] + v[2 * k + 1] * v[2 * k + 1];
            }
            const float rs = rsqrtf(wave_sum(sq) * (1.0f / 512.0f) + EPS);
            *(u32x4*)(MERGED + (size_t)(row0 + t0 + 8 * q) * DM + 512 + lane * 8) =
                (u32x4){pk2(v[0] * rs * gn[0], v[1] * rs * gn[1]), pk2(v[2] * rs * gn[2], v[3] * rs * gn[3]), pk2(v[4] * rs * gn[4], v[5] * rs * gn[5]), pk2(v[6] * rs * gn[6], v[7] * rs * gn[7])};
        }
    }
    __syncthreads();
}

__device__ __forceinline__ void sample_finalize_part(int part, const float* __restrict__ xs_old, const float* __restrict__ ACC, float* xs_new, bf16_t* XBs, float* ssq_s, unsigned* flag) {
    const int lane = threadIdx.x & 63, w = __builtin_amdgcn_readfirstlane(threadIdx.x >> 6);
    const int r0 = part * 32 + w * 4;
    f32x4 v[4][4];
#pragma unroll
    for (int q = 0; q < 4; ++q)
#pragma unroll
        for (int j = 0; j < 4; ++j) v[q][j] = *((const f32x4*)(xs_old + (size_t)(r0 + q) * DM) + lane + 64 * j) + *((const f32x4*)(ACC + (size_t)(r0 + q) * DM) + lane + 64 * j);
#pragma unroll
    for (int q = 0; q < 4; ++q) {
        float s = 0.f;
#pragma unroll
        for (int j = 0; j < 4; ++j) s += (v[q][j][0] * v[q][j][0] + v[q][j][1] * v[q][j][1]) + (v[q][j][2] * v[q][j][2] + v[q][j][3] * v[q][j][3]);
        s = wave_sum(s); if (lane == 0) ssq_s[r0 + q] = s;
#pragma unroll
        for (int j = 0; j < 4; ++j) { *((f32x4*)(xs_new + (size_t)(r0 + q) * DM) + lane + 64 * j) = v[q][j]; *((u32x2*)(XBs + (size_t)(r0 + q) * DM) + lane + 64 * j) = (u32x2){pk2(v[q][j][0], v[q][j][1]), pk2(v[q][j][2], v[q][j][3])}; }
    }
    asm volatile("s_waitcnt vmcnt(0)" ::: "memory");
    __syncthreads();
    if (threadIdx.x == 0) { __builtin_amdgcn_fence(__ATOMIC_RELEASE, "agent"); asm volatile("s_waitcnt vmcnt(0)" ::: "memory"); __hip_atomic_fetch_add(flag, 1u, __ATOMIC_RELAXED, __HIP_MEMORY_SCOPE_AGENT); }
}
__device__ __forceinline__ void sample_wait(unsigned* flag, unsigned want) {
    if (threadIdx.x == 0) { while (__hip_atomic_load(flag, __ATOMIC_RELAXED, __HIP_MEMORY_SCOPE_AGENT) < want) __builtin_amdgcn_s_sleep(2);
        __builtin_amdgcn_fence(__ATOMIC_ACQUIRE, "agent"); asm volatile("s_waitcnt vmcnt(0)" ::: "memory"); }
    __syncthreads();
}

__device__ __forceinline__ void tr_item(const float* __restrict__ W, int N, int k0, int n0, bf16_t* WT, int drow0, int ldd, const float* gain, LAS float* scr, int lane) {
    float tv[32];
#pragma unroll
    for (int i = 0; i < 32; ++i) tv[i] = W[(size_t)(k0 + 2 * i + (lane >> 5)) * N + n0 + (lane & 31)];
#pragma unroll
    for (int i = 0; i < 32; ++i) { const int kk = 2 * i + (lane >> 5); float v = tv[i]; if (gain) v *= gain[k0 + kk]; scr[kk * 33 + (lane & 31)] = v; }
    asm volatile("s_waitcnt lgkmcnt(0)" ::: "memory");
    const int cc = lane & 7;
#pragma unroll
    for (int jj = 0; jj < 4; ++jj) { const int n = (lane >> 3) + 8 * jj; const LAS float* s = scr + (8 * cc) * 33 + n;
        u32x4 o; o.x = pk2(s[0 * 33], s[1 * 33]); o.y = pk2(s[2 * 33], s[3 * 33]); o.z = pk2(s[4 * 33], s[5 * 33]); o.w = pk2(s[6 * 33], s[7 * 33]);
        *(u32x4*)(WT + (size_t)(drow0 + n) * ldd + k0 + 8 * cc) = o; }
    asm volatile("s_waitcnt lgkmcnt(0)" ::: "memory");
}

#define XB_TMO      128
#define XB_XCNT(j)  (256  + 64 * (j))
#define XB_XSUB(j)  (1280 + 64 * (j))
#define XB_XGEN(j)  (2304 + 64 * (j))
#define XB_TOP      3328
#define XB_TOPGEN   3392
#define XCD_BAR_WORDS 3456
#define XB_SPIN_CAP (1u << 18)

__device__ __forceinline__ unsigned xb_ld(unsigned* p)              { return __hip_atomic_load(p, __ATOMIC_RELAXED, __HIP_MEMORY_SCOPE_AGENT); }
__device__ __forceinline__ unsigned xb_add(unsigned* p, unsigned v) { return __hip_atomic_fetch_add(p, v, __ATOMIC_RELAXED, __HIP_MEMORY_SCOPE_AGENT); }
__device__ __forceinline__ unsigned xb_xcc_id() { return (unsigned)__builtin_amdgcn_s_getreg((3 << 11) | 20) & 0xFu; }
#define XB_SPIN(cond, bar) do { unsigned _sp = 0; while (cond) { __builtin_amdgcn_s_sleep(1); \
    if ((++_sp & 255u) == 0u) { if (xb_ld(&(bar)[XB_TMO])) break; if (_sp > XB_SPIN_CAP) { atomicAdd(&(bar)[XB_TMO], 1u); break; } } } } while (0)

struct XcdBarrier {
    unsigned* bar; unsigned x;
    volatile LAS unsigned* st;
};

__device__ __forceinline__ XcdBarrier xcd_barrier_post(unsigned* bar, volatile LAS unsigned* st) {
    XcdBarrier b; b.bar = bar; b.x = xb_xcc_id(); b.st = st;
    if (threadIdx.x == 0) (void)xb_add(&bar[XB_XCNT(b.x)], 1u);
    return b;
}
__device__ __forceinline__ void xcd_barrier_complete(unsigned* bar, unsigned x, unsigned& nloc, unsigned& nx) {
    const unsigned G = gridDim.x * gridDim.y * gridDim.z;
    unsigned sum, cnt, mine, sp = 0u;
    for (;;) {
        sum = 0u; cnt = 0u; mine = 0u;
#pragma unroll
        for (unsigned j = 0; j < 16; ++j) { const unsigned c = xb_ld(&bar[XB_XCNT(j)]); sum += c; cnt += (c > 0u) ? 1u : 0u; mine = (j == x) ? c : mine; }
        if (sum == G) break;
        __builtin_amdgcn_s_sleep(1);
        if ((++sp & 255u) == 0u) { if (xb_ld(&bar[XB_TMO])) break; if (sp > XB_SPIN_CAP) { atomicAdd(&bar[XB_TMO], 1u); break; } }
    }
    nloc = mine > 0u ? mine : 1u; nx = cnt > 0u ? cnt : 1u;
}

__device__ __forceinline__ void xcd_barrier(const XcdBarrier& b) {
    asm volatile("s_waitcnt vmcnt(0)" ::: "memory");
    __syncthreads();
    if (threadIdx.x == 0) {
        unsigned* bar = b.bar;
        __builtin_amdgcn_s_waitcnt(0);
        unsigned nloc = b.st[0], nx = b.st[1];
        if (nloc == 0u) { xcd_barrier_complete(bar, b.x, nloc, nx); b.st[0] = nloc; b.st[1] = nx; }
        const unsigned old = xb_add(&bar[XB_XSUB(b.x)], 1u);
        const unsigned gen = old / nloc;
        if (old + 1u == (gen + 1u) * nloc) {
            __builtin_amdgcn_fence(__ATOMIC_RELEASE, "agent");
            asm volatile("s_waitcnt vmcnt(0)" ::: "memory");
            const unsigned og = xb_add(&bar[XB_TOP], 1u);
            const unsigned tg = og / nx;
            if (og + 1u == (tg + 1u) * nx) xb_add(&bar[XB_TOPGEN], 1u);
            else XB_SPIN(xb_ld(&bar[XB_TOPGEN]) == tg, bar);
            __builtin_amdgcn_fence(__ATOMIC_ACQUIRE, "agent");
            xb_add(&bar[XB_XGEN(b.x)], 1u);
            asm volatile("s_waitcnt vmcnt(0)" ::: "memory");
        } else {
            XB_SPIN(xb_ld(&bar[XB_XGEN(b.x)]) == gen, bar);
            __builtin_amdgcn_fence(__ATOMIC_ACQUIRE, "agent");
            asm volatile("s_waitcnt vmcnt(0)" ::: "memory");
        }
    }
    __syncthreads();
}

constexpr int NPHASE = 13;
struct Args { const float* in[40]; float* out; unsigned char* ws; int ph_lo, ph_hi; };
enum { I_XP = 0, I_XS, I_MEM, I_CCKV, I_CKPE, I_SCONV, I_SLRU, I_CMK, I_CMV, I_F1N, I_F1W1, I_F1W3, I_F1W2, I_MIXN, I_WIN, I_QN, I_WUQ, I_KVN, I_WUKV, I_CONVW, I_CONVB,
       I_LWA, I_LBA, I_LWX, I_LBX, I_LAM, I_AON, I_LON, I_WOUT, I_MEMN, I_XAN, I_WMQ, I_WMK, I_WMV, I_WMO, I_F2N, I_F2W1, I_F2W3, I_F2W2, I_FINN };

#define ssq0 ((float*)(ws + WS_SSQ))
#define ssq1 ((float*)(ws + WS_SSQ) + 1 * MT)
#define ssq2 ((float*)(ws + WS_SSQ) + 2 * MT)
#define ssq3 ((float*)(ws + WS_SSQ) + 3 * MT)
#define ssq4 ((float*)(ws + WS_SSQ) + 4 * MT)
#define ssqq ((float*)(ws + WS_SSQ) + 5 * MT)
#define ssqa ((float*)(ws + WS_SSQ) + 6 * MT)
#define W13_1 ((bf16_t*)(ws + WS_W13_1))
#define W2_1 ((bf16_t*)(ws + WS_W2_1))
#define W13_2 ((bf16_t*)(ws + WS_W13_2))
#define W2_2 ((bf16_t*)(ws + WS_W2_2))
#define WIN ((bf16_t*)(ws + WS_WIN))
#define WUQ ((bf16_t*)(ws + WS_WUQ))
#define WK ((bf16_t*)(ws + WS_WK))
#define WV ((bf16_t*)(ws + WS_WV))
#define WOUT ((bf16_t*)(ws + WS_WOUT))
#define WMQ ((bf16_t*)(ws + WS_WMQ))
#define WMKV ((bf16_t*)(ws + WS_WMKV))
#define WMO ((bf16_t*)(ws + WS_WMO))
#define MEMB ((bf16_t*)(ws + WS_MEMB))
#define MKB ((bf16_t*)(ws + WS_MKB))
#define MVTB ((bf16_t*)(ws + WS_MVTB))
#define MVB ((bf16_t*)(ws + WS_MVB))
#define CMKB ((bf16_t*)(ws + WS_CMKB))
#define CMVTB ((bf16_t*)(ws + WS_CMVTB))
#define XB ((bf16_t*)(ws + WS_XB))
#define HLOC ((bf16_t*)(out + O_Y))
#define ACUM ((bf16_t*)(out + O_Y) + (size_t)MT * 512)
#define HID ((bf16_t*)(ws + WS_HID))
#define CQ ((bf16_t*)(ws + WS_CQ))
#define CKVP ((bf16_t*)(ws + WS_CKVP))
#define CKVS ((bf16_t*)(ws + WS_CKVS))
#define XBR ((bf16_t*)(ws + WS_XBR))
#define MERGED ((bf16_t*)(ws + WS_MERGED))
#define GG ((bf16_t*)(ws + WS_GG))
#define Q ((bf16_t*)(ws + WS_Q))
#define KNP ((bf16_t*)(ws + WS_KNP))
#define KNS ((bf16_t*)(ws + WS_KNS))
#define VTP ((bf16_t*)(ws + WS_VTP))
#define VTS (((bf16_t*)(ws + WS_VTP)) + TP)
#define KPEP ((bf16_t*)(ws + WS_KPEP))
#define KPES ((bf16_t*)(ws + WS_KPES))
#define QM ((bf16_t*)(ws + WS_QM))
#define ATOT ((float*)(ws + WS_ATOT))
#define ACCB(i) ((float*)(ws + WS_ACC) + (size_t)(i) * TS * DM)
#define FLAGW(i) ((unsigned*)(ws + WS_BAR) + 3584 + 64 * (i))
#define XSA ((float*)(ws + WS_XSA))
#define XSB ((float*)(ws + WS_XSB))
#define BTOT ((float*)(ws + WS_BTOT))
__global__ void __launch_bounds__(NTHR, 2) mk_fwd(Args a) {
    extern __shared__ __attribute__((aligned(16))) unsigned char lds_raw[];
    LAS unsigned char* lds = (LAS unsigned char*)lds_raw;
    cg::grid_group grid = cg::this_grid();
    const int wave = __builtin_amdgcn_readfirstlane((int)threadIdx.x >> 6);
#define tid ((int)threadIdx.x)
#define lane ((int)threadIdx.x & 63)
    const __attribute__((address_space(4))) char* kargp = (const __attribute__((address_space(4))) char*)__builtin_amdgcn_kernarg_segment_ptr();
#define INP(i) (*(const float* const volatile __attribute__((address_space(4)))*)(kargp + 8 * (i)))
#define out (*(float* const volatile __attribute__((address_space(4)))*)(kargp + 320))
#define ws (*(unsigned char* const volatile __attribute__((address_space(4)))*)(kargp + 328))
#define lo (*(const volatile int __attribute__((address_space(4)))*)(kargp + 336))
#define hi (*(const volatile int __attribute__((address_space(4)))*)(kargp + 340))
#define G ((int)gridDim.x)
#define blk ((int)blockIdx.x)
#define vcu ((G % 8 == 0) ? (blk % 8) * (G / 8) + blk / 8 : blk)
#define gw (blk * NWAVE + wave)
#define NGW (G * NWAVE)
#define gtid ((size_t)blk * NTHR + tid)
#define NGT ((size_t)G * NTHR)
#define X (out + O_Y)
#ifndef PHMASK
#define PHMASK 0x1FFF
#endif
#define IN(k) (((PHMASK >> (k)) & 1) && lo <= (k) && (k) < hi)
    volatile LAS unsigned* xst = (volatile LAS unsigned*)(lds + LDS_EPI + 8192);
    if (tid == 0) { xst[0] = 0u; xst[1] = 0u; }
    __syncthreads();
    { XcdBarrier b0 = xcd_barrier_post((unsigned*)(ws + WS_BAR), xst); (void)b0; }
    if (hi > 1000) grid.sync();
#define SEAM(k) do { if (IN(k) && IN((k) + 1)) { XcdBarrier b_; b_.bar = (unsigned*)(ws + WS_BAR); b_.x = xb_xcc_id(); b_.st = xst; xcd_barrier(b_); } } while (0)

    constexpr int I_FFN = 16 * 88, I_W2 = 44 * 32, I_IN = 16 * 53, I_UQ = 6 * 24, I_UKV = 4 * 32, I_SQ = 16 * 32, I_CMVI = 8 * 128;
    constexpr int NITEMS = 4 * I_FFN + 2 * I_W2 + I_IN + I_UQ + I_UKV + 5 * I_SQ + I_CMVI, NA = 2 * I_FFN + 2 * I_SQ;
    auto do_item = [&](int it) {
        LAS float* scr = (LAS float*)(lds + wave * 16384);
        int r = it;
#define TRJ(NI, W, K_, N_, DST, LDD, GAIN, MAP) if (r < (NI)) { const int nb_ = (N_) / 32, kb = r / nb_, n0 = (r % nb_) * 32; tr_item((W), (N_), kb * 64, n0, (DST), (MAP), (LDD), (GAIN), scr, lane); return; } r -= (NI)
        TRJ(I_FFN, INP(I_F1W1), 1024, FF, W13_1, 1024, INP(I_F1N), (n0 >> 7) * 256 + (n0 & 127));
        TRJ(I_FFN, INP(I_F1W3), 1024, FF, W13_1, 1024, INP(I_F1N), (n0 >> 7) * 256 + 128 + (n0 & 127));
        TRJ(I_SQ, INP(I_WMK), 1024, 1024, WMKV, 1024, (const float*)nullptr, n0);
        TRJ(I_SQ, INP(I_WMV), 1024, 1024, WMKV, 1024, (const float*)nullptr, 1024 + n0);
        TRJ(I_W2, INP(I_F1W2), FF, 1024, W2_1, FF, (const float*)nullptr, n0);
        TRJ(I_IN, INP(I_WIN), 1024, 1696, WIN, 1024, INP(I_MIXN), (n0 < 384 ? 256 + n0 : (n0 < 640 ? n0 - 384 : (n0 < 672 ? n0 : n0 + 96))));
        TRJ(I_UQ, INP(I_WUQ), 384, 768, WUQ, 384, INP(I_QN), n0);
        TRJ(I_UKV, INP(I_WUKV), 256, 1024, WK, 256, (const float*)nullptr, ((n0 & 127) < 64 ? (n0 >> 7) * 64 + (n0 & 127) : 512 + (n0 >> 7) * 64 + (n0 & 127) - 64));
        TRJ(I_SQ, INP(I_WOUT), 1024, 1024, WOUT, 1024, (kb < 8 ? INP(I_AON) : (const float*)nullptr), n0);
        TRJ(I_SQ, INP(I_WMQ), 1024, 1024, WMQ, 1024, INP(I_XAN), n0);
        TRJ(I_SQ, INP(I_WMO), 1024, 1024, WMO, 1024, (const float*)nullptr, n0);
        TRJ(I_FFN, INP(I_F2W1), 1024, FF, W13_2, 1024, INP(I_F2N), (n0 >> 7) * 256 + (n0 & 127));
        TRJ(I_FFN, INP(I_F2W3), 1024, FF, W13_2, 1024, INP(I_F2N), (n0 >> 7) * 256 + 128 + (n0 & 127));
        TRJ(I_W2, INP(I_F2W2), FF, 1024, W2_2, FF, (const float*)nullptr, n0);
        { const int bb = r >> 7, rr = r & 127, kb = rr >> 5, n0 = (rr & 31) * 32;
          tr_item(INP(I_CMV) + (size_t)bb * 256 * 1024, 1024, kb * 64, n0, CMVTB + (size_t)bb * 1024 * 256, n0, 256, (const float*)nullptr, scr, lane); }
#undef TRJ
    };
    if (IN(0)) {
        { const int ngw0_ = NGW; const int nfirst = (G == 256) ? NA : NITEMS;
          for (int it = gw; it < nfirst; it += ngw0_) do_item(it); }
        const float* xp_ = INP(I_XP); const float* xs_ = INP(I_XS); const float* mem_ = INP(I_MEM); const float* cmk_ = INP(I_CMK); const float* memn_ = INP(I_MEMN);
        bf16_t* xb_ = XB; bf16_t* memb_ = MEMB; bf16_t* cmkb_ = CMKB; float* ssq0_ = ssq0; const int ngw_ = NGW;
        for (int m = gw; m < MT + 256 + 2048; m += ngw_) {
            const float* src; bf16_t* dst; int kind;
            if (m < TP) { src = xp_ + (size_t)m * DM; dst = xb_ + (size_t)m * DM; kind = 0; }
            else if (m < MT) { src = xs_ + (size_t)(m - TP) * DM; dst = xb_ + (size_t)m * DM; kind = 0; }
            else if (m < MT + 256) { src = mem_ + (size_t)(m - MT) * DM; dst = memb_ + (size_t)(m - MT) * DM; kind = 1; }
            else { src = cmk_ + (size_t)(m - MT - 256) * DM; dst = cmkb_ + (size_t)(m - MT - 256) * DM; kind = 2; }
            f32x4 v[4]; float s = 0.f;
#pragma unroll
            for (int j = 0; j < 4; ++j) { v[j] = *((const f32x4*)src + lane + 64 * j); s += (v[j][0] * v[j][0] + v[j][1] * v[j][1]) + (v[j][2] * v[j][2] + v[j][3] * v[j][3]); }
            if (kind != 2) s = wave_sum(s);
            if (kind == 0 && lane == 0) ssq0_[m] = s;
            if (kind == 1) { const float rs = rsqrtf(s * (1.0f / 1024.0f) + EPS);
#pragma unroll
                for (int j = 0; j < 4; ++j) v[j] = v[j] * rs * *((const f32x4*)memn_ + lane + 64 * j); }
#pragma unroll
            for (int j = 0; j < 4; ++j) *((u32x2*)dst + lane + 64 * j) = (u32x2){pk2(v[j][0], v[j][1]), pk2(v[j][2], v[j][3])};
        }
        { float* z_ = ssq1; u32x4* wz_ = (u32x4*)(WIN + (size_t)672 * 1024); const size_t ngt_ = NGT;
          for (size_t i = gtid; i < (size_t)6 * MT; i += ngt_) z_[i] = 0.f;
          { f32x4* za_ = (f32x4*)ACCB(0); for (size_t i = gtid; i < (size_t)5 * TS * DM / 4; i += ngt_) za_[i] = (f32x4){0.f, 0.f, 0.f, 0.f}; }
          for (size_t i = gtid; i < (size_t)96 * 1024 / 8; i += ngt_) wz_[i] = (u32x4){0, 0, 0, 0}; }
    }
    SEAM(0);

    if (IN(1)) {
        { pg8::Gemm g{XB, W13_1, MT, 2 * FF, 1024, 1024, 1024}; pg8::Order S; S.init(MT, 2 * FF, G, blk, 0); pg8::EpiUp E{HID, ssq0};
          pg8::gemm_phase<pg8::EpiUp, pg8::Order, true, true>(lds, g, S, E); }
        { pg8::Gemm g{MEMB, WMKV, 256, 2048, 1024, 1024, 1024}; pg8::Order S; S.init(256, 2048, G, blk, 144); pg8::EpiMem E{out + O_MKP, out + O_MVP, MKB, MVB};
          pg8::gemm_phase<pg8::EpiMem, pg8::Order, true, true>(lds, g, S, E); }
        if (G == 256 && blk >= 152) { for (int it = NA + (blk - 152) * NWAVE + wave; it < NITEMS; it += (256 - 152) * NWAVE) do_item(it); }
    }
    SEAM(1);
    if (IN(2)) {
        { pg8::Gemm g{HID, W2_1, TP, 1024, FF, FF, FF}; pg8::Order S; S.init(TP, 1024, G, blk, 0);
          pg8::EpiRes E{XB, ssq1, nullptr, 0.f, 0.5f};
          pg8::gemm_phase<pg8::EpiRes, pg8::Order, true, true>(lds, g, S, E); }
        { pg8::Gemm g{HID, W2_1, TS, 1024, 256, FF, FF, 512}; pg8::Order S; S.init(TS, 1024, G, blk, 0, 64, 11);
          pg8::EpiAcc E{ACCB(0), nullptr, 0.f, 0, 0.5f};
          pg8::gemm_phase<pg8::EpiAcc, pg8::Order, true, true>(lds, g, S, E); }
    }
    SEAM(2);
    if (IN(3)) {
        if (blk >= G - 8) sample_finalize_part(blk - (G - 8), INP(I_XS), ACCB(0), XSA, XB + (size_t)TP * DM, ssq1 + TP, FLAGW(0));
        pg8::EpiWin E{ssq1, INP(I_KVN), out, CQ, ssqq, CKVP, CKVS, KPEP, KPES, XBR, GG, (LAS float*)(lds + LDS_EPI)};
        { pg8::Gemm g{XB, WIN, TP, 1792, 1024, 1024, 1024}; pg8::Order S; S.init(TP, 1792, G, blk, 0);
          pg8::gemm_phase<pg8::EpiWin, pg8::Order, true, true>(lds, g, S, E); }
        { pg8::Gemm g{XB, WIN, TS, 1792, 1024, 1024, 1024}; pg8::Order S; S.init(TS, 1792, G, blk, 192, 64); pg8::Unit u_;
          if (S.next(0, u_)) sample_wait(FLAGW(0), 8u);
          pg8::gemm_phase<pg8::EpiWin, pg8::Order, true, true>(lds, g, S, E); }
        if (G != 256 || blk >= 200) {
        { const f32x4* cckv_ = (const f32x4*)INP(I_CCKV); const f32x4* ckpe_ = (const f32x4*)INP(I_CKPE); bf16_t* ckvs_ = CKVS; bf16_t* kpes_ = KPES; bf16_t* mvtb_ = MVTB; const bf16_t* mvb_ = MVB; const bool idl_ = (G == 256); const size_t ngt_ = idl_ ? (size_t)(256 - 200) * NTHR : NGT; const size_t g0_ = idl_ ? (size_t)(blk - 200) * NTHR + tid : gtid;
          for (size_t i = g0_; i < (size_t)NBAT * PAST * 64; i += ngt_) { const size_t rw = i >> 6; const int c4 = (int)(i & 63); const int b = (int)(rw / PAST), t = (int)(rw % PAST);
              const f32x4 v = cckv_[i]; *(u32x2*)(ckvs_ + ((size_t)b * SKV + t) * 256 + c4 * 4) = (u32x2){pk2(v[0], v[1]), pk2(v[2], v[3])}; }
          for (size_t i = g0_; i < (size_t)NBAT * PAST * 8; i += ngt_) { const size_t rw = i >> 3; const int c4 = (int)(i & 7); const int b = (int)(rw / PAST), t = (int)(rw % PAST);
              const f32x4 v = ckpe_[i]; *(u32x2*)(kpes_ + ((size_t)b * SKV + t) * 32 + c4 * 4) = (u32x2){pk2(v[0], v[1]), pk2(v[2], v[3])}; }
          for (size_t i = g0_; i < (size_t)1024 * 256; i += ngt_) { const int d = (int)(i >> 8), k = (int)(i & 255); mvtb_[i] = mvb_[(size_t)k * DM + d]; } }
        }
    }
    SEAM(3);
    if (IN(4)) {
        { pg8::Gemm g{CQ, WUQ, MT, 768, QL, QL, QL}; pg8::Order S; S.init(MT, 768, G, blk, 0); pg8::EpiQ E{Q, ssqq};
          pg8::gemm_phase<pg8::EpiQ, pg8::Order, true, true>(lds, g, S, E); }
        { pg8::Gemm g{CKVP, WK, TP + MT, 512, 256, 256, 256}; pg8::Order S; S.init(TP + MT, 512, G, blk, 192); pg8::EpiStore E{KNP, 512, nullptr, 0.f, 1.f};
          pg8::gemm_phase<pg8::EpiStore, pg8::Order, true, true>(lds, g, S, E); }
        { pg8::Gemm g{WV, CKVP, 512, TP + MT, 256, 256, 256}; pg8::Order S; S.init(512, TP + MT, G, blk, 192); pg8::EpiStore E{VTP, VT_LD, nullptr, 0.f, 1.f};
          pg8::gemm_phase<pg8::EpiStore, pg8::Order, true, true>(lds, g, S, E); }
        const LruArgs LA{XBR, INP(I_CONVW), INP(I_CONVB), INP(I_LWA), INP(I_LBA), INP(I_LWX), INP(I_LBX), INP(I_LAM), INP(I_SCONV), INP(I_SLRU), HLOC, ACUM, ATOT, BTOT, out};
        { const int g_ = G; for (int u = (blk + g_ - (199 % g_)) % g_; u < 256; u += g_) lru_l1_unit(lds, u, LA); }
    }
    SEAM(4);
    if (IN(5)) {
        const int g_ = G; bf16_t* merged_ = MERGED; float* ssqa_ = ssqa; float* out_ = out;
        { const bf16_t* hloc_ = HLOC; const bf16_t* acum_ = ACUM; const bf16_t* gg_ = GG; const float* atot_ = ATOT; const float* btot_ = BTOT; const float* lon_ = INP(I_LON);
          for (int u = blk; u < 256; u += g_) lru_l3_unit(lds, u, hloc_, acum_, gg_, atot_, btot_, lon_, merged_, out_);
          const LruArgs LA{XBR, INP(I_CONVW), INP(I_CONVB), INP(I_LWA), INP(I_LBA), INP(I_LWX), INP(I_LBX), INP(I_LAM), INP(I_SCONV), INP(I_SLRU), HLOC, ACUM, ATOT, BTOT, out};
          for (int u = (blk + g_ - (128 % g_)) % g_; u < 8; u += g_) { lru_l1_unit(lds, 256 + u, LA); asm volatile("s_waitcnt vmcnt(0)" ::: "memory"); __syncthreads();
              lru_l3_unit(lds, 256 + u, hloc_, acum_, gg_, atot_, btot_, lon_, merged_, out_); } }
        { const bf16_t* q_ = Q; const bf16_t* knp_ = KNP; const bf16_t* kpep_ = KPEP; const bf16_t* vtp_ = VTP;
          for (int p = vcu; p < 256; p += g_) {
              const int h = p >> 5, s = p & 31;
              mla_prompt_unit(lds, h, 63 - s, q_, knp_, kpep_, vtp_, merged_, ssqa_);
              mla_prompt_unit(lds, h, s, q_, knp_, kpep_, vtp_, merged_, ssqa_);
          }
          const bf16_t* kns_ = KNS; const bf16_t* kpes_ = KPES; const bf16_t* vts_ = VTS;
          for (int u = blk; u < 64; u += g_) mla_sample_unit(lds, u >> 3, u & 7, q_, kns_, kpes_, vts_, merged_, ssqa_); }
    }
    SEAM(5);
    if (IN(6)) {
        { pg8::Gemm g{MERGED, WOUT, TP, 1024, 1024, 1024, 1024}; pg8::Order S; S.init(TP, 1024, G, blk, 0);
          pg8::EpiResMid E{{XB, ssq2, nullptr, 0.f, 1.f}, ssqa};
          pg8::gemm_phase<pg8::EpiResMid, pg8::Order, true, true>(lds, g, S, E); }
        { pg8::Gemm g{MERGED, WOUT, TS, 1024, 256, 1024, 1024, 512}; pg8::Order Ss; Ss.init(TS, 1024, G, blk, 0, 64, 4);
          pg8::EpiAcc E{ACCB(1), ssqa, 1.0f / 512.0f, 2, 1.f};
          pg8::gemm_phase<pg8::EpiAcc, pg8::Order, true, true>(lds, g, Ss, E); }
    }
    SEAM(6);
    if (IN(7)) {
        if (blk >= G - 8) sample_finalize_part(blk - (G - 8), XSA, ACCB(1), XSB, XB + (size_t)TP * DM, ssq2 + TP, FLAGW(1));
        { pg8::Gemm g{XB, WMQ, TP, 1024, 1024, 1024, 1024}; pg8::Order S; S.init(TP, 1024, G, blk, 0); pg8::EpiStore E{QM, 1024, ssq2, 1.0f / 1024.0f, XSCALE};
          pg8::gemm_phase<pg8::EpiStore, pg8::Order, true, true>(lds, g, S, E);
          asm volatile("s_waitcnt vmcnt(0)" ::: "memory"); __syncthreads();
          bf16_t* qm_ = QM; const bf16_t* mkb_ = MKB; const bf16_t* mvtb_ = MVTB; pg8::Unit u_;
          for (int i = 0; S.next(i, u_); ++i) xattn_unit(lds, u_.pm * 256, false, u_.pn, qm_, mkb_, mvtb_, nullptr, nullptr); }
        { pg8::Gemm g{XB, WMQ, TS, 1024, 256, 1024, 1024, 512}; pg8::Order S; S.init(TS, 1024, G, blk, 0, 64, 4); pg8::Unit u_;
          if (S.next(0, u_)) sample_wait(FLAGW(1), 8u);
          pg8::EpiAcc E{ACCB(2), nullptr, 0.f, 0, 1.f};
          pg8::gemm_phase<pg8::EpiAcc, pg8::Order, true, true>(lds, g, S, E); }
    }
    SEAM(7);
    if (IN(9)) {
        { const int g_ = G; bf16_t* qm_ = QM; const bf16_t* cmkb_ = CMKB; const bf16_t* cmvtb_ = CMVTB; const float* qacc_ = ACCB(2); const float* ssq2_ = ssq2;
          for (int u = g_ - 1 - blk; u < 32; u += g_) { const int b = u >> 2;
              xattn_unit(lds, TP + b * 32, true, u & 3, qm_, cmkb_ + (size_t)b * 256 * DM, cmvtb_ + (size_t)b * 1024 * 256, qacc_, ssq2_);
              asm volatile("s_waitcnt vmcnt(0)" ::: "memory"); __syncthreads();
              if (tid == 0) { __builtin_amdgcn_fence(__ATOMIC_RELEASE, "agent"); asm volatile("s_waitcnt vmcnt(0)" ::: "memory"); __hip_atomic_fetch_add(FLAGW(3), 1u, __ATOMIC_RELAXED, __HIP_MEMORY_SCOPE_AGENT); } } }
        { pg8::Gemm g{QM, WMO, TP, 1024, 1024, 1024, 1024}; pg8::Order S; S.init(TP, 1024, G, blk, 0);
          pg8::EpiRes E{XB, ssq3, nullptr, 0.f, 1.f};
          pg8::gemm_phase<pg8::EpiRes, pg8::Order, true, true>(lds, g, S, E); }
        { pg8::Gemm g{QM, WMO, TS, 1024, 256, 1024, 1024, 512}; pg8::Order S; S.init(TS, 1024, G, blk, 0, 64, 4); pg8::Unit u_;
          if (S.next(0, u_)) sample_wait(FLAGW(3), 32u);
          pg8::EpiAcc E{ACCB(3), nullptr, 0.f, 0, 1.f};
          pg8::gemm_phase<pg8::EpiAcc, pg8::Order, true, true>(lds, g, S, E); }
    }
    SEAM(9);
    if (IN(10)) {
        if (blk >= G - 8) sample_finalize_part(blk - (G - 8), XSB, ACCB(3), XSA, XB + (size_t)TP * DM, ssq3 + TP, FLAGW(2));
        pg8::EpiUp E{HID, ssq3};
        { pg8::Gemm g{XB, W13_2, TP, 2 * FF, 1024, 1024, 1024}; pg8::Order S; S.init(TP, 2 * FF, G, blk, 0);
          pg8::gemm_phase<pg8::EpiUp, pg8::Order, true, true>(lds, g, S, E); }
        { pg8::Gemm g{XB, W13_2, TS, 2 * FF, 1024, 1024, 1024}; pg8::Order S; S.init(TS, 2 * FF, G, blk, 128, 64); pg8::Unit u_;
          if (S.next(0, u_)) sample_wait(FLAGW(2), 8u);
          pg8::gemm_phase<pg8::EpiUp, pg8::Order, true, true>(lds, g, S, E); }
    }
    SEAM(10);
    if (IN(11)) {
        { pg8::Gemm g{HID, W2_2, TP, 1024, FF, FF, FF}; pg8::Order S; S.init(TP, 1024, G, blk, 0);
          pg8::EpiRes E{XB, ssq4, nullptr, 0.f, 0.5f};
          pg8::gemm_phase<pg8::EpiRes, pg8::Order, true, true>(lds, g, S, E); }
        { pg8::Gemm g{HID, W2_2, TS, 1024, 256, FF, FF, 512}; pg8::Order S; S.init(TS, 1024, G, blk, 0, 64, 11);
          pg8::EpiAcc E{ACCB(4), nullptr, 0.f, 0, 0.5f};
          pg8::gemm_phase<pg8::EpiAcc, pg8::Order, true, true>(lds, g, S, E); }
    }
    SEAM(11);
    if (IN(12)) {
        float* x_ = X; const float* s4_ = ssq4; const f32x4* fn_ = (const f32x4*)INP(I_FINN); const int ngw_ = NGW; const float* xs_ = XSA; const float* acc_ = ACCB(4); const bf16_t* xb12_ = XB;
        for (int m = gw; m < MT; m += ngw_) {
            f32x4* xr = (f32x4*)(x_ + (size_t)m * DM);
            if (m < TP) {
                const float rs = rsqrtf(s4_[m] * (1.0f / 1024.0f) + EPS);
                const u32x2* xbr = (const u32x2*)(xb12_ + (size_t)m * DM);
#pragma unroll
                for (int j = 0; j < 4; ++j) { const u32x2 b = xbr[lane + 64 * j]; const f32x4 v = (f32x4){__builtin_bit_cast(float, b[0] << 16), __builtin_bit_cast(float, b[0] & 0xffff0000u), __builtin_bit_cast(float, b[1] << 16), __builtin_bit_cast(float, b[1] & 0xffff0000u)};
                    xr[lane + 64 * j] = v * rs * fn_[lane + 64 * j]; }
            } else {
                const size_t r = (size_t)(m - TP) * DM; f32x4 v[4]; float s = 0.f;
#pragma unroll
                for (int j = 0; j < 4; ++j) { v[j] = *((const f32x4*)(xs_ + r) + lane + 64 * j) + *((const f32x4*)(acc_ + r) + lane + 64 * j);
                    s += (v[j][0] * v[j][0] + v[j][1] * v[j][1]) + (v[j][2] * v[j][2] + v[j][3] * v[j][3]); }
                const float rs = rsqrtf(wave_sum(s) * (1.0f / 1024.0f) + EPS);
#pragma unroll
                for (int j = 0; j < 4; ++j) xr[lane + 64 * j] = v[j] * rs * fn_[lane + 64 * j];
            }
        }
    }
#undef IN
#undef SEAM
}

#undef INP
#undef X
#undef tid
#undef lane
#undef out
#undef ws
#undef lo
#undef hi
#undef G
#undef blk
#undef vcu
#undef gw
#undef NGW
#undef gtid
#undef NGT
#ifndef MK_N_LAUNCHES
#define MK_N_LAUNCHES 1
#endif
extern "C" void kernel_launch(void* const* d_in, const int* in_sizes, int n_in, void* d_out, int out_size, void* d_ws, size_t ws_size, hipStream_t stream) {
    static int grid = 0;
    if (grid == 0) {
        int dev = 0, cus = 0, per_cu = 0;
        hipGetDevice(&dev);
        hipDeviceGetAttribute(&cus, hipDeviceAttributeMultiprocessorCount, dev);
        if (hipFuncSetAttribute((const void*)mk_fwd, hipFuncAttributeMaxDynamicSharedMemorySize, LDS_BYTES) != hipSuccess) fprintf(stderr, "kernel_launch: hipFuncSetAttribute failed\n");
        if (hipOccupancyMaxActiveBlocksPerMultiprocessor(&per_cu, (const void*)mk_fwd, NTHR, LDS_BYTES) != hipSuccess || per_cu < 1) { fprintf(stderr, "kernel_launch: occupancy query gave %d\n", per_cu); per_cu = 1; }
        (void)hipGetLastError();
        grid = cus * per_cu;
        if (n_in != 40 || ws_size < WS_END) { fprintf(stderr, "kernel_launch: unexpected n_in %d / ws %zu\n", n_in, ws_size); }
    }
    (void)hipMemsetAsync((unsigned char*)d_ws + WS_BAR, 0, 16384, stream);
    Args a{};
    for (int i = 0; i < 40; ++i) a.in[i] = (const float*)d_in[i];
    a.out = (float*)d_out; a.ws = (unsigned char*)d_ws;
#if MK_N_LAUNCHES == 1
    a.ph_lo = 0; a.ph_hi = NPHASE;
    void* args[] = {&a};
    hipError_t e = hipLaunchCooperativeKernel((const void*)mk_fwd, dim3(grid), dim3(NTHR), args, LDS_BYTES, stream);
    if (e != hipSuccess) fprintf(stderr, "kernel_launch: cooperative launch failed: %s (grid %d)\n", hipGetErrorString(e), grid);
#else
    for (int p = 0; p < NPHASE; ++p) { a.ph_lo = p; a.ph_hi = p + 1; hipLaunchKernelGGL(mk_fwd, dim3(grid), dim3(NTHR), LDS_BYTES, stream, a); }
#endif
}
```

```cpp
#include <hip/hip_runtime.h>
#include <hip/hip_cooperative_groups.h>
#include <cstdio>
#include <cstdint>
namespace cg = cooperative_groups;

#define LAS __attribute__((address_space(3)))
typedef unsigned short bf16_t;
typedef short bf16x8 __attribute__((ext_vector_type(8)));
typedef short s16x4 __attribute__((ext_vector_type(4)));
typedef float f32x4 __attribute__((ext_vector_type(4)));
typedef float f32x16 __attribute__((ext_vector_type(16)));
typedef unsigned u32x4 __attribute__((ext_vector_type(4)));
typedef unsigned u32x2 __attribute__((ext_vector_type(2)));

constexpr int TP = 16384, TS = 256, MT = TP + TS, DM = 1024, FF = 2816, QL = 384, KVL = 256, NBAT = 8, DSEQ = 32, PAST = 2048, SKV = PAST + DSEQ  ;
constexpr int VT_LD = 33152;
constexpr int VTS_LD = VT_LD;
constexpr float EPS = 1e-6f;
constexpr float LOG2E = 1.4426950408889634f;
constexpr float QSCALE = 0.10206207261596575f * LOG2E;
constexpr float XSCALE = 0.0625f * LOG2E;
constexpr int NTHR = 512, NWAVE = 8;
constexpr int LDS_BYTES = 147456;
constexpr int LDS_EPI = 131072;

constexpr size_t O_Y = 0, O_YS = 16777216, O_CKVP = 17039360, O_KPEP = 21233664, O_CONVP = 21757952, O_LRUP = 21759488,
                 O_MKP = 21760000, O_MVP = 22022144, O_CKVS = 22284288, O_KPES = 22349824, O_CONVS = 22358016, O_LRUS = 22370304;

constexpr size_t U64K = 65536;
constexpr size_t WS_SSQ = 0;
constexpr size_t WS_BAR = 466944;
constexpr size_t WS_ATOT = 16 * U64K, WS_BTOT = 32 * U64K;
constexpr size_t WS_W13_1 = 64 * U64K;
constexpr size_t WS_W2_1 = WS_W13_1 + 176 * U64K;
constexpr size_t WS_W13_2 = WS_W2_1 + 88 * U64K;
constexpr size_t WS_W2_2 = WS_W13_2 + 176 * U64K;
constexpr size_t WS_WIN = WS_W2_2 + 88 * U64K;
constexpr size_t WS_WUQ = WS_WIN + 56 * U64K;
constexpr size_t WS_WK = WS_WUQ + 9 * U64K;
constexpr size_t WS_WV = WS_WK + 4 * U64K;
constexpr size_t WS_WOUT = WS_WV + 4 * U64K;
constexpr size_t WS_WMQ = WS_WOUT + 32 * U64K;
constexpr size_t WS_WMKV = WS_WMQ + 32 * U64K;
constexpr size_t WS_WMO = WS_WMKV + 64 * U64K;
constexpr size_t WS_MEMB = 52 * 16 * U64K;
constexpr size_t WS_MKB = WS_MEMB + 8 * U64K, WS_MVTB = WS_MKB + 8 * U64K, WS_MVB = WS_MVTB + 8 * U64K, WS_CMKB = WS_MVB + 8 * U64K, WS_CMVTB = WS_CMKB + 64 * U64K;
constexpr size_t WS_XB = 62 * 16 * U64K;
constexpr size_t WS_HLOC = WS_XB, WS_ACUM = WS_XB + 260 * U64K;
constexpr size_t WS_R = 95 * 16 * U64K;
constexpr size_t WS_HID = WS_R;
constexpr size_t WS_CQ = WS_R;
constexpr size_t WS_CKVP = WS_CQ + 195 * U64K;
constexpr size_t WS_CKVS = WS_CKVP + 128 * U64K;
constexpr size_t WS_XBR = WS_CKVS + 130 * U64K;
constexpr size_t WS_MERGED = WS_R;
constexpr size_t WS_GG = WS_R + 720 * U64K;
constexpr size_t WS_Q = WS_GG + 260 * U64K;
constexpr size_t WS_KNP = WS_Q + 390 * U64K;
constexpr size_t WS_KNS = WS_KNP + 256 * U64K;
constexpr size_t WS_VTP = WS_KNS + 261 * U64K;
constexpr size_t WS_VTS = WS_VTP + 256 * U64K;
constexpr size_t WS_KPEP = WS_VTS + 262 * U64K;
constexpr size_t WS_KPES = WS_KPEP + 16 * U64K;
constexpr size_t WS_QM = WS_R + 768 * U64K;
constexpr size_t WS_END = WS_KPES + 17 * U64K;
constexpr size_t WS_ACC = 248 * 16 * U64K;
constexpr size_t WS_XSA = 253 * 16 * U64K, WS_XSB = 254 * 16 * U64K;
static_assert(WS_WMO + 32 * U64K <= WS_MEMB && WS_CMVTB + 64 * U64K <= WS_XB && WS_XB + 520 * U64K <= WS_R, "ws map 1");
static_assert(WS_XBR + 260 * U64K <= WS_GG && WS_END <= WS_ACC && WS_HID + (size_t)MT * FF * 2 <= 256u * 16 * U64K, "ws map 2");

__device__ __forceinline__ unsigned f2bf(float f) { unsigned u = __builtin_bit_cast(unsigned, f); return (u + 0x7fffu + ((u >> 16) & 1u)) >> 16; }
__device__ __forceinline__ unsigned pk2(float lo, float hi) { unsigned r; asm volatile("v_cvt_pk_bf16_f32 %0, %1, %2" : "=v"(r) : "v"(lo), "v"(hi)); return r; }
__device__ __forceinline__ float bf2f(unsigned short b) { return __builtin_bit_cast(float, (unsigned)b << 16); }
__device__ __forceinline__ float wave_sum(float v) {
#pragma unroll
    for (int o = 1; o < 64; o <<= 1) v += __shfl_xor(v, o);
    return v;
}
__device__ __forceinline__ void atomic_addf(float* p, float v) { __hip_atomic_fetch_add(p, v, __ATOMIC_RELAXED, __HIP_MEMORY_SCOPE_AGENT); }
__device__ __forceinline__ float sigmoidf_(float x) { return 1.f / (1.f + __expf(-x)); }
__device__ __forceinline__ float gelu_tanh(float v) { const float u = 1.5957691216057308f * (v + 0.044715f * v * v * v); return v * __builtin_amdgcn_rcpf(1.f + __builtin_amdgcn_exp2f(-LOG2E * u)); }
__device__ __forceinline__ void rope_cs(int pos, int j, float& c, float& s) {
    const float inv = __builtin_amdgcn_exp2f(-0.8304820237218406f * (float)j);
    const float ang = (float)pos * inv;
    const float k = rintf(ang * 0.15915494309189535f);
    float r = fmaf(-k, 6.28125f, ang); r = fmaf(-k, 0.0019353071795864769f, r);
    c = __cosf(r); s = __sinf(r);
}
namespace pg8 {
#define PG8_LAS __attribute__((address_space(3)))
typedef unsigned short bf16_t;
typedef short bf16x8 __attribute__((ext_vector_type(8)));
typedef float f32x4 __attribute__((ext_vector_type(4)));
typedef unsigned u32x4 __attribute__((ext_vector_type(4)));
constexpr int BM = 256, BK = 64, HALF = 128, HTB = HALF * BK * 2  , STAGE_BYTES = 8 * HTB, NXCD = 8, WGM = 8;

__host__ __device__ __forceinline__ int lds_byte(int r, int c) { const int st = (r >> 4) * 2 + (c >> 5), rr = r & 15, cc = c & 31, ob = rr * 64 + cc * 2; return st * 1024 + (ob ^ (((ob >> 9) & 1) << 5)); }
__host__ __device__ __forceinline__ void stage_rc(int b, int& R, int& C) { const int st = b / 1024, sb = b % 1024, swz = sb ^ (((sb >> 9) & 1) << 5); R = (st >> 1) * 16 + swz / 64; C = (st & 1) * 32 + (swz % 64) / 2; }
__host__ __device__ __forceinline__ int perm32(int rho) { const int n = rho >> 4, i = rho & 15; return 8 * (i >> 2) + 4 * n + (i & 3); }

struct Unit { int pm, pn, kc; };
struct Gemm { const bf16_t* A; const bf16_t* Bt; int M, N, K, lda, ldb, kcb; };

struct StaticOrder {
    int nM, nN, nwg, G, c;
    __host__ __device__ void init(int M, int N, int G_, int c_) { nM = M / BM; nN = N / BM; nwg = nM * nN; G = G_; c = c_; }
    __host__ __device__ bool next(int i, Unit& u) const {
        const long L = (long)i * G + c; if (L >= nwg) return false;
        int wgid = (int)L; { const int q = nwg / NXCD, r = nwg % NXCD, xcd = wgid % NXCD, off = wgid / NXCD; wgid = (xcd < r ? xcd * (q + 1) : r * (q + 1) + (xcd - r) * q) + off; }
        const int nig = WGM * nN, gid = wgid / nig, fm = gid * WGM, gsz = (nM - fm) < WGM ? (nM - fm) : WGM;
        u.pm = fm + ((wgid % nig) % gsz); u.pn = (wgid % nig) / gsz; u.kc = 0; return true;
    }
    __device__ __forceinline__ void a_ready(const Unit&) const {}
    __device__ __forceinline__ void done(const Unit&) const {}
};

__device__ __forceinline__ unsigned cvt_pk_bf16(float lo, float hi) { unsigned r; asm volatile("v_cvt_pk_bf16_f32 %0, %1, %2" : "=v"(r) : "v"(lo), "v"(hi)); return r; }

struct Order {
    int nM, nN, nK, nwg, G, c, pmo;
    __device__ __forceinline__ void init(int M, int N, int G_, int blk, int rot, int pm_off = 0, int nK_ = 1) { nM = M / BM; nN = N / BM; nK = nK_; nwg = nM * nN * nK_; G = G_; c = (blk + G_ - (rot % G_)) % G_; pmo = pm_off; }
    __device__ __forceinline__ bool next(int i, Unit& u) const {
        const long L = (long)i * G + c; if (L >= nwg) return false;
        int wgid = (int)L; { const int q = nwg / NXCD, r = nwg % NXCD, xcd = wgid % NXCD, off = wgid / NXCD; wgid = (xcd < r ? xcd * (q + 1) : r * (q + 1) + (xcd - r) * q) + off; }
        u.kc = wgid % nK; wgid /= nK;
        const int nig = WGM * nN, gid = wgid / nig, fm = gid * WGM, gsz = (nM - fm) < WGM ? (nM - fm) : WGM;
        u.pm = pmo + fm + ((wgid % nig) % gsz); u.pn = (wgid % nig) / gsz; return true;
    }
    __device__ __forceinline__ void a_ready(const Unit&) const {}
    __device__ __forceinline__ void done(const Unit&) const {}
};

struct EpiAcc {
    static constexpr bool PERM = false, AFTER_DRAIN = false, MIDSCALE = false;
    float* ACC; const float* rs_in; float rs_invn; int kc_lim; float alpha;
    __device__ __forceinline__ void operator()(const f32x4 (&acc)[2][2][4][2], const Unit& u, int wr, int wc, int fr, int fq) const {
        const int col0 = u.pn * BM + wc * 32 + 4 * fq;
#pragma unroll
        for (int ai = 0; ai < 2; ++ai)
#pragma unroll
            for (int m = 0; m < 4; ++m) {
                const int rl = ai * HALF + wr * 64 + m * 16 + fr;
                float sc = alpha; if (rs_in && u.kc < kc_lim) sc *= __builtin_amdgcn_rsqf(rs_in[TP + rl] * rs_invn + EPS);
#pragma unroll
                for (int bj = 0; bj < 2; ++bj)
#pragma unroll
                    for (int n = 0; n < 2; ++n) {
                        float* p = ACC + (size_t)rl * DM + col0 + bj * HALF + n * 16; const f32x4 v = acc[ai][bj][m][n] * sc;
                        atomic_addf(p, v[0]); atomic_addf(p + 1, v[1]); atomic_addf(p + 2, v[2]); atomic_addf(p + 3, v[3]);
                    }
            }
    }
};

struct EpiUp {
    static constexpr bool PERM = true, AFTER_DRAIN = false, MIDSCALE = false;
    bf16_t* H; const float* ssq;
    __device__ __forceinline__ void operator()(const f32x4 (&acc)[2][2][4][2], const Unit& u, int wr, int wc, int fr, int fq) const {
        const int col = u.pn * 128 + wc * 32 + 8 * fq;
#pragma unroll
        for (int ai = 0; ai < 2; ++ai)
#pragma unroll
            for (int m = 0; m < 4; ++m) {
                const int row = u.pm * BM + ai * HALF + wr * 64 + m * 16 + fr;
                const float r = __builtin_amdgcn_rsqf(ssq[row] * (1.0f / 1024.0f) + EPS);
                unsigned w[4];
#pragma unroll
                for (int n = 0; n < 2; ++n) {
                    const f32x4 g = acc[ai][0][m][n] * r, uu = acc[ai][1][m][n] * r; float v[4];
#pragma unroll
                    for (int i = 0; i < 4; ++i) v[i] = g[i] * uu[i] * __builtin_amdgcn_rcpf(1.f + __builtin_amdgcn_exp2f(-LOG2E * g[i]));
                    w[2 * n] = cvt_pk_bf16(v[0], v[1]); w[2 * n + 1] = cvt_pk_bf16(v[2], v[3]);
                }
                *(u32x4*)(H + (size_t)row * FF + col) = (u32x4){w[0], w[1], w[2], w[3]};
            }
    }
};

struct EpiRes {
    static constexpr bool PERM = true, AFTER_DRAIN = false, MIDSCALE = false;
    bf16_t* XB; float* ssq_out; const float* rs_in; float rs_invn; float alpha;
    __device__ __forceinline__ void operator()(const f32x4 (&acc)[2][2][4][2], const Unit& u, int wr, int wc, int fr, int fq) const {
        const int col0 = u.pn * BM + wc * 32 + 8 * fq;
#pragma unroll
        for (int ai = 0; ai < 2; ++ai)
#pragma unroll
            for (int m = 0; m < 4; ++m) {
                const int row = u.pm * BM + ai * HALF + wr * 64 + m * 16 + fr;
                float sc = alpha; if (rs_in) sc *= __builtin_amdgcn_rsqf(rs_in[row] * rs_invn + EPS);
                float sq = 0.f;
#pragma unroll
                for (int bj = 0; bj < 2; ++bj) {
                    bf16_t* p = XB + (size_t)row * DM + col0 + bj * HALF;
                    const u32x4 b = *(const u32x4*)p; float o[8];
#pragma unroll
                    for (int k = 0; k < 4; ++k) { o[2 * k] = __builtin_bit_cast(float, b[k] << 16); o[2 * k + 1] = __builtin_bit_cast(float, b[k] & 0xffff0000u); }
#pragma unroll
                    for (int k = 0; k < 4; ++k) { o[k] += acc[ai][bj][m][0][k] * sc; o[4 + k] += acc[ai][bj][m][1][k] * sc; }
#pragma unroll
                    for (int k = 0; k < 8; ++k) sq += o[k] * o[k];
                    *(u32x4*)p = (u32x4){cvt_pk_bf16(o[0], o[1]), cvt_pk_bf16(o[2], o[3]), cvt_pk_bf16(o[4], o[5]), cvt_pk_bf16(o[6], o[7])};
                }
                if (ssq_out) { sq += __shfl_xor(sq, 16); sq += __shfl_xor(sq, 32); if (fq == 0) atomic_addf(ssq_out + row, sq); }
            }
    }
};

struct EpiResMid : EpiRes {
    static constexpr bool MIDSCALE = true;
    const float* ssqa;
    __device__ __forceinline__ void midscale(f32x4 (&acc)[2][2][4][2], const Unit& u, int wr, int fr) const {
#pragma unroll
        for (int ai = 0; ai < 2; ++ai)
#pragma unroll
            for (int m = 0; m < 4; ++m) {
                const float f = __builtin_amdgcn_rsqf(ssqa[u.pm * BM + ai * HALF + wr * 64 + m * 16 + fr] * (1.0f / 512.0f) + EPS);
#pragma unroll
                for (int bj = 0; bj < 2; ++bj)
#pragma unroll
                    for (int n = 0; n < 2; ++n) acc[ai][bj][m][n] *= f;
            }
    }
};

struct EpiStore {
    static constexpr bool PERM = true, AFTER_DRAIN = false, MIDSCALE = false;
    bf16_t* O; int ldc; const float* rs_in; float rs_invn; float scale;
    __device__ __forceinline__ void operator()(const f32x4 (&acc)[2][2][4][2], const Unit& u, int wr, int wc, int fr, int fq) const {
        const int col0 = u.pn * BM + wc * 32 + 8 * fq;
#pragma unroll
        for (int ai = 0; ai < 2; ++ai)
#pragma unroll
            for (int m = 0; m < 4; ++m) {
                const int row = u.pm * BM + ai * HALF + wr * 64 + m * 16 + fr;
                float sc = scale; if (rs_in) sc *= __builtin_amdgcn_rsqf(rs_in[row] * rs_invn + EPS);
#pragma unroll
                for (int bj = 0; bj < 2; ++bj) {
                    const f32x4 v0 = acc[ai][bj][m][0] * sc, v1 = acc[ai][bj][m][1] * sc;
                    *(u32x4*)(O + (size_t)row * ldc + col0 + bj * HALF) = (u32x4){cvt_pk_bf16(v0[0], v0[1]), cvt_pk_bf16(v0[2], v0[3]), cvt_pk_bf16(v1[0], v1[1]), cvt_pk_bf16(v1[2], v1[3])};
                }
            }
    }
};

struct EpiMem {
    static constexpr bool PERM = false, AFTER_DRAIN = false, MIDSCALE = false;
    float* outk; float* outv; bf16_t* KB; bf16_t* VB;
    __device__ __forceinline__ void operator()(const f32x4 (&acc)[2][2][4][2], const Unit& u, int wr, int wc, int fr, int fq) const {
        const bool isv = u.pn >= 4; const int col0 = (u.pn & 3) * BM + wc * 32 + 4 * fq;
        float* of = isv ? outv : outk; bf16_t* ob = isv ? VB : KB;
#pragma unroll
        for (int ai = 0; ai < 2; ++ai)
#pragma unroll
            for (int m = 0; m < 4; ++m) {
                const int row = ai * HALF + wr * 64 + m * 16 + fr;
#pragma unroll
                for (int bj = 0; bj < 2; ++bj)
#pragma unroll
                    for (int n = 0; n < 2; ++n) {
                        const int col = col0 + bj * HALF + n * 16; const f32x4 o = acc[ai][bj][m][n];
                        *(f32x4*)(of + (size_t)row * DM + col) = o;
                        *(u32x2*)(ob + (size_t)row * DM + col) = (u32x2){cvt_pk_bf16(o[0], o[1]), cvt_pk_bf16(o[2], o[3])};
                    }
            }
    }
};

struct EpiQ {
    static constexpr bool PERM = false, AFTER_DRAIN = false, MIDSCALE = false;
    bf16_t* Q; const float* ssqq;
    __device__ __forceinline__ void operator()(const f32x4 (&acc)[2][2][4][2], const Unit& u, int wr, int wc, int fr, int fq) const {
#pragma unroll
        for (int ai = 0; ai < 2; ++ai)
#pragma unroll
            for (int m = 0; m < 4; ++m) {
                const int row = u.pm * BM + ai * HALF + wr * 64 + m * 16 + fr;
                const float sc = QSCALE * __builtin_amdgcn_rsqf(ssqq[row] * (1.0f / 384.0f) + EPS);
                const int pos = row < TP ? row : PAST + ((row - TP) & 31);
#pragma unroll
                for (int bj = 0; bj < 2; ++bj) {
                    const int gidx = u.pn * 8 + bj * 4 + wc; const int c0 = gidx * 32 + 4 * fq;
                    f32x4 v0 = acc[ai][bj][m][0] * sc, v1 = acc[ai][bj][m][1] * sc;
                    if (gidx % 3 == 2) {
#pragma unroll
                        for (int i = 0; i < 4; ++i) { float c, s; rope_cs(pos, 4 * fq + i, c, s); const float a = v0[i], b = v1[i]; v0[i] = a * c - b * s; v1[i] = b * c + a * s; }
                    }
                    *(u32x2*)(Q + (size_t)row * 768 + c0) = (u32x2){cvt_pk_bf16(v0[0], v0[1]), cvt_pk_bf16(v0[2], v0[3])};
                    *(u32x2*)(Q + (size_t)row * 768 + c0 + 16) = (u32x2){cvt_pk_bf16(v1[0], v1[1]), cvt_pk_bf16(v1[2], v1[3])};
                }
            }
    }
};

struct EpiWin {
    static constexpr bool PERM = false, AFTER_DRAIN = false, MIDSCALE = false;
    const float* ssq1; const float* kvg; float* out; bf16_t* CQ; float* ssqq; bf16_t* CKVP; bf16_t* CKVS; bf16_t* KPEP; bf16_t* KPES; bf16_t* XBR; bf16_t* GG; LAS float* P;
    __device__ __forceinline__ void operator()(const f32x4 (&acc)[2][2][4][2], const Unit& u, int wr, int wc, int fr, int fq) const {
        const int pn = u.pn;
        if (pn == 0) {
#pragma unroll
            for (int ai = 0; ai < 2; ++ai)
#pragma unroll
                for (int m = 0; m < 4; ++m) {
                    const int row = u.pm * BM + ai * HALF + wr * 64 + m * 16 + fr;
                    const float r = __builtin_amdgcn_rsqf(ssq1[row] * (1.0f / 1024.0f) + EPS);
                    float sq = 0.f;
#pragma unroll
                    for (int bj = 0; bj < 2; ++bj)
#pragma unroll
                        for (int n = 0; n < 2; ++n) { const f32x4 v = acc[ai][bj][m][n] * r; sq += (v[0] * v[0] + v[1] * v[1]) + (v[2] * v[2] + v[3] * v[3]); }
                    sq += __shfl_xor(sq, 16); sq += __shfl_xor(sq, 32);
                    if (fq == 0) P[(ai * HALF + wr * 64 + m * 16 + fr) * 4 + wc] = sq;
                }
            asm volatile("s_waitcnt lgkmcnt(0)" ::: "memory"); __builtin_amdgcn_s_barrier(); asm volatile("" ::: "memory");
#pragma unroll
            for (int ai = 0; ai < 2; ++ai)
#pragma unroll
                for (int m = 0; m < 4; ++m) {
                    const int rl = ai * HALF + wr * 64 + m * 16 + fr; const int row = u.pm * BM + rl;
                    const f32x4 pp = *(const LAS f32x4*)(P + rl * 4);
                    const float rk = __builtin_amdgcn_rsqf(((pp[0] + pp[1]) + (pp[2] + pp[3])) * (1.0f / 256.0f) + EPS) * __builtin_amdgcn_rsqf(ssq1[row] * (1.0f / 1024.0f) + EPS);
                    float* of; bf16_t* ob;
                    if (row < TP) { of = out + O_CKVP + (size_t)row * 256; ob = CKVP + (size_t)row * 256; }
                    else { const int rs = row - TP; of = out + O_CKVS + (size_t)rs * 256; ob = CKVS + (size_t)((rs >> 5) * SKV + PAST + (rs & 31)) * 256; }
#pragma unroll
                    for (int bj = 0; bj < 2; ++bj)
#pragma unroll
                        for (int n = 0; n < 2; ++n) {
                            const int col = bj * HALF + wc * 32 + n * 16 + 4 * fq;
                            const f32x4 o = acc[ai][bj][m][n] * rk * *(const f32x4*)(kvg + col);
                            *(f32x4*)(of + col) = o; *(u32x2*)(ob + col) = (u32x2){cvt_pk_bf16(o[0], o[1]), cvt_pk_bf16(o[2], o[3])};
                        }
                }
            asm volatile("s_waitcnt lgkmcnt(0)" ::: "memory"); __builtin_amdgcn_s_barrier(); asm volatile("" ::: "memory");
            return;
        }
#pragma unroll
        for (int ai = 0; ai < 2; ++ai)
#pragma unroll
            for (int m = 0; m < 4; ++m) {
                const int row = u.pm * BM + ai * HALF + wr * 64 + m * 16 + fr;
                const float r = __builtin_amdgcn_rsqf(ssq1[row] * (1.0f / 1024.0f) + EPS);
                if (pn == 1 || pn == 2) {
                    float sq = 0.f;
#pragma unroll
                    for (int bj = 0; bj < 2; ++bj) {
                        if (pn == 2 && bj == 1) {
                            if (wc == 0) {
                                const int pos = row < TP ? row : PAST + ((row - TP) & 31);
                                f32x4 v0 = acc[ai][1][m][0] * r, v1 = acc[ai][1][m][1] * r;
#pragma unroll
                                for (int i = 0; i < 4; ++i) { float c, s; rope_cs(pos, 4 * fq + i, c, s); const float a = v0[i], b = v1[i]; v0[i] = a * c - b * s; v1[i] = b * c + a * s; }
                                float* of; bf16_t* ob;
                                if (row < TP) { of = out + O_KPEP + (size_t)row * 32; ob = KPEP + (size_t)row * 32; }
                                else { const int rs = row - TP; of = out + O_KPES + (size_t)rs * 32; ob = KPES + (size_t)((rs >> 5) * SKV + PAST + (rs & 31)) * 32; }
                                *(f32x4*)(of + 4 * fq) = v0; *(f32x4*)(of + 16 + 4 * fq) = v1;
                                *(u32x2*)(ob + 4 * fq) = (u32x2){cvt_pk_bf16(v0[0], v0[1]), cvt_pk_bf16(v0[2], v0[3])};
                                *(u32x2*)(ob + 16 + 4 * fq) = (u32x2){cvt_pk_bf16(v1[0], v1[1]), cvt_pk_bf16(v1[2], v1[3])};
                            }
                        } else {
#pragma unroll
                            for (int n = 0; n < 2; ++n) {
                                const int col = (pn - 1) * 256 + bj * HALF + wc * 32 + n * 16 + 4 * fq;
                                const f32x4 v = acc[ai][bj][m][n] * r;
                                *(u32x2*)(CQ + (size_t)row * QL + col) = (u32x2){cvt_pk_bf16(v[0], v[1]), cvt_pk_bf16(v[2], v[3])};
                                sq += (v[0] * v[0] + v[1] * v[1]) + (v[2] * v[2] + v[3] * v[3]);
                            }
                        }
                    }
                    sq += __shfl_xor(sq, 16); sq += __shfl_xor(sq, 32); if (fq == 0) atomic_addf(ssqq + row, sq);
                } else if (pn <= 4) {
                    float* cs = nullptr;
                    if (row < TP) { if (row >= TP - 3) cs = out + O_CONVP + (size_t)(row - (TP - 3)) * 512; }
                    else { const int rs = row - TP, t = rs & 31; if (t >= 29) cs = out + O_CONVS + (size_t)((rs >> 5) * 3 + (t - 29)) * 512; }
#pragma unroll
                    for (int bj = 0; bj < 2; ++bj)
#pragma unroll
                        for (int n = 0; n < 2; ++n) {
                            const int col = (pn - 3) * 256 + bj * HALF + wc * 32 + n * 16 + 4 * fq;
                            const f32x4 v = acc[ai][bj][m][n] * r;
                            *(u32x2*)(XBR + (size_t)row * 512 + col) = (u32x2){cvt_pk_bf16(v[0], v[1]), cvt_pk_bf16(v[2], v[3])};
                            if (cs) *(f32x4*)(cs + col) = v;
                        }
                } else {
#pragma unroll
                    for (int bj = 0; bj < 2; ++bj)
#pragma unroll
                        for (int n = 0; n < 2; ++n) {
                            const int col = (pn - 5) * 256 + bj * HALF + wc * 32 + n * 16 + 4 * fq;
                            const f32x4 v = acc[ai][bj][m][n] * r;
                            *(u32x2*)(GG + (size_t)row * 512 + col) = (u32x2){cvt_pk_bf16(gelu_tanh(v[0]), gelu_tanh(v[1])), cvt_pk_bf16(gelu_tanh(v[2]), gelu_tanh(v[3]))};
                        }
                }
            }
    }
};

template <class Epi, class Sched, bool ALIGN_EPI = false, bool SP2 = false>
__device__ __forceinline__ void gemm_phase(PG8_LAS unsigned char* lds, const Gemm g, const Sched& S, const Epi& E) {
    const int tid = threadIdx.x, wid = __builtin_amdgcn_readfirstlane(tid >> 6), lane = tid & 63, wr = wid >> 2, wc = wid & 3, fr = lane & 15, fq = lane >> 4;
    const int K = g.K, nt = K / BK;
    unsigned voffA[2], voffB[2];
#pragma unroll
    for (int i = 0; i < 2; ++i) { int R, C; stage_rc(tid * 16 + i * 8192, R, C); const int Rb = Epi::PERM ? ((R & ~31) + perm32(R & 31)) : R;
        voffA[i] = (unsigned)(R * g.lda + C) * 2u; voffB[i] = (unsigned)(Rb * g.ldb + C) * 2u; }
    const size_t kstep = (size_t)(BK * 2);
    const size_t hstepA = (size_t)HALF * g.lda * 2, hstepB = (size_t)HALF * g.ldb * 2;
    const size_t tstepA = 2 * hstepA, tstepB = 2 * hstepB;
    const unsigned ldsw = (unsigned)wid * 1024u;
    const int aoff = lds_byte(wr * 64 + fr, fq * 8), boff = lds_byte(wc * 32 + fr, fq * 8);
#define PG8_SA(b, h) (((b) * 2 + (h)) * HTB)
#define PG8_SB(b, h) ((4 + (b) * 2 + (h)) * HTB)
#define PG8_STAGE(bufoff, gbase, voff) do { _Pragma("unroll") for (int _i = 0; _i < 2; ++_i) \
        __builtin_amdgcn_global_load_lds((const unsigned*)((const char*)(gbase) + (voff)[_i]), (PG8_LAS unsigned*)(lds + (bufoff) + ldsw + _i * 8192), 16, 0, 0); } while (0)
#define PG8_LDA(dst, b, h) do { _Pragma("unroll") for (int m = 0; m < 4; ++m) _Pragma("unroll") for (int k = 0; k < 2; ++k) dst[m][k] = *(const PG8_LAS bf16x8*)(lds + PG8_SA(b, h) + aoff + m * 2048 + k * 1024); } while (0)
#define PG8_LDB(dst, b, h) do { _Pragma("unroll") for (int n = 0; n < 2; ++n) _Pragma("unroll") for (int k = 0; k < 2; ++k) dst[n][k] = *(const PG8_LAS bf16x8*)(lds + PG8_SB(b, h) + boff + n * 2048 + k * 1024); } while (0)
#define PG8_MMA(ai, bj, At, Bt) do { __builtin_amdgcn_s_setprio(1); _Pragma("unroll") for (int m = 0; m < 4; ++m) _Pragma("unroll") for (int n = 0; n < 2; ++n) _Pragma("unroll") for (int k = 0; k < 2; ++k) \
        acc[ai][bj][m][n] = __builtin_amdgcn_mfma_f32_16x16x32_bf16(Bt[n][k], At[m][k], acc[ai][bj][m][n], 0, 0, 0); __builtin_amdgcn_s_setprio(0); } while (0)
#define PG8_WAIT_V(n) asm volatile("s_waitcnt vmcnt(" #n ")" ::: "memory")
#define PG8_WAIT_L(n) asm volatile("s_waitcnt lgkmcnt(" #n ")" ::: "memory")
#define PG8_BAR __builtin_amdgcn_s_barrier()
#define PG8_SCHED __builtin_amdgcn_sched_barrier(0)
    Unit cur, nxt; int ui = 0;
    if (!S.next(0, cur)) return;
    f32x4 acc[2][2][4][2];
#pragma unroll
    for (int a = 0; a < 2; ++a)
#pragma unroll
        for (int b = 0; b < 2; ++b)
#pragma unroll
            for (int m = 0; m < 4; ++m)
#pragma unroll
                for (int n = 0; n < 2; ++n) acc[a][b][m][n] = (f32x4){0.f, 0.f, 0.f, 0.f};
    bf16x8 At[4][2], B0[2][2], B1[2][2];
    const char* cA = (const char*)g.A + (size_t)cur.pm * tstepA + (size_t)cur.kc * g.kcb; const char* cB = (const char*)g.Bt + (size_t)cur.pn * tstepB + (size_t)cur.kc * g.kcb;
    S.a_ready(cur);
    if constexpr (SP2) {
        PG8_STAGE(PG8_SB(0, 0), cB, voffB); PG8_STAGE(PG8_SB(0, 1), cB + hstepB, voffB); PG8_STAGE(PG8_SA(0, 0), cA, voffA); PG8_STAGE(PG8_SA(0, 1), cA + hstepA, voffA);
        if (wr == 1) PG8_BAR;
        PG8_WAIT_V(2); PG8_BAR;
        PG8_STAGE(PG8_SB(1, 0), cB + kstep, voffB); PG8_STAGE(PG8_SA(1, 0), cA + kstep, voffA); PG8_STAGE(PG8_SB(1, 1), cB + hstepB + kstep, voffB);
        PG8_WAIT_V(6); PG8_BAR;
    } else {
        PG8_STAGE(PG8_SB(0, 0), cB, voffB); PG8_STAGE(PG8_SA(0, 0), cA, voffA); PG8_STAGE(PG8_SB(0, 1), cB + hstepB, voffB); PG8_STAGE(PG8_SA(0, 1), cA + hstepA, voffA);
        if (wr == 1) PG8_BAR;
        PG8_WAIT_V(4); PG8_BAR;
        PG8_STAGE(PG8_SB(1, 0), cB + kstep, voffB); PG8_STAGE(PG8_SA(1, 0), cA + kstep, voffA); PG8_STAGE(PG8_SB(1, 1), cB + hstepB + kstep, voffB);
        PG8_WAIT_V(6); PG8_BAR;
    }
    for (;;) {
        const bool has_next = S.next(ui + 1, nxt);
        const char* nA = has_next ? (const char*)g.A + (size_t)nxt.pm * tstepA + (size_t)nxt.kc * g.kcb : cA; const char* nB = has_next ? (const char*)g.Bt + (size_t)nxt.pn * tstepB + (size_t)nxt.kc * g.kcb : cB;
_Pragma("unroll 1")
        for (int t = 0; t < nt; t += 2) {
            if constexpr (Epi::MIDSCALE) { if (t == nt / 2) E.midscale(acc, cur, wr, fr); }
            const bool last = (t == nt - 2);
            const char* a1 = cA + (size_t)(t + 1) * kstep;
            const char* a2 = last ? nA : cA + (size_t)(t + 2) * kstep; const char* b2 = last ? nB : cB + (size_t)(t + 2) * kstep;
            const char* a3 = a2 + kstep; const char* b3 = b2 + kstep;
            if (last && has_next) S.a_ready(nxt);
            if constexpr (SP2) {
            PG8_LDB(B0, 0, 0); PG8_LDB(B1, 0, 1); PG8_SCHED; PG8_LDA(At, 0, 0); PG8_STAGE(PG8_SA(1, 1), a1 + hstepA, voffA);
            PG8_WAIT_V(8); PG8_WAIT_L(0); PG8_BAR; PG8_MMA(0, 0, At, B0); PG8_MMA(0, 1, At, B1); PG8_BAR; PG8_SCHED;
            PG8_LDA(At, 0, 1); PG8_STAGE(PG8_SB(0, 0), b2, voffB); PG8_STAGE(PG8_SB(0, 1), b2 + hstepB, voffB); PG8_STAGE(PG8_SA(0, 0), a2, voffA);
            PG8_WAIT_V(8); PG8_WAIT_L(0); PG8_BAR; PG8_MMA(1, 0, At, B0); PG8_MMA(1, 1, At, B1); PG8_BAR; PG8_SCHED;
            PG8_LDB(B0, 1, 0); PG8_LDB(B1, 1, 1); PG8_SCHED; PG8_LDA(At, 1, 0); PG8_STAGE(PG8_SA(0, 1), a2 + hstepA, voffA);
            PG8_WAIT_V(8); PG8_WAIT_L(0); PG8_BAR; PG8_MMA(0, 0, At, B0); PG8_MMA(0, 1, At, B1); PG8_BAR; PG8_SCHED;
            PG8_LDA(At, 1, 1); PG8_STAGE(PG8_SB(1, 0), b3, voffB); PG8_STAGE(PG8_SB(1, 1), b3 + hstepB, voffB); PG8_STAGE(PG8_SA(1, 0), a3, voffA);
            PG8_WAIT_V(8); PG8_WAIT_L(0); PG8_BAR; PG8_MMA(1, 0, At, B0); PG8_MMA(1, 1, At, B1); PG8_BAR; PG8_SCHED;
            } else {
            PG8_LDB(B0, 0, 0); PG8_SCHED; PG8_LDA(At, 0, 0); PG8_STAGE(PG8_SA(1, 1), a1 + hstepA, voffA);
            PG8_WAIT_L(8); PG8_BAR; PG8_WAIT_L(0); PG8_MMA(0, 0, At, B0); PG8_BAR; PG8_SCHED;
            PG8_LDB(B1, 0, 1); PG8_STAGE(PG8_SB(0, 0), b2, voffB);
            PG8_BAR; PG8_WAIT_L(0); PG8_MMA(0, 1, At, B1); PG8_BAR;
            PG8_LDA(At, 0, 1); PG8_STAGE(PG8_SA(0, 0), a2, voffA);
            PG8_BAR; PG8_WAIT_L(0); PG8_MMA(1, 0, At, B0); PG8_BAR; PG8_SCHED;
            PG8_STAGE(PG8_SB(0, 1), b2 + hstepB, voffB);
            PG8_WAIT_V(6); PG8_BAR; PG8_MMA(1, 1, At, B1); PG8_BAR;
            PG8_LDB(B0, 1, 0); PG8_SCHED; PG8_LDA(At, 1, 0); PG8_STAGE(PG8_SA(0, 1), a2 + hstepA, voffA);
            PG8_WAIT_L(8); PG8_BAR; PG8_WAIT_L(0); PG8_MMA(0, 0, At, B0); PG8_BAR; PG8_SCHED;
            PG8_LDB(B1, 1, 1); PG8_STAGE(PG8_SB(1, 0), b3, voffB);
            PG8_BAR; PG8_WAIT_L(0); PG8_MMA(0, 1, At, B1); PG8_BAR;
            PG8_LDA(At, 1, 1); PG8_STAGE(PG8_SA(1, 0), a3, voffA);
            PG8_BAR; PG8_WAIT_L(0); PG8_MMA(1, 0, At, B0); PG8_BAR; PG8_SCHED;
            PG8_STAGE(PG8_SB(1, 1), b3 + hstepB, voffB);
            PG8_WAIT_V(6); PG8_BAR; PG8_MMA(1, 1, At, B1); PG8_BAR;
            }
        }
        if constexpr (ALIGN_EPI) { if (wr == 0) PG8_BAR; }
        if constexpr (!Epi::AFTER_DRAIN) { E(acc, cur, wr, wc, fr, fq); S.done(cur); }
        if (!has_next) break;
#pragma unroll
        for (int a = 0; a < 2; ++a)
#pragma unroll
            for (int b = 0; b < 2; ++b)
#pragma unroll
                for (int m = 0; m < 4; ++m)
#pragma unroll
                    for (int n = 0; n < 2; ++n) acc[a][b][m][n] = (f32x4){0.f, 0.f, 0.f, 0.f};
        cur = nxt; cA = nA; cB = nB; ++ui;
        if constexpr (ALIGN_EPI) { if (wr == 1) PG8_BAR; }
    }
    PG8_WAIT_V(0);
    if constexpr (!ALIGN_EPI) { if (wr == 0) PG8_BAR; }
    PG8_BAR;
    if constexpr (Epi::AFTER_DRAIN) { E.fused(acc, cur, wr, wc, fr, fq, lds, wid, lane); S.done(cur); }
#undef PG8_SA
#undef PG8_SB
#undef PG8_STAGE
#undef PG8_LDA
#undef PG8_LDB
#undef PG8_MMA
#undef PG8_WAIT_V
#undef PG8_WAIT_L
#undef PG8_BAR
#undef PG8_SCHED
}
}

#define MFMA32(a, b, c) __builtin_amdgcn_mfma_f32_32x32x16_bf16((a), (b), (c), 0, 0, 0)
__device__ __forceinline__ bf16x8 pack8(const f32x16& p, int b) {
    u32x4 w = (u32x4){pk2(p[b], p[b + 1]), pk2(p[b + 2], p[b + 3]), pk2(p[b + 4], p[b + 5]), pk2(p[b + 6], p[b + 7])};
    return __builtin_bit_cast(bf16x8, w);
}
__device__ __forceinline__ float max3f_(float a, float b, float c) { float r; asm("v_max3_f32 %0, %1, %2, %3" : "=v"(r) : "v"(a), "v"(b), "v"(c)); return r; }
__device__ __forceinline__ float max16(const f32x16& p) {
    float a = max3f_(p[0], p[1], p[2]), b = max3f_(p[3], p[4], p[5]);
    a = max3f_(a, p[6], p[7]); b = max3f_(b, p[8], p[9]); a = max3f_(a, p[10], p[11]); b = max3f_(b, p[12], p[13]);
    return max3f_(a, b, max3f_(p[14], p[15], p[15]));
}
__device__ __forceinline__ bf16x8 cat44(s16x4 a, s16x4 b) { return (bf16x8){a[0], a[1], a[2], a[3], b[0], b[1], b[2], b[3]}; }

struct MlaState { f32x16 o0, o1, negm; float l; };
typedef float f32x2p __attribute__((ext_vector_type(2)));
__device__ __forceinline__ void mla_softmax_pv_prep(MlaState& st, f32x16& p0, f32x16& p1, bf16x8 (&pb)[4], bool first) {
    float mx = fmaxf(max16(p0), max16(p1));
    { auto rr = __builtin_amdgcn_permlane32_swap(__builtin_bit_cast(unsigned, mx), __builtin_bit_cast(unsigned, mx), false, false);
      mx = fmaxf(__builtin_bit_cast(float, rr[0]), __builtin_bit_cast(float, rr[1])); }
    if (first || __any(mx > 8.0f)) {
        const float d = first ? mx : (mx > 8.0f ? mx : 0.f);
#pragma unroll
        for (int r = 0; r < 16; ++r) { p0[r] -= d; p1[r] -= d; st.negm[r] -= d; }
        if (!first) { const float f = __builtin_amdgcn_exp2f(-d); st.l *= f;
#pragma unroll
            for (int r = 0; r < 16; ++r) { st.o0[r] *= f; st.o1[r] *= f; } }
    }
    f32x2p ps = (f32x2p){0.f, 0.f};
#pragma unroll
    for (int r = 0; r < 16; r += 2) {
        p0[r] = __builtin_amdgcn_exp2f(p0[r]); p0[r + 1] = __builtin_amdgcn_exp2f(p0[r + 1]); p1[r] = __builtin_amdgcn_exp2f(p1[r]); p1[r + 1] = __builtin_amdgcn_exp2f(p1[r + 1]);
        ps += (f32x2p){p0[r], p0[r + 1]}; ps += (f32x2p){p1[r], p1[r + 1]};
    }
    st.l += ps[0] + ps[1];
    pb[0] = pack8(p0, 0); pb[1] = pack8(p0, 8); pb[2] = pack8(p1, 0); pb[3] = pack8(p1, 8);
}

constexpr int MLA_KROW = 208, MLA_VROW = 144, MLA_KT = 64 * MLA_KROW  , MLA_STAGE = MLA_KT + 64 * MLA_VROW  ;

__device__ __forceinline__ void mla_prompt_unit(LAS unsigned char* lds, int h, int qb, const bf16_t* __restrict__ Q, const bf16_t* __restrict__ KN, const bf16_t* __restrict__ KPE,
                                                const bf16_t* __restrict__ VT, bf16_t* MERGED, float* ssqa) {
    const int tid = threadIdx.x, lane = tid & 63, w = __builtin_amdgcn_readfirstlane(tid >> 6), r32 = lane & 31, hi = lane >> 5;
    const int q0 = qb * 256 + w * 32;
    bf16x8 qf[6];
    { const bf16_t* qp = Q + (size_t)(q0 + r32) * 768 + h * 96 + hi * 8;
#pragma unroll
      for (int s = 0; s < 6; ++s) qf[s] = *(const bf16x8*)(qp + 16 * s); }
    const int NT = 4 * qb + 4, mylast = 4 * qb + (w >> 1);
    MlaState st; st.l = 0.f;
#pragma unroll
    for (int r = 0; r < 16; ++r) { st.o0[r] = 0.f; st.o1[r] = 0.f; st.negm[r] = 0.f; }
    const int krow = tid >> 3, kch = tid & 7, prow = (tid & 255) >> 2, pch = tid & 3, vd = tid >> 3, vch = tid & 7;
    const bf16_t* ksrc = KN + (size_t)krow * 512 + h * 64 + kch * 8;
    const bf16_t* psrc = KPE + (size_t)prow * 32 + pch * 8;
    const bf16_t* vsrc = VT + (size_t)(h * 64 + vd) * VT_LD + vch * 8;
    const int kdst = krow * MLA_KROW + kch * 16, pdst = prow * MLA_KROW + 128 + pch * 16, vdst = MLA_KT + vd * MLA_VROW + (vch >> 1) * 32 + (vch & 1) * 8;
    u32x4 rk, rp, rv; rp = (u32x4){0, 0, 0, 0};
#define MLA_GLOAD(t) do { rk = *(const u32x4*)(ksrc + (size_t)(t) * 64 * 512); if (tid < 256) rp = *(const u32x4*)(psrc + (size_t)(t) * 64 * 32); rv = *(const u32x4*)(vsrc + (size_t)(t) * 64); } while (0)
#define MLA_LSTORE(b) do { LAS unsigned char* sb_ = lds + (b) * MLA_STAGE; *(LAS u32x4*)(sb_ + kdst) = rk; if (tid < 256) *(LAS u32x4*)(sb_ + pdst) = rp; \
        *(LAS u32x2*)(sb_ + vdst) = (u32x2){rv[0], rv[1]}; *(LAS u32x2*)(sb_ + vdst + 16) = (u32x2){rv[2], rv[3]}; } while (0)
    MLA_GLOAD(0); MLA_LSTORE(0); __syncthreads();
    for (int t = 0; t < NT; ++t) {
        const bool more = (t + 1 < NT);
        if (more) MLA_GLOAD(t + 1);
        if (t <= mylast) {
            const LAS unsigned char* sb = lds + (t & 1) * MLA_STAGE;
            const LAS unsigned char* kb = sb + r32 * MLA_KROW + hi * 16;
            bf16x8 ka[6], kc[6];
#pragma unroll
            for (int s = 0; s < 6; ++s) { ka[s] = *(const LAS bf16x8*)(kb + s * 32); kc[s] = *(const LAS bf16x8*)(kb + 32 * MLA_KROW + s * 32); }
            __builtin_amdgcn_sched_barrier(0);
            f32x16 p0 = st.negm, p1 = st.negm;
#pragma unroll
            for (int s = 0; s < 6; ++s) { p0 = MFMA32(ka[s], qf[s], p0); p1 = MFMA32(kc[s], qf[s], p1); }
            __builtin_amdgcn_sched_barrier(0);
            const LAS unsigned char* vb = sb + MLA_KT + r32 * MLA_VROW + hi * 16;
            bf16x8 va[4], vc[4];
#pragma unroll
            for (int s = 0; s < 4; ++s) {
                va[s] = *(const LAS bf16x8*)(vb + s * 32); vc[s] = *(const LAS bf16x8*)(vb + 32 * MLA_VROW + s * 32);
            }
            __builtin_amdgcn_sched_barrier(0);
            bf16x8 pb[4];
            mla_softmax_pv_prep(st, p0, p1, pb, t == 0);
#pragma unroll
            for (int s = 0; s < 4; ++s) { st.o0 = MFMA32(va[s], pb[s], st.o0); st.o1 = MFMA32(vc[s], pb[s], st.o1); }
        }
        if (more) MLA_LSTORE((t + 1) & 1);
        __syncthreads();
    }
#undef MLA_GLOAD
#undef MLA_LSTORE
    const float l = st.l + __shfl_xor(st.l, 32); const float inv = 1.f / l;
    const int row = q0 + r32; bf16_t* op = MERGED + (size_t)row * DM + h * 64 + 4 * hi; float sq = 0.f;
#pragma unroll
    for (int g = 0; g < 4; ++g) {
        const float a0 = st.o0[4 * g] * inv, a1 = st.o0[4 * g + 1] * inv, a2 = st.o0[4 * g + 2] * inv, a3 = st.o0[4 * g + 3] * inv;
        const float b0 = st.o1[4 * g] * inv, b1 = st.o1[4 * g + 1] * inv, b2 = st.o1[4 * g + 2] * inv, b3 = st.o1[4 * g + 3] * inv;
        *(u32x2*)(op + 8 * g) = (u32x2){pk2(a0, a1), pk2(a2, a3)}; *(u32x2*)(op + 32 + 8 * g) = (u32x2){pk2(b0, b1), pk2(b2, b3)};
        sq += (a0 * a0 + a1 * a1) + (a2 * a2 + a3 * a3) + (b0 * b0 + b1 * b1) + (b2 * b2 + b3 * b3);
    }
    sq += __shfl_xor(sq, 32); if (hi == 0) atomic_addf(ssqa + row, sq);
}

__device__ __forceinline__ void mla_sample_unit(LAS unsigned char* lds, int b, int h, const bf16_t* __restrict__ Q, const bf16_t* __restrict__ KN, const bf16_t* __restrict__ KPE,
                                                const bf16_t* __restrict__ VT, bf16_t* MERGED, float* ssqa) {
    const int tid = threadIdx.x, lane = tid & 63, w = __builtin_amdgcn_readfirstlane(tid >> 6), r32 = lane & 31, hi = lane >> 5;
    const int row = TP + b * 32 + r32;
    bf16x8 qf[6];
    { const bf16_t* qp = Q + (size_t)row * 768 + h * 96 + hi * 8;
#pragma unroll
      for (int s = 0; s < 6; ++s) qf[s] = *(const bf16x8*)(qp + 16 * s); }
    MlaState st; st.l = 0.f;
#pragma unroll
    for (int r = 0; r < 16; ++r) { st.o0[r] = 0.f; st.o1[r] = 0.f; st.negm[r] = 0.f; }
    bf16x8 ka[6], kc[6]; s16x4 va[8], vc[8];
#define MLS_LOAD(t_, KA, KC, VA, VC) do { const size_t kv0_ = (size_t)b * SKV + (t_) * 64; \
        const bf16_t* kp_ = KN + (kv0_ + r32) * 512 + h * 64 + hi * 8; const bf16_t* pp_ = KPE + (kv0_ + r32) * 32 + hi * 8; \
        _Pragma("unroll") for (int s_ = 0; s_ < 4; ++s_) { KA[s_] = *(const bf16x8*)(kp_ + 16 * s_); KC[s_] = *(const bf16x8*)(kp_ + 32 * 512 + 16 * s_); } \
        _Pragma("unroll") for (int s_ = 0; s_ < 2; ++s_) { KA[4 + s_] = *(const bf16x8*)(pp_ + 16 * s_); KC[4 + s_] = *(const bf16x8*)(pp_ + 32 * 32 + 16 * s_); } \
        const bf16_t* vp_ = VT + (size_t)(h * 64 + r32) * VTS_LD + kv0_ + 4 * hi; \
        _Pragma("unroll") for (int s_ = 0; s_ < 4; ++s_) { VA[2 * s_] = *(const s16x4*)(vp_ + 16 * s_); VA[2 * s_ + 1] = *(const s16x4*)(vp_ + 16 * s_ + 8); \
            VC[2 * s_] = *(const s16x4*)(vp_ + (size_t)32 * VTS_LD + 16 * s_); VC[2 * s_ + 1] = *(const s16x4*)(vp_ + (size_t)32 * VTS_LD + 16 * s_ + 8); } } while (0)
    for (int t = w; t < 33; t += 8) {
        MLS_LOAD(t, ka, kc, va, vc);
        __builtin_amdgcn_sched_barrier(0);
        f32x16 p0 = st.negm, p1 = st.negm;
        const bool tail = (t == 32);
#pragma unroll
        for (int s = 0; s < 6; ++s) { p0 = MFMA32(ka[s], qf[s], p0); if (!tail) p1 = MFMA32(kc[s], qf[s], p1); }
        if (tail) {
#pragma unroll
            for (int r = 0; r < 16; ++r) p1[r] = -1e30f;
        }
        bf16x8 pb[4];
        mla_softmax_pv_prep(st, p0, p1, pb, t == w);
#pragma unroll
        for (int s = 0; s < 4; ++s) {
            if (tail && s >= 2) break;
            st.o0 = MFMA32(cat44(va[2 * s], va[2 * s + 1]), pb[s], st.o0); st.o1 = MFMA32(cat44(vc[2 * s], vc[2 * s + 1]), pb[s], st.o1);
        }
    }
#undef MLS_LOAD
    LAS float* Lm = (LAS float*)lds; LAS float* Ll = Lm + 512; LAS float* LO = Lm + 1024;
    const float mref = -st.negm[0];
    Lm[w * 64 + lane] = mref;
    __syncthreads();
    float M = Lm[lane];
#pragma unroll
    for (int k = 1; k < 8; ++k) M = fmaxf(M, Lm[k * 64 + lane]);
    const float f = __builtin_amdgcn_exp2f(mref - M);
    Ll[w * 64 + lane] = st.l * f;
#pragma unroll
    for (int r = 0; r < 16; ++r) { LO[(w * 32 + r) * 64 + lane] = st.o0[r] * f; LO[(w * 32 + 16 + r) * 64 + lane] = st.o1[r] * f; }
    __syncthreads();
    float l = 0.f;
#pragma unroll
    for (int k = 0; k < 8; ++k) l += Ll[k * 64 + lane] + Ll[k * 64 + (lane ^ 32)];
    const float inv = 1.f / l;
    float v[4];
#pragma unroll
    for (int i = 0; i < 4; ++i) { float s = 0.f;
#pragma unroll
        for (int k = 0; k < 8; ++k) s += LO[(k * 32 + 4 * w + i) * 64 + lane];
        v[i] = s * inv; }
    *(u32x2*)(MERGED + (size_t)row * DM + h * 64 + 32 * (w >> 2) + 8 * (w & 3) + 4 * hi) = (u32x2){pk2(v[0], v[1]), pk2(v[2], v[3])};
    float sq = (v[0] * v[0] + v[1] * v[1]) + (v[2] * v[2] + v[3] * v[3]);
    sq += __shfl_xor(sq, 32); if (hi == 0) atomic_addf(ssqa + row, sq);
    __syncthreads();
}

template <class QF, class KF, class VF, class MID>
__device__ __forceinline__ void xattn_wave(QF qfrag, bf16_t* orow  , KF kfrag, VF vfrag, MID mid) {
    bf16x8 pb[16];
    float inv;
    {
        f32x16 S[4][2];
#pragma unroll
        for (int kt = 0; kt < 4; ++kt)
#pragma unroll
            for (int r = 0; r < 16; ++r) { S[kt][0][r] = 0.f; S[kt][1][r] = 0.f; }
#pragma unroll
        for (int s = 0; s < 16; ++s) {
            const bf16x8 qf = qfrag(s);
#pragma unroll
            for (int kt = 0; kt < 4; ++kt) { S[kt][0] = MFMA32(kfrag(kt, 0, s), qf, S[kt][0]); S[kt][1] = MFMA32(kfrag(kt, 1, s), qf, S[kt][1]); }
        }
        float mx = -1e30f;
#pragma unroll
        for (int kt = 0; kt < 4; ++kt) mx = fmaxf(mx, fmaxf(max16(S[kt][0]), max16(S[kt][1])));
        mx = fmaxf(mx, __shfl_xor(mx, 32));
        float l = 0.f;
#pragma unroll
        for (int kt = 0; kt < 4; ++kt) {
#pragma unroll
            for (int r = 0; r < 16; ++r) { S[kt][0][r] = __builtin_amdgcn_exp2f(S[kt][0][r] - mx); S[kt][1][r] = __builtin_amdgcn_exp2f(S[kt][1][r] - mx); l += S[kt][0][r] + S[kt][1][r]; }
            pb[4 * kt] = pack8(S[kt][0], 0); pb[4 * kt + 1] = pack8(S[kt][0], 8); pb[4 * kt + 2] = pack8(S[kt][1], 0); pb[4 * kt + 3] = pack8(S[kt][1], 8);
        }
        l += __shfl_xor(l, 32); inv = 1.f / l;
    }
    mid();
#pragma unroll 1
    for (int db = 0; db < 8; ++db) {
        f32x16 o;
#pragma unroll
        for (int r = 0; r < 16; ++r) o[r] = 0.f;
        bf16x8 vf[16];
#pragma unroll
        for (int s = 0; s < 16; ++s) vf[s] = vfrag(db, s);
        __builtin_amdgcn_sched_barrier(0);
#pragma unroll
        for (int s = 0; s < 16; ++s) o = MFMA32(vf[s], pb[s], o);
#pragma unroll
        for (int g = 0; g < 4; ++g)
            *(u32x2*)(orow + 32 * db + 8 * g) = (u32x2){pk2(o[4 * g] * inv, o[4 * g + 1] * inv), pk2(o[4 * g + 2] * inv, o[4 * g + 3] * inv)};
    }
}

constexpr int XA_KROW = 528, XA_VROW = 528;
__device__ __forceinline__ void xattn_unit(LAS unsigned char* lds, int rowbase, bool single, int h, bf16_t* QM, const bf16_t* __restrict__ MKB, const bf16_t* __restrict__ MVTB, const float* __restrict__ QACC, const float* __restrict__ ssq2) {
    const int tid = threadIdx.x, lane = tid & 63, w = __builtin_amdgcn_readfirstlane(tid >> 6), r32 = lane & 31, hi = lane >> 5;
#pragma unroll 4
    for (int it = 0; it < 16; ++it) { const int idx = it * 512 + tid, rw = idx >> 5, ch = idx & 31;
        *(LAS u32x4*)(lds + rw * XA_KROW + ch * 16) = *(const u32x4*)(MKB + (size_t)rw * DM + h * 256 + ch * 8); }
    __syncthreads();
    const int row = rowbase + (single ? 0 : w * 32) + r32;
    const LAS unsigned char* kb = lds + r32 * XA_KROW + hi * 16;
    const LAS unsigned char* vb = lds + r32 * XA_VROW + hi * 16;
    auto kfrag = [&](int kt, int half, int s) -> bf16x8 { return *(const LAS bf16x8*)(kb + (kt * 64 + half * 32) * XA_KROW + s * 32); };
    auto vfrag = [&](int db, int s) -> bf16x8 { return *(const LAS bf16x8*)(vb + db * 32 * XA_VROW + s * 32); };
    auto mid = [&]() {
        __syncthreads();
#pragma unroll 4
        for (int it = 0; it < 16; ++it) { const int idx = it * 512 + tid, d = idx >> 5, ch = idx & 31;
            const u32x4 v = *(const u32x4*)(MVTB + (size_t)(h * 256 + d) * 256 + ch * 8);
            LAS unsigned char* dp = lds + d * XA_VROW + (ch >> 1) * 32 + (ch & 1) * 8;
            *(LAS u32x2*)dp = (u32x2){v[0], v[1]}; *(LAS u32x2*)(dp + 16) = (u32x2){v[2], v[3]}; }
        __syncthreads();
    };
    if (!single) {
        const bf16_t* qrow = QM + (size_t)row * DM + h * 256 + hi * 8;
        auto qfrag = [&](int s) -> bf16x8 { return *(const bf16x8*)(qrow + 16 * s); };
        xattn_wave(qfrag, QM + (size_t)row * DM + h * 256 + 4 * hi, kfrag, vfrag, mid);
    } else if (w == 0) {
        const float* qrow = QACC + (size_t)(row - TP) * DM + h * 256 + hi * 8; const float sc = XSCALE * __builtin_amdgcn_rsqf(ssq2[row] * (1.0f / 1024.0f) + EPS);
        auto qfrag = [&](int s) -> bf16x8 { const f32x4 a = *(const f32x4*)(qrow + 16 * s) * sc, b = *(const f32x4*)(qrow + 16 * s + 4) * sc;
            return __builtin_bit_cast(bf16x8, (u32x4){pk2(a[0], a[1]), pk2(a[2], a[3]), pk2(b[0], b[1]), pk2(b[2], b[3])}); };
        xattn_wave(qfrag, QM + (size_t)row * DM + h * 256 + 4 * hi, kfrag, vfrag, mid);
    } else mid();
    __syncthreads();
}
struct LruArgs { const bf16_t* XBR; const float* conv_w; const float* conv_b; const float* wa; const float* ba; const float* wx; const float* bx; const float* lam;
                 const float* state_conv; const float* state_lru; bf16_t* HLOC; bf16_t* ACUM; float* ATOT; float* BTOT; float* out; };
__device__ __forceinline__ void lru_l1_unit(LAS unsigned char* lds, int unit, const LruArgs& A) {
    const int c = threadIdx.x, g = __builtin_amdgcn_readfirstlane(c >> 6), j = c & 63, r32 = j & 31, hi = j >> 5;
    const bool samp = unit >= 256; const int b = unit - 256;
    const int row0 = samp ? TP + b * 32 : unit * 64; const int nt = samp ? 32 : 64;
    constexpr int XROW = 1040;
    LAS unsigned char* XCB = lds;
    LAS unsigned* PRE = (LAS unsigned*)(lds + 64 * XROW);
    const float w0 = A.conv_w[c], w1 = A.conv_w[512 + c], w2 = A.conv_w[1024 + c], w3 = A.conv_w[1536 + c], cb = A.conv_b[c];
    float xm3, xm2, xm1;
    if (samp) { xm3 = A.state_conv[(b * 3 + 0) * 512 + c]; xm2 = A.state_conv[(b * 3 + 1) * 512 + c]; xm1 = A.state_conv[(b * 3 + 2) * 512 + c]; }
    else if (unit > 0) { xm3 = bf2f(A.XBR[(size_t)(row0 - 3) * 512 + c]); xm2 = bf2f(A.XBR[(size_t)(row0 - 2) * 512 + c]); xm1 = bf2f(A.XBR[(size_t)(row0 - 1) * 512 + c]); }
    else { xm3 = 0.f; xm2 = 0.f; xm1 = 0.f; }
    {
        unsigned short xraw[64];
#pragma unroll
        for (int t = 0; t < 64; ++t) xraw[t] = (t < nt) ? A.XBR[(size_t)(row0 + t) * 512 + c] : (unsigned short)0;
#pragma unroll
        for (int t = 0; t < 64; ++t) {
            if (t < nt) {
                const float x0 = bf2f(xraw[t]);
                *(LAS bf16_t*)(XCB + t * XROW + c * 2) = (bf16_t)f2bf(cb + w0 * xm3 + w1 * xm2 + w2 * xm1 + w3 * x0);
                xm3 = xm2; xm2 = xm1; xm1 = x0;
            }
        }
    }
    bf16x8 bw[4][4];
#pragma unroll
    for (int nb = 0; nb < 4; ++nb)
#pragma unroll
        for (int ks = 0; ks < 4; ++ks) {
            const float* W = ((nb < 2) ? A.wa : A.wx) + g * 4096 + (16 * ks) * 64 + (nb & 1) * 32;
            const float* Wl = W + (8 * hi) * 64 + r32;
            bw[nb][ks] = __builtin_bit_cast(bf16x8, (u32x4){pk2(Wl[0], Wl[64]), pk2(Wl[128], Wl[192]), pk2(Wl[256], Wl[320]), pk2(Wl[384], Wl[448])});
        }
    const float bav = A.ba[c], bxv = A.bx[c];
    const float lamv = A.lam[c]; const float sp = log1pf(__expf(-lamv));
    float h = samp ? A.state_lru[b * 512 + c] : 0.f, Ac = 1.f;
    asm volatile("s_waitcnt lgkmcnt(0)" ::: "memory");
    for (int mb = 0; mb < (nt >> 5); ++mb) {
        f32x16 C0, C1, C2, C3;
#pragma unroll
        for (int r = 0; r < 16; ++r) { C0[r] = 0.f; C1[r] = 0.f; C2[r] = 0.f; C3[r] = 0.f; }
#pragma unroll
        for (int ks = 0; ks < 4; ++ks) {
            const bf16x8 a = *(const LAS bf16x8*)(XCB + (32 * mb + r32) * XROW + (g * 64 + 16 * ks + 8 * hi) * 2);
            C0 = MFMA32(a, bw[0][ks], C0); C1 = MFMA32(a, bw[1][ks], C1); C2 = MFMA32(a, bw[2][ks], C2); C3 = MFMA32(a, bw[3][ks], C3);
        }
#pragma unroll
        for (int r = 0; r < 16; ++r) { const int tl = (r & 3) + 8 * (r >> 2) + 4 * hi;
            PRE[tl * 512 + g * 64 + r32] = f2bf(C0[r]) | (f2bf(C2[r]) << 16); PRE[tl * 512 + g * 64 + 32 + r32] = f2bf(C1[r]) | (f2bf(C3[r]) << 16); }
        asm volatile("s_waitcnt lgkmcnt(0)" ::: "memory");
#pragma unroll 4
        for (int tl = 0; tl < 32; ++tl) {
            const int t = 32 * mb + tl;
            const unsigned u = PRE[tl * 512 + c];
            const float ra = __builtin_bit_cast(float, u << 16) + bav, ri = __builtin_bit_cast(float, u & 0xffff0000u) + bxv;
            const float xcv = bf2f(*(const LAS bf16_t*)(XCB + t * XROW + c * 2));
            const float rg = __builtin_amdgcn_rcpf(1.f + __builtin_amdgcn_exp2f(-LOG2E * ra)), ig = __builtin_amdgcn_rcpf(1.f + __builtin_amdgcn_exp2f(-LOG2E * ri));
            const float a = __builtin_amdgcn_exp2f((-8.0f * LOG2E) * rg * sp);
            const float bt = __builtin_amdgcn_sqrtf(fmaxf(1.f - a * a, 0.f)) * ig * xcv;
            h = a * h + bt; Ac *= a;
            A.HLOC[(size_t)(row0 + t) * 512 + c] = (bf16_t)f2bf(h); A.ACUM[(size_t)(row0 + t) * 512 + c] = (bf16_t)f2bf(Ac);
        }
        asm volatile("s_waitcnt lgkmcnt(0)" ::: "memory");
    }
    A.ATOT[unit * 512 + c] = Ac; A.BTOT[unit * 512 + c] = h;
    if (samp) A.out[O_LRUS + b * 512 + c] = h;
    __syncthreads();
}
__device__ __forceinline__ void lru_l3_unit(LAS unsigned char* lds, int unit, const bf16_t* __restrict__ HLOC, const bf16_t* __restrict__ ACUM, const bf16_t* __restrict__ GG,
                                            const float* __restrict__ ATOT, const float* __restrict__ BTOT, const float* __restrict__ gain, bf16_t* MERGED, float* out) {
    const int c = threadIdx.x, lane = c & 63, w = __builtin_amdgcn_readfirstlane(c >> 6);
    const bool samp = unit >= 256; const int row0 = samp ? TP + (unit - 256) * 32 : unit * 64; const int nt = samp ? 32 : 64;
    LAS float* HIN = (LAS float*)lds;
    float H = 0.f;
    if (!samp) {
#pragma unroll 32
        for (int k = 0; k < unit; ++k) H = ATOT[k * 512 + c] * H + BTOT[k * 512 + c];
        if (unit == 255) out[O_LRUP + c] = ATOT[255 * 512 + c] * H + BTOT[255 * 512 + c];
    }
    HIN[c] = H;
    __syncthreads();
    float hin[8], gn[8];
#pragma unroll
    for (int k = 0; k < 8; ++k) { hin[k] = HIN[lane * 8 + k]; gn[k] = gain[lane * 8 + k]; }
    for (int t0 = w; t0 < nt; t0 += 32) {
        u32x4 hl[4], ac[4], gg[4];
#pragma unroll
        for (int q = 0; q < 4; ++q) { const size_t off = (size_t)(row0 + t0 + 8 * q) * 512 + lane * 8;
            hl[q] = *(const u32x4*)(HLOC + off); ac[q] = *(const u32x4*)(ACUM + off); gg[q] = *(const u32x4*)(GG + off); }
#pragma unroll
        for (int q = 0; q < 4; ++q) {
            float v[8]; float sq = 0.f;
#pragma unroll
            for (int k = 0; k < 4; ++k) {
                const float h0 = __builtin_bit_cast(float, hl[q][k] << 16) + __builtin_bit_cast(float, ac[q][k] << 16) * hin[2 * k];
                const float h1 = __builtin_bit_cast(float, hl[q][k] & 0xffff0000u) + __builtin_bit_cast(float, ac[q][k] & 0xffff0000u) * hin[2 * k + 1];
                v[2 * k] = __builtin_bit_cast(float, gg[q][k] << 16) * h0; v[2 * k + 1] = __builtin_bit_cast(float, gg[q][k] & 0xffff0000u) * h1;
                sq += v[2 * k] * v[2 * k] + v[2 * k + 1] * v[2 * k + 1];
            }
            const float rs = __builtin_amdgcn_rsqf(wave_sum(sq) * (1.0f / 512.0f) + EPS);
            *(u32x4*)(MERGED + (size_t)(row0 + t0 + 8 * q) * DM + 512 + lane * 8) =
                (u32x4){pk2(v[0] * rs * gn[0], v[1] * rs * gn[1]), pk2(v[2] * rs * gn[2], v[3] * rs * gn[3]), pk2(v[4] * rs * gn[4], v[5] * rs * gn[5]), pk2(v[6] * rs * gn[6], v[7] * rs * gn[7])};
        }
    }
    __syncthreads();
}

__device__ __forceinline__ void sample_finalize_part(int part, const float* __restrict__ xs_old, const float* __restrict__ ACC, float* xs_new, bf16_t* XBs, float* ssq_s, unsigned* flag) {
    const int lane = threadIdx.x & 63, w = __builtin_amdgcn_readfirstlane(threadIdx.x >> 6);
    const int r0 = part * 32 + w * 4;
    f32x4 v[4][4];
#pragma unroll
    for (int q = 0; q < 4; ++q)
#pragma unroll
        for (int j = 0; j < 4; ++j) v[q][j] = *((const f32x4*)(xs_old + (size_t)(r0 + q) * DM) + lane + 64 * j) + *((const f32x4*)(ACC + (size_t)(r0 + q) * DM) + lane + 64 * j);
#pragma unroll
    for (int q = 0; q < 4; ++q) {
        float s = 0.f;
#pragma unroll
        for (int j = 0; j < 4; ++j) s += (v[q][j][0] * v[q][j][0] + v[q][j][1] * v[q][j][1]) + (v[q][j][2] * v[q][j][2] + v[q][j][3] * v[q][j][3]);
        s = wave_sum(s); if (lane == 0) ssq_s[r0 + q] = s;
#pragma unroll
        for (int j = 0; j < 4; ++j) { *((f32x4*)(xs_new + (size_t)(r0 + q) * DM) + lane + 64 * j) = v[q][j]; *((u32x2*)(XBs + (size_t)(r0 + q) * DM) + lane + 64 * j) = (u32x2){pk2(v[q][j][0], v[q][j][1]), pk2(v[q][j][2], v[q][j][3])}; }
    }
    asm volatile("s_waitcnt vmcnt(0)" ::: "memory");
    __syncthreads();
    if (threadIdx.x == 0) { __builtin_amdgcn_fence(__ATOMIC_RELEASE, "agent"); asm volatile("s_waitcnt vmcnt(0)" ::: "memory"); __hip_atomic_fetch_add(flag, 1u, __ATOMIC_RELAXED, __HIP_MEMORY_SCOPE_AGENT); }
}
__device__ __forceinline__ void sample_wait(unsigned* flag, unsigned want) {
    if (threadIdx.x == 0) { while (__hip_atomic_load(flag, __ATOMIC_RELAXED, __HIP_MEMORY_SCOPE_AGENT) < want) __builtin_amdgcn_s_sleep(2);
        __builtin_amdgcn_fence(__ATOMIC_ACQUIRE, "agent"); asm volatile("s_waitcnt vmcnt(0)" ::: "memory"); }
    __syncthreads();
}

__device__ __forceinline__ void tr_item(const float* __restrict__ W, int N, int k0, int n0, bf16_t* WT, int drow0, int ldd, const float* gain, LAS float* scr, int lane) {
    float tv[32];
#pragma unroll
    for (int i = 0; i < 32; ++i) tv[i] = W[(size_t)(k0 + 2 * i + (lane >> 5)) * N + n0 + (lane & 31)];
#pragma unroll
    for (int i = 0; i < 32; ++i) { const int kk = 2 * i + (lane >> 5); float v = tv[i]; if (gain) v *= gain[k0 + kk]; scr[kk * 33 + (lane & 31)] = v; }
    asm volatile("s_waitcnt lgkmcnt(0)" ::: "memory");
    const int cc = lane & 7;
#pragma unroll
    for (int jj = 0; jj < 4; ++jj) { const int n = (lane >> 3) + 8 * jj; const LAS float* s = scr + (8 * cc) * 33 + n;
        u32x4 o; o.x = pk2(s[0 * 33], s[1 * 33]); o.y = pk2(s[2 * 33], s[3 * 33]); o.z = pk2(s[4 * 33], s[5 * 33]); o.w = pk2(s[6 * 33], s[7 * 33]);
        *(u32x4*)(WT + (size_t)(drow0 + n) * ldd + k0 + 8 * cc) = o; }
    asm volatile("s_waitcnt lgkmcnt(0)" ::: "memory");
}

#define XB_TMO      128
#define XB_XCNT(j)  (256  + 64 * (j))
#define XB_XSUB(j)  (1280 + 64 * (j))
#define XB_XGEN(j)  (2304 + 64 * (j))
#define XB_TOP      3328
#define XB_TOPGEN   3392
#define XCD_BAR_WORDS 3456
#define XB_SPIN_CAP (1u << 18)

__device__ __forceinline__ unsigned xb_ld(unsigned* p)              { return __hip_atomic_load(p, __ATOMIC_RELAXED, __HIP_MEMORY_SCOPE_AGENT); }
__device__ __forceinline__ unsigned xb_add(unsigned* p, unsigned v) { return __hip_atomic_fetch_add(p, v, __ATOMIC_RELAXED, __HIP_MEMORY_SCOPE_AGENT); }
__device__ __forceinline__ unsigned xb_xcc_id() { return (unsigned)__builtin_amdgcn_s_getreg((3 << 11) | 20) & 0xFu; }
#define XB_SPIN(cond, bar) do { unsigned _sp = 0; while (cond) { __builtin_amdgcn_s_sleep(1); \
    if ((++_sp & 255u) == 0u) { if (xb_ld(&(bar)[XB_TMO])) break; if (_sp > XB_SPIN_CAP) { atomicAdd(&(bar)[XB_TMO], 1u); break; } } } } while (0)

struct XcdBarrier {
    unsigned* bar; unsigned x;
    volatile LAS unsigned* st;
};

__device__ __forceinline__ XcdBarrier xcd_barrier_post(unsigned* bar, volatile LAS unsigned* st) {
    XcdBarrier b; b.bar = bar; b.x = xb_xcc_id(); b.st = st;
    if (threadIdx.x == 0) (void)xb_add(&bar[XB_XCNT(b.x)], 1u);
    return b;
}
__device__ __forceinline__ void xcd_barrier_complete(unsigned* bar, unsigned x, unsigned& nloc, unsigned& nx) {
    const unsigned G = gridDim.x * gridDim.y * gridDim.z;
    unsigned sum, cnt, mine, sp = 0u;
    for (;;) {
        sum = 0u; cnt = 0u; mine = 0u;
#pragma unroll
        for (unsigned j = 0; j < 16; ++j) { const unsigned c = xb_ld(&bar[XB_XCNT(j)]); sum += c; cnt += (c > 0u) ? 1u : 0u; mine = (j == x) ? c : mine; }
        if (sum == G) break;
        __builtin_amdgcn_s_sleep(1);
        if ((++sp & 255u) == 0u) { if (xb_ld(&bar[XB_TMO])) break; if (sp > XB_SPIN_CAP) { atomicAdd(&bar[XB_TMO], 1u); break; } }
    }
    nloc = mine > 0u ? mine : 1u; nx = cnt > 0u ? cnt : 1u;
}

__device__ __forceinline__ void xcd_barrier(const XcdBarrier& b) {
    asm volatile("s_waitcnt vmcnt(0)" ::: "memory");
    __syncthreads();
    if (threadIdx.x == 0) {
        unsigned* bar = b.bar;
        __builtin_amdgcn_s_waitcnt(0);
        unsigned nloc = b.st[0], nx = b.st[1];
        if (nloc == 0u) { xcd_barrier_complete(bar, b.x, nloc, nx); b.st[0] = nloc; b.st[1] = nx; }
        const unsigned old = xb_add(&bar[XB_XSUB(b.x)], 1u);
        const unsigned gen = old / nloc;
        if (old + 1u == (gen + 1u) * nloc) {
            __builtin_amdgcn_fence(__ATOMIC_RELEASE, "agent");
            asm volatile("s_waitcnt vmcnt(0)" ::: "memory");
            const unsigned og = xb_add(&bar[XB_TOP], 1u);
            const unsigned tg = og / nx;
            if (og + 1u == (tg + 1u) * nx) xb_add(&bar[XB_TOPGEN], 1u);
            else XB_SPIN(xb_ld(&bar[XB_TOPGEN]) == tg, bar);
            __builtin_amdgcn_fence(__ATOMIC_ACQUIRE, "agent");
            xb_add(&bar[XB_XGEN(b.x)], 1u);
            asm volatile("s_waitcnt vmcnt(0)" ::: "memory");
        } else {
            XB_SPIN(xb_ld(&bar[XB_XGEN(b.x)]) == gen, bar);
            __builtin_amdgcn_fence(__ATOMIC_ACQUIRE, "agent");
            asm volatile("s_waitcnt vmcnt(0)" ::: "memory");
        }
    }
    __syncthreads();
}

constexpr int NPHASE = 13;
struct Args { const float* in[40]; float* out; unsigned char* ws; int ph_lo, ph_hi; };
enum { I_XP = 0, I_XS, I_MEM, I_CCKV, I_CKPE, I_SCONV, I_SLRU, I_CMK, I_CMV, I_F1N, I_F1W1, I_F1W3, I_F1W2, I_MIXN, I_WIN, I_QN, I_WUQ, I_KVN, I_WUKV, I_CONVW, I_CONVB,
       I_LWA, I_LBA, I_LWX, I_LBX, I_LAM, I_AON, I_LON, I_WOUT, I_MEMN, I_XAN, I_WMQ, I_WMK, I_WMV, I_WMO, I_F2N, I_F2W1, I_F2W3, I_F2W2, I_FINN };

#define ssq0 ((float*)(ws + WS_SSQ))
#define ssq1 ((float*)(ws + WS_SSQ) + 1 * MT)
#define ssq2 ((float*)(ws + WS_SSQ) + 2 * MT)
#define ssq3 ((float*)(ws + WS_SSQ) + 3 * MT)
#define ssq4 ((float*)(ws + WS_SSQ) + 4 * MT)
#define ssqq ((float*)(ws + WS_SSQ) + 5 * MT)
#define ssqa ((float*)(ws + WS_SSQ) + 6 * MT)
#define W13_1 ((bf16_t*)(ws + WS_W13_1))
#define W2_1 ((bf16_t*)(ws + WS_W2_1))
#define W13_2 ((bf16_t*)(ws + WS_W13_2))
#define W2_2 ((bf16_t*)(ws + WS_W2_2))
#define WIN ((bf16_t*)(ws + WS_WIN))
#define WUQ ((bf16_t*)(ws + WS_WUQ))
#define WK ((bf16_t*)(ws + WS_WK))
#define WV ((bf16_t*)(ws + WS_WV))
#define WOUT ((bf16_t*)(ws + WS_WOUT))
#define WMQ ((bf16_t*)(ws + WS_WMQ))
#define WMKV ((bf16_t*)(ws + WS_WMKV))
#define WMO ((bf16_t*)(ws + WS_WMO))
#define MEMB ((bf16_t*)(ws + WS_MEMB))
#define MKB ((bf16_t*)(ws + WS_MKB))
#define MVTB ((bf16_t*)(ws + WS_MVTB))
#define MVB ((bf16_t*)(ws + WS_MVB))
#define CMKB ((bf16_t*)(ws + WS_CMKB))
#define CMVTB ((bf16_t*)(ws + WS_CMVTB))
#define XB ((bf16_t*)(ws + WS_XB))
#define HLOC ((bf16_t*)(out + O_Y))
#define ACUM ((bf16_t*)(out + O_Y) + (size_t)MT * 512)
#define HID ((bf16_t*)(ws + WS_HID))
#define CQ ((bf16_t*)(ws + WS_CQ))
#define CKVP ((bf16_t*)(ws + WS_CKVP))
#define CKVS ((bf16_t*)(ws + WS_CKVS))
#define XBR ((bf16_t*)(ws + WS_XBR))
#define MERGED ((bf16_t*)(ws + WS_MERGED))
#define GG ((bf16_t*)(ws + WS_GG))
#define Q ((bf16_t*)(ws + WS_Q))
#define KNP ((bf16_t*)(ws + WS_KNP))
#define KNS ((bf16_t*)(ws + WS_KNS))
#define VTP ((bf16_t*)(ws + WS_VTP))
#define VTS (((bf16_t*)(ws + WS_VTP)) + TP)
#define KPEP ((bf16_t*)(ws + WS_KPEP))
#define KPES ((bf16_t*)(ws + WS_KPES))
#define QM ((bf16_t*)(ws + WS_QM))
#define ATOT ((float*)(ws + WS_ATOT))
#define ACCB(i) ((float*)(ws + WS_ACC) + (size_t)(i) * TS * DM)
#define FLAGW(i) ((unsigned*)(ws + WS_BAR) + 3584 + 64 * (i))
#define XSA ((float*)(ws + WS_XSA))
#define XSB ((float*)(ws + WS_XSB))
#define BTOT ((float*)(ws + WS_BTOT))
__global__ void __launch_bounds__(NTHR, 2) mk_fwd(Args a) {
    extern __shared__ __attribute__((aligned(16))) unsigned char lds_raw[];
    LAS unsigned char* lds = (LAS unsigned char*)lds_raw;
    cg::grid_group grid = cg::this_grid();
    const int wave = __builtin_amdgcn_readfirstlane((int)threadIdx.x >> 6);
#define tid ((int)threadIdx.x)
#define lane ((int)threadIdx.x & 63)
    const __attribute__((address_space(4))) char* kargp = (const __attribute__((address_space(4))) char*)__builtin_amdgcn_kernarg_segment_ptr();
#define INP(i) (*(const float* const volatile __attribute__((address_space(4)))*)(kargp + 8 * (i)))
#define out (*(float* const volatile __attribute__((address_space(4)))*)(kargp + 320))
#define ws (*(unsigned char* const volatile __attribute__((address_space(4)))*)(kargp + 328))
#define lo (*(const volatile int __attribute__((address_space(4)))*)(kargp + 336))
#define hi (*(const volatile int __attribute__((address_space(4)))*)(kargp + 340))
#define G ((int)gridDim.x)
#define blk ((int)blockIdx.x)
#define vcu ((G % 8 == 0) ? (blk % 8) * (G / 8) + blk / 8 : blk)
#define gw (blk * NWAVE + wave)
#define NGW (G * NWAVE)
#define gtid ((size_t)blk * NTHR + tid)
#define NGT ((size_t)G * NTHR)
#define X (out + O_Y)
#ifndef PHMASK
#define PHMASK 0x1FFF
#endif
#define IN(k) (((PHMASK >> (k)) & 1) && lo <= (k) && (k) < hi)
    volatile LAS unsigned* xst = (volatile LAS unsigned*)(lds + LDS_EPI + 8192);
    if (tid == 0) { xst[0] = 0u; xst[1] = 0u; }
    __syncthreads();
    { XcdBarrier b0 = xcd_barrier_post((unsigned*)(ws + WS_BAR), xst); (void)b0; }
    if (hi > 1000) grid.sync();
#define SEAM(k) do { if (IN(k) && IN((k) + 1)) { XcdBarrier b_; b_.bar = (unsigned*)(ws + WS_BAR); b_.x = xb_xcc_id(); b_.st = xst; xcd_barrier(b_); } } while (0)

    constexpr int I_FFN = 16 * 88, I_W2 = 44 * 32, I_IN = 16 * 53, I_UQ = 6 * 24, I_UKV = 4 * 32, I_SQ = 16 * 32, I_CMVI = 8 * 128;
    constexpr int NITEMS = 4 * I_FFN + 2 * I_W2 + I_IN + I_UQ + I_UKV + 5 * I_SQ + I_CMVI, NA = 2 * I_FFN + 2 * I_SQ;
    auto do_item = [&](int it) {
        LAS float* scr = (LAS float*)(lds + wave * 16384);
        int r = it;
#define TRJ(NI, W, K_, N_, DST, LDD, GAIN, MAP) if (r < (NI)) { const int nb_ = (N_) / 32, kb = r / nb_, n0 = (r % nb_) * 32; tr_item((W), (N_), kb * 64, n0, (DST), (MAP), (LDD), (GAIN), scr, lane); return; } r -= (NI)
        TRJ(I_FFN, INP(I_F1W1), 1024, FF, W13_1, 1024, INP(I_F1N), (n0 >> 7) * 256 + (n0 & 127));
        TRJ(I_FFN, INP(I_F1W3), 1024, FF, W13_1, 1024, INP(I_F1N), (n0 >> 7) * 256 + 128 + (n0 & 127));
        TRJ(I_SQ, INP(I_WMK), 1024, 1024, WMKV, 1024, (const float*)nullptr, n0);
        TRJ(I_SQ, INP(I_WMV), 1024, 1024, WMKV, 1024, (const float*)nullptr, 1024 + n0);
        TRJ(I_W2, INP(I_F1W2), FF, 1024, W2_1, FF, (const float*)nullptr, n0);
        TRJ(I_IN, INP(I_WIN), 1024, 1696, WIN, 1024, INP(I_MIXN), (n0 < 384 ? 256 + n0 : (n0 < 640 ? n0 - 384 : (n0 < 672 ? n0 : n0 + 96))));
        TRJ(I_UQ, INP(I_WUQ), 384, 768, WUQ, 384, INP(I_QN), n0);
        TRJ(I_UKV, INP(I_WUKV), 256, 1024, WK, 256, (const float*)nullptr, ((n0 & 127) < 64 ? (n0 >> 7) * 64 + (n0 & 127) : 512 + (n0 >> 7) * 64 + (n0 & 127) - 64));
        TRJ(I_SQ, INP(I_WOUT), 1024, 1024, WOUT, 1024, (kb < 8 ? INP(I_AON) : (const float*)nullptr), n0);
        TRJ(I_SQ, INP(I_WMQ), 1024, 1024, WMQ, 1024, INP(I_XAN), n0);
        TRJ(I_SQ, INP(I_WMO), 1024, 1024, WMO, 1024, (const float*)nullptr, n0);
        TRJ(I_FFN, INP(I_F2W1), 1024, FF, W13_2, 1024, INP(I_F2N), (n0 >> 7) * 256 + (n0 & 127));
        TRJ(I_FFN, INP(I_F2W3), 1024, FF, W13_2, 1024, INP(I_F2N), (n0 >> 7) * 256 + 128 + (n0 & 127));
        TRJ(I_W2, INP(I_F2W2), FF, 1024, W2_2, FF, (const float*)nullptr, n0);
        { const int bb = r >> 7, rr = r & 127, kb = rr >> 5, n0 = (rr & 31) * 32;
          tr_item(INP(I_CMV) + (size_t)bb * 256 * 1024, 1024, kb * 64, n0, CMVTB + (size_t)bb * 1024 * 256, n0, 256, (const float*)nullptr, scr, lane); }
#undef TRJ
    };
    if (IN(0)) {
        { const int ngw0_ = NGW; const int nfirst = (G == 256) ? NA : NITEMS;
          for (int it = gw; it < nfirst; it += ngw0_) do_item(it); }
        const float* xp_ = INP(I_XP); const float* xs_ = INP(I_XS); const float* mem_ = INP(I_MEM); const float* cmk_ = INP(I_CMK); const float* memn_ = INP(I_MEMN);
        bf16_t* xb_ = XB; bf16_t* memb_ = MEMB; bf16_t* cmkb_ = CMKB; float* ssq0_ = ssq0; const int ngw_ = NGW;
        for (int m = gw; m < MT + 256 + 2048; m += ngw_) {
            const float* src; bf16_t* dst; int kind;
            if (m < TP) { src = xp_ + (size_t)m * DM; dst = xb_ + (size_t)m * DM; kind = 0; }
            else if (m < MT) { src = xs_ + (size_t)(m - TP) * DM; dst = xb_ + (size_t)m * DM; kind = 0; }
            else if (m < MT + 256) { src = mem_ + (size_t)(m - MT) * DM; dst = memb_ + (size_t)(m - MT) * DM; kind = 1; }
            else { src = cmk_ + (size_t)(m - MT - 256) * DM; dst = cmkb_ + (size_t)(m - MT - 256) * DM; kind = 2; }
            f32x4 v[4]; float s = 0.f;
#pragma unroll
            for (int j = 0; j < 4; ++j) { v[j] = *((const f32x4*)src + lane + 64 * j); s += (v[j][0] * v[j][0] + v[j][1] * v[j][1]) + (v[j][2] * v[j][2] + v[j][3] * v[j][3]); }
            if (kind != 2) s = wave_sum(s);
            if (kind == 0 && lane == 0) ssq0_[m] = s;
            if (kind == 1) { const float rs = __builtin_amdgcn_rsqf(s * (1.0f / 1024.0f) + EPS);
#pragma unroll
                for (int j = 0; j < 4; ++j) v[j] = v[j] * rs * *((const f32x4*)memn_ + lane + 64 * j); }
#pragma unroll
            for (int j = 0; j < 4; ++j) *((u32x2*)dst + lane + 64 * j) = (u32x2){pk2(v[j][0], v[j][1]), pk2(v[j][2], v[j][3])};
        }
        { float* z_ = ssq1; u32x4* wz_ = (u32x4*)(WIN + (size_t)672 * 1024); const size_t ngt_ = NGT;
          for (size_t i = gtid; i < (size_t)6 * MT; i += ngt_) z_[i] = 0.f;
          { f32x4* za_ = (f32x4*)ACCB(0); for (size_t i = gtid; i < (size_t)5 * TS * DM / 4; i += ngt_) za_[i] = (f32x4){0.f, 0.f, 0.f, 0.f}; }
          for (size_t i = gtid; i < (size_t)96 * 1024 / 8; i += ngt_) wz_[i] = (u32x4){0, 0, 0, 0}; }
    }
    SEAM(0);

    if (IN(1)) {
        { pg8::Gemm g{XB, W13_1, MT, 2 * FF, 1024, 1024, 1024}; pg8::Order S; S.init(MT, 2 * FF, G, blk, 0); pg8::EpiUp E{HID, ssq0};
          pg8::gemm_phase<pg8::EpiUp, pg8::Order, true, true>(lds, g, S, E); }
        { pg8::Gemm g{MEMB, WMKV, 256, 2048, 1024, 1024, 1024}; pg8::Order S; S.init(256, 2048, G, blk, 144); pg8::EpiMem E{out + O_MKP, out + O_MVP, MKB, MVB};
          pg8::gemm_phase<pg8::EpiMem, pg8::Order, true, true>(lds, g, S, E); }
        if (G == 256 && blk >= 152) { for (int it = NA + (blk - 152) * NWAVE + wave; it < NITEMS; it += (256 - 152) * NWAVE) do_item(it); }
    }
    SEAM(1);
    if (IN(2)) {
        { pg8::Gemm g{HID, W2_1, TP, 1024, FF, FF, FF}; pg8::Order S; S.init(TP, 1024, G, blk, 0);
          pg8::EpiRes E{XB, ssq1, nullptr, 0.f, 0.5f};
          pg8::gemm_phase<pg8::EpiRes, pg8::Order, true, true>(lds, g, S, E); }
        { pg8::Gemm g{HID, W2_1, TS, 1024, 256, FF, FF, 512}; pg8::Order S; S.init(TS, 1024, G, blk, 0, 64, 11);
          pg8::EpiAcc E{ACCB(0), nullptr, 0.f, 0, 0.5f};
          pg8::gemm_phase<pg8::EpiAcc, pg8::Order, true, true>(lds, g, S, E); }
    }
    SEAM(2);
    if (IN(3)) {
        if (blk >= G - 8) sample_finalize_part(blk - (G - 8), INP(I_XS), ACCB(0), XSA, XB + (size_t)TP * DM, ssq1 + TP, FLAGW(0));
        pg8::EpiWin E{ssq1, INP(I_KVN), out, CQ, ssqq, CKVP, CKVS, KPEP, KPES, XBR, GG, (LAS float*)(lds + LDS_EPI)};
        { pg8::Gemm g{XB, WIN, TP, 1792, 1024, 1024, 1024}; pg8::Order S; S.init(TP, 1792, G, blk, 0);
          pg8::gemm_phase<pg8::EpiWin, pg8::Order, true, true>(lds, g, S, E); }
        { pg8::Gemm g{XB, WIN, TS, 1792, 1024, 1024, 1024}; pg8::Order S; S.init(TS, 1792, G, blk, 192, 64); pg8::Unit u_;
          if (S.next(0, u_)) sample_wait(FLAGW(0), 8u);
          pg8::gemm_phase<pg8::EpiWin, pg8::Order, true, true>(lds, g, S, E); }
        if (G != 256 || blk >= 200) {
        { const f32x4* cckv_ = (const f32x4*)INP(I_CCKV); const f32x4* ckpe_ = (const f32x4*)INP(I_CKPE); bf16_t* ckvs_ = CKVS; bf16_t* kpes_ = KPES; bf16_t* mvtb_ = MVTB; const bf16_t* mvb_ = MVB; const bool idl_ = (G == 256); const size_t ngt_ = idl_ ? (size_t)(256 - 200) * NTHR : NGT; const size_t g0_ = idl_ ? (size_t)(blk - 200) * NTHR + tid : gtid;
          for (size_t i = g0_; i < (size_t)NBAT * PAST * 64; i += ngt_) { const size_t rw = i >> 6; const int c4 = (int)(i & 63); const int b = (int)(rw / PAST), t = (int)(rw % PAST);
              const f32x4 v = cckv_[i]; *(u32x2*)(ckvs_ + ((size_t)b * SKV + t) * 256 + c4 * 4) = (u32x2){pk2(v[0], v[1]), pk2(v[2], v[3])}; }
          for (size_t i = g0_; i < (size_t)NBAT * PAST * 8; i += ngt_) { const size_t rw = i >> 3; const int c4 = (int)(i & 7); const int b = (int)(rw / PAST), t = (int)(rw % PAST);
              const f32x4 v = ckpe_[i]; *(u32x2*)(kpes_ + ((size_t)b * SKV + t) * 32 + c4 * 4) = (u32x2){pk2(v[0], v[1]), pk2(v[2], v[3])}; }
          for (size_t i = g0_; i < (size_t)1024 * 256; i += ngt_) { const int d = (int)(i >> 8), k = (int)(i & 255); mvtb_[i] = mvb_[(size_t)k * DM + d]; } }
        }
    }
    SEAM(3);
    if (IN(4)) {
        { pg8::Gemm g{CQ, WUQ, MT, 768, QL, QL, QL}; pg8::Order S; S.init(MT, 768, G, blk, 0); pg8::EpiQ E{Q, ssqq};
          pg8::gemm_phase<pg8::EpiQ, pg8::Order, true, true>(lds, g, S, E); }
        { pg8::Gemm g{CKVP, WK, TP + MT, 512, 256, 256, 256}; pg8::Order S; S.init(TP + MT, 512, G, blk, 192); pg8::EpiStore E{KNP, 512, nullptr, 0.f, 1.f};
          pg8::gemm_phase<pg8::EpiStore, pg8::Order, true, true>(lds, g, S, E); }
        { pg8::Gemm g{WV, CKVP, 512, TP + MT, 256, 256, 256}; pg8::Order S; S.init(512, TP + MT, G, blk, 192); pg8::EpiStore E{VTP, VT_LD, nullptr, 0.f, 1.f};
          pg8::gemm_phase<pg8::EpiStore, pg8::Order, true, true>(lds, g, S, E); }
        const LruArgs LA{XBR, INP(I_CONVW), INP(I_CONVB), INP(I_LWA), INP(I_LBA), INP(I_LWX), INP(I_LBX), INP(I_LAM), INP(I_SCONV), INP(I_SLRU), HLOC, ACUM, ATOT, BTOT, out};
        { const int g_ = G; for (int u = (blk + g_ - (199 % g_)) % g_; u < 256; u += g_) lru_l1_unit(lds, u, LA); }
    }
    SEAM(4);
    if (IN(5)) {
        const int g_ = G; bf16_t* merged_ = MERGED; float* ssqa_ = ssqa; float* out_ = out;
        { const bf16_t* hloc_ = HLOC; const bf16_t* acum_ = ACUM; const bf16_t* gg_ = GG; const float* atot_ = ATOT; const float* btot_ = BTOT; const float* lon_ = INP(I_LON);
          for (int u = blk; u < 256; u += g_) lru_l3_unit(lds, u, hloc_, acum_, gg_, atot_, btot_, lon_, merged_, out_);
          const LruArgs LA{XBR, INP(I_CONVW), INP(I_CONVB), INP(I_LWA), INP(I_LBA), INP(I_LWX), INP(I_LBX), INP(I_LAM), INP(I_SCONV), INP(I_SLRU), HLOC, ACUM, ATOT, BTOT, out};
          for (int u = (blk + g_ - (128 % g_)) % g_; u < 8; u += g_) { lru_l1_unit(lds, 256 + u, LA); asm volatile("s_waitcnt vmcnt(0)" ::: "memory"); __syncthreads();
              lru_l3_unit(lds, 256 + u, hloc_, acum_, gg_, atot_, btot_, lon_, merged_, out_); } }
        { const bf16_t* q_ = Q; const bf16_t* knp_ = KNP; const bf16_t* kpep_ = KPEP; const bf16_t* vtp_ = VTP;
          for (int p = vcu; p < 256; p += g_) {
              const int h = p >> 5, s = p & 31;
              mla_prompt_unit(lds, h, 63 - s, q_, knp_, kpep_, vtp_, merged_, ssqa_);
              mla_prompt_unit(lds, h, s, q_, knp_, kpep_, vtp_, merged_, ssqa_);
          }
          const bf16_t* kns_ = KNS; const bf16_t* kpes_ = KPES; const bf16_t* vts_ = VTS;
          for (int u = blk; u < 64; u += g_) mla_sample_unit(lds, u >> 3, u & 7, q_, kns_, kpes_, vts_, merged_, ssqa_); }
    }
    SEAM(5);
    if (IN(6)) {
        { pg8::Gemm g{MERGED, WOUT, TP, 1024, 1024, 1024, 1024}; pg8::Order S; S.init(TP, 1024, G, blk, 0);
          pg8::EpiResMid E{{XB, ssq2, nullptr, 0.f, 1.f}, ssqa};
          pg8::gemm_phase<pg8::EpiResMid, pg8::Order, true, true>(lds, g, S, E); }
        { pg8::Gemm g{MERGED, WOUT, TS, 1024, 256, 1024, 1024, 512}; pg8::Order Ss; Ss.init(TS, 1024, G, blk, 0, 64, 4);
          pg8::EpiAcc E{ACCB(1), ssqa, 1.0f / 512.0f, 2, 1.f};
          pg8::gemm_phase<pg8::EpiAcc, pg8::Order, true, true>(lds, g, Ss, E); }
    }
    SEAM(6);
    if (IN(7)) {
        if (blk >= G - 8) sample_finalize_part(blk - (G - 8), XSA, ACCB(1), XSB, XB + (size_t)TP * DM, ssq2 + TP, FLAGW(1));
        { pg8::Gemm g{XB, WMQ, TP, 1024, 1024, 1024, 1024}; pg8::Order S; S.init(TP, 1024, G, blk, 0); pg8::EpiStore E{QM, 1024, ssq2, 1.0f / 1024.0f, XSCALE};
          pg8::gemm_phase<pg8::EpiStore, pg8::Order, true, true>(lds, g, S, E);
          asm volatile("s_waitcnt vmcnt(0)" ::: "memory"); __syncthreads();
          bf16_t* qm_ = QM; const bf16_t* mkb_ = MKB; const bf16_t* mvtb_ = MVTB; pg8::Unit u_;
          for (int i = 0; S.next(i, u_); ++i) xattn_unit(lds, u_.pm * 256, false, u_.pn, qm_, mkb_, mvtb_, nullptr, nullptr); }
        { pg8::Gemm g{XB, WMQ, TS, 1024, 256, 1024, 1024, 512}; pg8::Order S; S.init(TS, 1024, G, blk, 0, 64, 4); pg8::Unit u_;
          if (S.next(0, u_)) sample_wait(FLAGW(1), 8u);
          pg8::EpiAcc E{ACCB(2), nullptr, 0.f, 0, 1.f};
          pg8::gemm_phase<pg8::EpiAcc, pg8::Order, true, true>(lds, g, S, E); }
    }
    SEAM(7);
    if (IN(9)) {
        { const int g_ = G; bf16_t* qm_ = QM; const bf16_t* cmkb_ = CMKB; const bf16_t* cmvtb_ = CMVTB; const float* qacc_ = ACCB(2); const float* ssq2_ = ssq2;
          for (int u = g_ - 1 - blk; u < 32; u += g_) { const int b = u >> 2;
              xattn_unit(lds, TP + b * 32, true, u & 3, qm_, cmkb_ + (size_t)b * 256 * DM, cmvtb_ + (size_t)b * 1024 * 256, qacc_, ssq2_);
              asm volatile("s_waitcnt vmcnt(0)" ::: "memory"); __syncthreads();
              if (tid == 0) { __builtin_amdgcn_fence(__ATOMIC_RELEASE, "agent"); asm volatile("s_waitcnt vmcnt(0)" ::: "memory"); __hip_atomic_fetch_add(FLAGW(3), 1u, __ATOMIC_RELAXED, __HIP_MEMORY_SCOPE_AGENT); } } }
        { pg8::Gemm g{QM, WMO, TP, 1024, 1024, 1024, 1024}; pg8::Order S; S.init(TP, 1024, G, blk, 0);
          pg8::EpiRes E{XB, ssq3, nullptr, 0.f, 1.f};
          pg8::gemm_phase<pg8::EpiRes, pg8::Order, true, true>(lds, g, S, E); }
        { pg8::Gemm g{QM, WMO, TS, 1024, 256, 1024, 1024, 512}; pg8::Order S; S.init(TS, 1024, G, blk, 0, 64, 4); pg8::Unit u_;
          if (S.next(0, u_)) sample_wait(FLAGW(3), 32u);
          pg8::EpiAcc E{ACCB(3), nullptr, 0.f, 0, 1.f};
          pg8::gemm_phase<pg8::EpiAcc, pg8::Order, true, true>(lds, g, S, E); }
    }
    SEAM(9);
    if (IN(10)) {
        if (blk >= G - 8) sample_finalize_part(blk - (G - 8), XSB, ACCB(3), XSA, XB + (size_t)TP * DM, ssq3 + TP, FLAGW(2));
        pg8::EpiUp E{HID, ssq3};
        { pg8::Gemm g{XB, W13_2, TP, 2 * FF, 1024, 1024, 1024}; pg8::Order S; S.init(TP, 2 * FF, G, blk, 0);
          pg8::gemm_phase<pg8::EpiUp, pg8::Order, true, true>(lds, g, S, E); }
        { pg8::Gemm g{XB, W13_2, TS, 2 * FF, 1024, 1024, 1024}; pg8::Order S; S.init(TS, 2 * FF, G, blk, 128, 64); pg8::Unit u_;
          if (S.next(0, u_)) sample_wait(FLAGW(2), 8u);
          pg8::gemm_phase<pg8::EpiUp, pg8::Order, true, true>(lds, g, S, E); }
    }
    SEAM(10);
    if (IN(11)) {
        { pg8::Gemm g{HID, W2_2, TP, 1024, FF, FF, FF}; pg8::Order S; S.init(TP, 1024, G, blk, 0);
          pg8::EpiRes E{XB, ssq4, nullptr, 0.f, 0.5f};
          pg8::gemm_phase<pg8::EpiRes, pg8::Order, true, true>(lds, g, S, E); }
        { pg8::Gemm g{HID, W2_2, TS, 1024, 256, FF, FF, 512}; pg8::Order S; S.init(TS, 1024, G, blk, 0, 64, 11);
          pg8::EpiAcc E{ACCB(4), nullptr, 0.f, 0, 0.5f};
          pg8::gemm_phase<pg8::EpiAcc, pg8::Order, true, true>(lds, g, S, E); }
    }
    SEAM(11);
    if (IN(12)) {
        float* x_ = X; const float* s4_ = ssq4; const f32x4* fn_ = (const f32x4*)INP(I_FINN); const int ngw_ = NGW; const float* xs_ = XSA; const float* acc_ = ACCB(4); const bf16_t* xb12_ = XB;
        for (int m = gw; m < MT; m += ngw_) {
            f32x4* xr = (f32x4*)(x_ + (size_t)m * DM);
            if (m < TP) {
                const float rs = __builtin_amdgcn_rsqf(s4_[m] * (1.0f / 1024.0f) + EPS);
                const u32x2* xbr = (const u32x2*)(xb12_ + (size_t)m * DM);
#pragma unroll
                for (int j = 0; j < 4; ++j) { const u32x2 b = xbr[lane + 64 * j]; const f32x4 v = (f32x4){__builtin_bit_cast(float, b[0] << 16), __builtin_bit_cast(float, b[0] & 0xffff0000u), __builtin_bit_cast(float, b[1] << 16), __builtin_bit_cast(float, b[1] & 0xffff0000u)};
                    xr[lane + 64 * j] = v * rs * fn_[lane + 64 * j]; }
            } else {
                const size_t r = (size_t)(m - TP) * DM; f32x4 v[4]; float s = 0.f;
#pragma unroll
                for (int j = 0; j < 4; ++j) { v[j] = *((const f32x4*)(xs_ + r) + lane + 64 * j) + *((const f32x4*)(acc_ + r) + lane + 64 * j);
                    s += (v[j][0] * v[j][0] + v[j][1] * v[j][1]) + (v[j][2] * v[j][2] + v[j][3] * v[j][3]); }
                const float rs = __builtin_amdgcn_rsqf(wave_sum(s) * (1.0f / 1024.0f) + EPS);
#pragma unroll
                for (int j = 0; j < 4; ++j) xr[lane + 64 * j] = v[j] * rs * fn_[lane + 64 * j];
            }
        }
    }
#undef IN
#undef SEAM
}

#undef INP
#undef X
#undef tid
#undef lane
#undef out
#undef ws
#undef lo
#undef hi
#undef G
#undef blk
#undef vcu
#undef gw
#undef NGW
#undef gtid
#undef NGT
#ifndef MK_N_LAUNCHES
#define MK_N_LAUNCHES 1
#endif
extern "C" void kernel_launch(void* const* d_in, const int* in_sizes, int n_in, void* d_out, int out_size, void* d_ws, size_t ws_size, hipStream_t stream) {
    static int grid = 0;
    if (grid == 0) {
        int dev = 0, cus = 0, per_cu = 0;
        hipGetDevice(&dev);
        hipDeviceGetAttribute(&cus, hipDeviceAttributeMultiprocessorCount, dev);
        if (hipFuncSetAttribute((const void*)mk_fwd, hipFuncAttributeMaxDynamicSharedMemorySize, LDS_BYTES) != hipSuccess) fprintf(stderr, "kernel_launch: hipFuncSetAttribute failed\n");
        if (hipOccupancyMaxActiveBlocksPerMultiprocessor(&per_cu, (const void*)mk_fwd, NTHR, LDS_BYTES) != hipSuccess || per_cu < 1) { fprintf(stderr, "kernel_launch: occupancy query gave %d\n", per_cu); per_cu = 1; }
        (void)hipGetLastError();
        grid = cus * per_cu;
        if (n_in != 40 || ws_size < WS_END) { fprintf(stderr, "kernel_launch: unexpected n_in %d / ws %zu\n", n_in, ws_size); }
    }
    (void)hipMemsetAsync((unsigned char*)d_ws + WS_BAR, 0, 16384, stream);
    Args a{};
    for (int i = 0; i < 40; ++i) a.in[i] = (const float*)d_in[i];
    a.out = (float*)d_out; a.ws = (unsigned char*)d_ws;
#if MK_N_LAUNCHES == 1
    a.ph_lo = 0; a.ph_hi = NPHASE;
    void* args[] = {&a};
    hipError_t e = hipLaunchCooperativeKernel((const void*)mk_fwd, dim3(grid), dim3(NTHR), args, LDS_BYTES, stream);
    if (e != hipSuccess) fprintf(stderr, "kernel_launch: cooperative launch failed: %s (grid %d)\n", hipGetErrorString(e), grid);
#else
    for (int p = 0; p < NPHASE; ++p) { a.ph_lo = p; a.ph_hi = p + 1; hipLaunchKernelGGL(mk_fwd, dim3(grid), dim3(NTHR), LDS_BYTES, stream, a); }
#endif
}
```

```cpp
#include <hip/hip_runtime.h>
#include <hip/hip_cooperative_groups.h>
#include <cstdio>
#include <cstdint>
namespace cg = cooperative_groups;

#define LAS __attribute__((address_space(3)))
typedef unsigned short bf16_t;
typedef short bf16x8 __attribute__((ext_vector_type(8)));
typedef short s16x4 __attribute__((ext_vector_type(4)));
typedef float f32x4 __attribute__((ext_vector_type(4)));
typedef float f32x16 __attribute__((ext_vector_type(16)));
typedef unsigned u32x4 __attribute__((ext_vector_type(4)));
typedef unsigned u32x2 __attribute__((ext_vector_type(2)));

constexpr int TP = 16384, TS = 256, MT = TP + TS, DM = 1024, FF = 2816, QL = 384, KVL = 256, NBAT = 8, DSEQ = 32, PAST = 2048, SKV = PAST + DSEQ  ;
constexpr int VT_LD = 33152;
constexpr int VTS_LD = VT_LD;
constexpr float EPS = 1e-6f;
constexpr float LOG2E = 1.4426950408889634f;
constexpr float QSCALE = 0.10206207261596575f * LOG2E;
constexpr float XSCALE = 0.0625f * LOG2E;
constexpr int NTHR = 512, NWAVE = 8;
constexpr int LDS_BYTES = 147456;
constexpr int LDS_EPI = 131072;

constexpr size_t O_Y = 0, O_YS = 16777216, O_CKVP = 17039360, O_KPEP = 21233664, O_CONVP = 21757952, O_LRUP = 21759488,
                 O_MKP = 21760000, O_MVP = 22022144, O_CKVS = 22284288, O_KPES = 22349824, O_CONVS = 22358016, O_LRUS = 22370304;

constexpr size_t U64K = 65536;
constexpr size_t WS_SSQ = 0;
constexpr size_t WS_BAR = 466944;
constexpr size_t WS_ATOT = 16 * U64K, WS_BTOT = 32 * U64K;
constexpr size_t WS_W13_1 = 64 * U64K;
constexpr size_t WS_W2_1 = WS_W13_1 + 176 * U64K;
constexpr size_t WS_W13_2 = WS_W2_1 + 88 * U64K;
constexpr size_t WS_W2_2 = WS_W13_2 + 176 * U64K;
constexpr size_t WS_WIN = WS_W2_2 + 88 * U64K;
constexpr size_t WS_WUQ = WS_WIN + 56 * U64K;
constexpr size_t WS_WK = WS_WUQ + 9 * U64K;
constexpr size_t WS_WV = WS_WK + 4 * U64K;
constexpr size_t WS_WOUT = WS_WV + 4 * U64K;
constexpr size_t WS_WMQ = WS_WOUT + 32 * U64K;
constexpr size_t WS_WMKV = WS_WMQ + 32 * U64K;
constexpr size_t WS_WMO = WS_WMKV + 64 * U64K;
constexpr size_t WS_MEMB = 52 * 16 * U64K;
constexpr size_t WS_MKB = WS_MEMB + 8 * U64K, WS_MVTB = WS_MKB + 8 * U64K, WS_MVB = WS_MVTB + 8 * U64K, WS_CMKB = WS_MVB + 8 * U64K, WS_CMVTB = WS_CMKB + 64 * U64K;
constexpr size_t WS_XB = 62 * 16 * U64K;
constexpr size_t WS_HLOC = WS_XB, WS_ACUM = WS_XB + 260 * U64K;
constexpr size_t WS_R = 95 * 16 * U64K;
constexpr size_t WS_HID = WS_R;
constexpr size_t WS_CQ = WS_R;
constexpr size_t WS_CKVP = WS_CQ + 195 * U64K;
constexpr size_t WS_CKVS = WS_CKVP + 128 * U64K;
constexpr size_t WS_XBR = WS_CKVS + 130 * U64K;
constexpr size_t WS_MERGED = WS_R;
constexpr size_t WS_GG = WS_R + 720 * U64K;
constexpr size_t WS_Q = WS_GG + 260 * U64K;
constexpr size_t WS_KNP = WS_Q + 390 * U64K;
constexpr size_t WS_KNS = WS_KNP + 256 * U64K;
constexpr size_t WS_VTP = WS_KNS + 261 * U64K;
constexpr size_t WS_VTS = WS_VTP + 256 * U64K;
constexpr size_t WS_KPEP = WS_VTS + 262 * U64K;
constexpr size_t WS_KPES = WS_KPEP + 16 * U64K;
constexpr size_t WS_QM = WS_R + 768 * U64K;
constexpr size_t WS_END = WS_KPES + 17 * U64K;
constexpr size_t WS_ACC = 248 * 16 * U64K;
constexpr size_t WS_XSA = 253 * 16 * U64K, WS_XSB = 254 * 16 * U64K;
static_assert(WS_WMO + 32 * U64K <= WS_MEMB && WS_CMVTB + 64 * U64K <= WS_XB && WS_XB + 520 * U64K <= WS_R, "ws map 1");
static_assert(WS_XBR + 260 * U64K <= WS_GG && WS_END <= WS_ACC && WS_HID + (size_t)MT * FF * 2 <= 256u * 16 * U64K, "ws map 2");

__device__ __forceinline__ unsigned f2bf(float f) { unsigned u = __builtin_bit_cast(unsigned, f); return (u + 0x7fffu + ((u >> 16) & 1u)) >> 16; }
__device__ __forceinline__ unsigned pk2(float lo, float hi) { unsigned r; asm volatile("v_cvt_pk_bf16_f32 %0, %1, %2" : "=v"(r) : "v"(lo), "v"(hi)); return r; }
__device__ __forceinline__ float bf2f(unsigned short b) { return __builtin_bit_cast(float, (unsigned)b << 16); }
__device__ __forceinline__ float wave_sum(float v) {
#pragma unroll
    for (int o = 1; o < 64; o <<= 1) v += __shfl_xor(v, o);
    return v;
}
__device__ __forceinline__ void atomic_addf(float* p, float v) { __hip_atomic_fetch_add(p, v, __ATOMIC_RELAXED, __HIP_MEMORY_SCOPE_AGENT); }
__device__ __forceinline__ float sigmoidf_(float x) { return 1.f / (1.f + __expf(-x)); }
__device__ __forceinline__ float gelu_tanh(float v) { const float u = 1.5957691216057308f * (v + 0.044715f * v * v * v); return v * __builtin_amdgcn_rcpf(1.f + __builtin_amdgcn_exp2f(-LOG2E * u)); }
__device__ __forceinline__ void rope_cs(int pos, int j, float& c, float& s) {
    const float inv = __builtin_amdgcn_exp2f(-0.8304820237218406f * (float)j);
    const float ang = (float)pos * inv;
    const float k = rintf(ang * 0.15915494309189535f);
    float r = fmaf(-k, 6.28125f, ang); r = fmaf(-k, 0.0019353071795864769f, r);
    c = __cosf(r); s = __sinf(r);
}
namespace pg8 {
#define PG8_LAS __attribute__((address_space(3)))
typedef unsigned short bf16_t;
typedef short bf16x8 __attribute__((ext_vector_type(8)));
typedef float f32x4 __attribute__((ext_vector_type(4)));
typedef unsigned u32x4 __attribute__((ext_vector_type(4)));
constexpr int BM = 256, BK = 64, HALF = 128, HTB = HALF * BK * 2  , STAGE_BYTES = 8 * HTB, NXCD = 8, WGM = 8;

__host__ __device__ __forceinline__ int lds_byte(int r, int c) { const int st = (r >> 4) * 2 + (c >> 5), rr = r & 15, cc = c & 31, ob = rr * 64 + cc * 2; return st * 1024 + (ob ^ (((ob >> 9) & 1) << 5)); }
__host__ __device__ __forceinline__ void stage_rc(int b, int& R, int& C) { const int st = b / 1024, sb = b % 1024, swz = sb ^ (((sb >> 9) & 1) << 5); R = (st >> 1) * 16 + swz / 64; C = (st & 1) * 32 + (swz % 64) / 2; }
__host__ __device__ __forceinline__ int perm32(int rho) { const int n = rho >> 4, i = rho & 15; return 8 * (i >> 2) + 4 * n + (i & 3); }

struct Unit { int pm, pn, kc; };
struct Gemm { const bf16_t* A; const bf16_t* Bt; int M, N, K, lda, ldb, kcb; };

struct StaticOrder {
    int nM, nN, nwg, G, c;
    __host__ __device__ void init(int M, int N, int G_, int c_) { nM = M / BM; nN = N / BM; nwg = nM * nN; G = G_; c = c_; }
    __host__ __device__ bool next(int i, Unit& u) const {
        const long L = (long)i * G + c; if (L >= nwg) return false;
        int wgid = (int)L; { const int q = nwg / NXCD, r = nwg % NXCD, xcd = wgid % NXCD, off = wgid / NXCD; wgid = (xcd < r ? xcd * (q + 1) : r * (q + 1) + (xcd - r) * q) + off; }
        const int nig = WGM * nN, gid = wgid / nig, fm = gid * WGM, gsz = (nM - fm) < WGM ? (nM - fm) : WGM;
        u.pm = fm + ((wgid % nig) % gsz); u.pn = (wgid % nig) / gsz; u.kc = 0; return true;
    }
    __device__ __forceinline__ void a_ready(const Unit&) const {}
    __device__ __forceinline__ void done(const Unit&) const {}
};

__device__ __forceinline__ unsigned cvt_pk_bf16(float lo, float hi) { unsigned r; asm volatile("v_cvt_pk_bf16_f32 %0, %1, %2" : "=v"(r) : "v"(lo), "v"(hi)); return r; }

struct Order {
    int nM, nN, nK, nwg, G, c, pmo;
    __device__ __forceinline__ void init(int M, int N, int G_, int blk, int rot, int pm_off = 0, int nK_ = 1) { nM = M / BM; nN = N / BM; nK = nK_; nwg = nM * nN * nK_; G = G_; c = (blk + G_ - (rot % G_)) % G_; pmo = pm_off; }
    __device__ __forceinline__ bool next(int i, Unit& u) const {
        const long L = (long)i * G + c; if (L >= nwg) return false;
        int wgid = (int)L; { const int q = nwg / NXCD, r = nwg % NXCD, xcd = wgid % NXCD, off = wgid / NXCD; wgid = (xcd < r ? xcd * (q + 1) : r * (q + 1) + (xcd - r) * q) + off; }
        u.kc = wgid % nK; wgid /= nK;
        const int nig = WGM * nN, gid = wgid / nig, fm = gid * WGM, gsz = (nM - fm) < WGM ? (nM - fm) : WGM;
        u.pm = pmo + fm + ((wgid % nig) % gsz); u.pn = (wgid % nig) / gsz; return true;
    }
    __device__ __forceinline__ void a_ready(const Unit&) const {}
    __device__ __forceinline__ void done(const Unit&) const {}
};

struct EpiAcc {
    static constexpr bool PERM = false, AFTER_DRAIN = false, MIDSCALE = false, PREFETCH = false;
    float* ACC; const float* rs_in; float rs_invn; int kc_lim; float alpha;
    __device__ __forceinline__ void operator()(const f32x4 (&acc)[2][2][4][2], const Unit& u, int wr, int wc, int fr, int fq) const {
        const int col0 = u.pn * BM + wc * 32 + 4 * fq;
#pragma unroll
        for (int ai = 0; ai < 2; ++ai)
#pragma unroll
            for (int m = 0; m < 4; ++m) {
                const int rl = ai * HALF + wr * 64 + m * 16 + fr;
                float sc = alpha; if (rs_in && u.kc < kc_lim) sc *= __builtin_amdgcn_rsqf(rs_in[TP + rl] * rs_invn + EPS);
#pragma unroll
                for (int bj = 0; bj < 2; ++bj)
#pragma unroll
                    for (int n = 0; n < 2; ++n) {
                        float* p = ACC + (size_t)rl * DM + col0 + bj * HALF + n * 16; const f32x4 v = acc[ai][bj][m][n] * sc;
                        atomic_addf(p, v[0]); atomic_addf(p + 1, v[1]); atomic_addf(p + 2, v[2]); atomic_addf(p + 3, v[3]);
                    }
            }
    }
};

struct EpiUp {
    static constexpr bool PERM = true, AFTER_DRAIN = false, MIDSCALE = false, PREFETCH = true;
    bf16_t* H; const float* ssq;
    __device__ __forceinline__ void prefetch(float (&pre)[8], const Unit& u, int wr, int fr) const {
#pragma unroll
        for (int ai = 0; ai < 2; ++ai)
#pragma unroll
            for (int m = 0; m < 4; ++m) pre[ai * 4 + m] = ssq[u.pm * BM + ai * HALF + wr * 64 + m * 16 + fr];
    }
    __device__ __forceinline__ void operator()(const f32x4 (&acc)[2][2][4][2], const Unit& u, int wr, int wc, int fr, int fq, const float (&pre)[8]) const {
        const int col = u.pn * 128 + wc * 32 + 8 * fq;
#pragma unroll
        for (int ai = 0; ai < 2; ++ai)
#pragma unroll
            for (int m = 0; m < 4; ++m) {
                const int row = u.pm * BM + ai * HALF + wr * 64 + m * 16 + fr;
                const float r = __builtin_amdgcn_rsqf(pre[ai * 4 + m] * (1.0f / 1024.0f) + EPS);
                const float rl = -LOG2E * r, r2 = r * r;
                typedef float f32x2e __attribute__((ext_vector_type(2)));
                unsigned w[4];
#pragma unroll
                for (int n = 0; n < 2; ++n) {
                    const f32x4 ag = acc[ai][0][m][n], au = acc[ai][1][m][n];
#pragma unroll
                    for (int hh = 0; hh < 2; ++hh) {
                        const f32x2e g2 = (f32x2e){ag[2 * hh], ag[2 * hh + 1]}, u2 = (f32x2e){au[2 * hh], au[2 * hh + 1]};
                        const f32x2e e2 = g2 * rl; f32x2e d2 = (f32x2e){__builtin_amdgcn_exp2f(e2[0]), __builtin_amdgcn_exp2f(e2[1])} + 1.0f;
                        const f32x2e rc2 = (f32x2e){__builtin_amdgcn_rcpf(d2[0]), __builtin_amdgcn_rcpf(d2[1])};
                        const f32x2e v2 = (g2 * u2) * (rc2 * r2);
                        w[2 * n + hh] = cvt_pk_bf16(v2[0], v2[1]);
                    }
                }
                *(u32x4*)(H + (size_t)row * FF + col) = (u32x4){w[0], w[1], w[2], w[3]};
            }
    }
};

struct EpiRes {
    static constexpr bool PERM = true, AFTER_DRAIN = false, MIDSCALE = false, PREFETCH = false;
    bf16_t* XB; float* ssq_out; const float* rs_in; float rs_invn; float alpha;
    __device__ __forceinline__ void operator()(const f32x4 (&acc)[2][2][4][2], const Unit& u, int wr, int wc, int fr, int fq) const {
        const int col0 = u.pn * BM + wc * 32 + 8 * fq;
#pragma unroll
        for (int ai = 0; ai < 2; ++ai)
#pragma unroll
            for (int m = 0; m < 4; ++m) {
                const int row = u.pm * BM + ai * HALF + wr * 64 + m * 16 + fr;
                float sc = alpha; if (rs_in) sc *= __builtin_amdgcn_rsqf(rs_in[row] * rs_invn + EPS);
                float sq = 0.f;
#pragma unroll
                for (int bj = 0; bj < 2; ++bj) {
                    bf16_t* p = XB + (size_t)row * DM + col0 + bj * HALF;
                    const u32x4 b = *(const u32x4*)p; float o[8];
#pragma unroll
                    for (int k = 0; k < 4; ++k) { o[2 * k] = __builtin_bit_cast(float, b[k] << 16); o[2 * k + 1] = __builtin_bit_cast(float, b[k] & 0xffff0000u); }
#pragma unroll
                    for (int k = 0; k < 4; ++k) { o[k] += acc[ai][bj][m][0][k] * sc; o[4 + k] += acc[ai][bj][m][1][k] * sc; }
#pragma unroll
                    for (int k = 0; k < 8; ++k) sq += o[k] * o[k];
                    *(u32x4*)p = (u32x4){cvt_pk_bf16(o[0], o[1]), cvt_pk_bf16(o[2], o[3]), cvt_pk_bf16(o[4], o[5]), cvt_pk_bf16(o[6], o[7])};
                }
                if (ssq_out) { sq += __shfl_xor(sq, 16); sq += __shfl_xor(sq, 32); if (fq == 0) atomic_addf(ssq_out + row, sq); }
            }
    }
};

struct EpiResMid : EpiRes {
    static constexpr bool MIDSCALE = true;
    const float* ssqa;
    __device__ __forceinline__ void midscale(f32x4 (&acc)[2][2][4][2], const Unit& u, int wr, int fr) const {
#pragma unroll
        for (int ai = 0; ai < 2; ++ai)
#pragma unroll
            for (int m = 0; m < 4; ++m) {
                const float f = __builtin_amdgcn_rsqf(ssqa[u.pm * BM + ai * HALF + wr * 64 + m * 16 + fr] * (1.0f / 512.0f) + EPS);
#pragma unroll
                for (int bj = 0; bj < 2; ++bj)
#pragma unroll
                    for (int n = 0; n < 2; ++n) acc[ai][bj][m][n] *= f;
            }
    }
};

struct EpiStore {
    static constexpr bool PERM = true, AFTER_DRAIN = false, MIDSCALE = false, PREFETCH = false;
    bf16_t* O; int ldc; const float* rs_in; float rs_invn; float scale;
    __device__ __forceinline__ void operator()(const f32x4 (&acc)[2][2][4][2], const Unit& u, int wr, int wc, int fr, int fq) const {
        const int col0 = u.pn * BM + wc * 32 + 8 * fq;
#pragma unroll
        for (int ai = 0; ai < 2; ++ai)
#pragma unroll
            for (int m = 0; m < 4; ++m) {
                const int row = u.pm * BM + ai * HALF + wr * 64 + m * 16 + fr;
                float sc = scale; if (rs_in) sc *= __builtin_amdgcn_rsqf(rs_in[row] * rs_invn + EPS);
#pragma unroll
                for (int bj = 0; bj < 2; ++bj) {
                    const f32x4 v0 = acc[ai][bj][m][0] * sc, v1 = acc[ai][bj][m][1] * sc;
                    *(u32x4*)(O + (size_t)row * ldc + col0 + bj * HALF) = (u32x4){cvt_pk_bf16(v0[0], v0[1]), cvt_pk_bf16(v0[2], v0[3]), cvt_pk_bf16(v1[0], v1[1]), cvt_pk_bf16(v1[2], v1[3])};
                }
            }
    }
};

struct EpiMem {
    static constexpr bool PERM = false, AFTER_DRAIN = false, MIDSCALE = false, PREFETCH = false;
    float* outk; float* outv; bf16_t* KB; bf16_t* VB;
    __device__ __forceinline__ void operator()(const f32x4 (&acc)[2][2][4][2], const Unit& u, int wr, int wc, int fr, int fq) const {
        const bool isv = u.pn >= 4; const int col0 = (u.pn & 3) * BM + wc * 32 + 4 * fq;
        float* of = isv ? outv : outk; bf16_t* ob = isv ? VB : KB;
#pragma unroll
        for (int ai = 0; ai < 2; ++ai)
#pragma unroll
            for (int m = 0; m < 4; ++m) {
                const int row = ai * HALF + wr * 64 + m * 16 + fr;
#pragma unroll
                for (int bj = 0; bj < 2; ++bj)
#pragma unroll
                    for (int n = 0; n < 2; ++n) {
                        const int col = col0 + bj * HALF + n * 16; const f32x4 o = acc[ai][bj][m][n];
                        *(f32x4*)(of + (size_t)row * DM + col) = o;
                        *(u32x2*)(ob + (size_t)row * DM + col) = (u32x2){cvt_pk_bf16(o[0], o[1]), cvt_pk_bf16(o[2], o[3])};
                    }
            }
    }
};

struct EpiQ {
    static constexpr bool PERM = false, AFTER_DRAIN = false, MIDSCALE = false, PREFETCH = false;
    bf16_t* Q; const float* ssqq;
    __device__ __forceinline__ void operator()(const f32x4 (&acc)[2][2][4][2], const Unit& u, int wr, int wc, int fr, int fq) const {
#pragma unroll
        for (int ai = 0; ai < 2; ++ai)
#pragma unroll
            for (int m = 0; m < 4; ++m) {
                const int row = u.pm * BM + ai * HALF + wr * 64 + m * 16 + fr;
                const float sc = QSCALE * __builtin_amdgcn_rsqf(ssqq[row] * (1.0f / 384.0f) + EPS);
                const int pos = row < TP ? row : PAST + ((row - TP) & 31);
#pragma unroll
                for (int bj = 0; bj < 2; ++bj) {
                    const int gidx = u.pn * 8 + bj * 4 + wc; const int c0 = gidx * 32 + 4 * fq;
                    f32x4 v0 = acc[ai][bj][m][0] * sc, v1 = acc[ai][bj][m][1] * sc;
                    if (gidx % 3 == 2) {
#pragma unroll
                        for (int i = 0; i < 4; ++i) { float c, s; rope_cs(pos, 4 * fq + i, c, s); const float a = v0[i], b = v1[i]; v0[i] = a * c - b * s; v1[i] = b * c + a * s; }
                    }
                    *(u32x2*)(Q + (size_t)row * 768 + c0) = (u32x2){cvt_pk_bf16(v0[0], v0[1]), cvt_pk_bf16(v0[2], v0[3])};
                    *(u32x2*)(Q + (size_t)row * 768 + c0 + 16) = (u32x2){cvt_pk_bf16(v1[0], v1[1]), cvt_pk_bf16(v1[2], v1[3])};
                }
            }
    }
};

struct EpiWin {
    static constexpr bool PERM = false, AFTER_DRAIN = false, MIDSCALE = false, PREFETCH = false;
    const float* ssq1; const float* kvg; float* out; bf16_t* CQ; float* ssqq; bf16_t* CKVP; bf16_t* CKVS; bf16_t* KPEP; bf16_t* KPES; bf16_t* XBR; bf16_t* GG; LAS float* P;
    __device__ __forceinline__ void operator()(const f32x4 (&acc)[2][2][4][2], const Unit& u, int wr, int wc, int fr, int fq) const {
        const int pn = u.pn;
        if (pn == 0) {
#pragma unroll
            for (int ai = 0; ai < 2; ++ai)
#pragma unroll
                for (int m = 0; m < 4; ++m) {
                    const int row = u.pm * BM + ai * HALF + wr * 64 + m * 16 + fr;
                    const float r = __builtin_amdgcn_rsqf(ssq1[row] * (1.0f / 1024.0f) + EPS);
                    float sq = 0.f;
#pragma unroll
                    for (int bj = 0; bj < 2; ++bj)
#pragma unroll
                        for (int n = 0; n < 2; ++n) { const f32x4 v = acc[ai][bj][m][n] * r; sq += (v[0] * v[0] + v[1] * v[1]) + (v[2] * v[2] + v[3] * v[3]); }
                    sq += __shfl_xor(sq, 16); sq += __shfl_xor(sq, 32);
                    if (fq == 0) P[(ai * HALF + wr * 64 + m * 16 + fr) * 4 + wc] = sq;
                }
            asm volatile("s_waitcnt lgkmcnt(0)" ::: "memory"); __builtin_amdgcn_s_barrier(); asm volatile("" ::: "memory");
#pragma unroll
            for (int ai = 0; ai < 2; ++ai)
#pragma unroll
                for (int m = 0; m < 4; ++m) {
                    const int rl = ai * HALF + wr * 64 + m * 16 + fr; const int row = u.pm * BM + rl;
                    const f32x4 pp = *(const LAS f32x4*)(P + rl * 4);
                    const float rk = __builtin_amdgcn_rsqf(((pp[0] + pp[1]) + (pp[2] + pp[3])) * (1.0f / 256.0f) + EPS) * __builtin_amdgcn_rsqf(ssq1[row] * (1.0f / 1024.0f) + EPS);
                    float* of; bf16_t* ob;
                    if (row < TP) { of = out + O_CKVP + (size_t)row * 256; ob = CKVP + (size_t)row * 256; }
                    else { const int rs = row - TP; of = out + O_CKVS + (size_t)rs * 256; ob = CKVS + (size_t)((rs >> 5) * SKV + PAST + (rs & 31)) * 256; }
#pragma unroll
                    for (int bj = 0; bj < 2; ++bj)
#pragma unroll
                        for (int n = 0; n < 2; ++n) {
                            const int col = bj * HALF + wc * 32 + n * 16 + 4 * fq;
                            const f32x4 o = acc[ai][bj][m][n] * rk * *(const f32x4*)(kvg + col);
                            *(f32x4*)(of + col) = o; *(u32x2*)(ob + col) = (u32x2){cvt_pk_bf16(o[0], o[1]), cvt_pk_bf16(o[2], o[3])};
                        }
                }
            asm volatile("s_waitcnt lgkmcnt(0)" ::: "memory"); __builtin_amdgcn_s_barrier(); asm volatile("" ::: "memory");
            return;
        }
#pragma unroll
        for (int ai = 0; ai < 2; ++ai)
#pragma unroll
            for (int m = 0; m < 4; ++m) {
                const int row = u.pm * BM + ai * HALF + wr * 64 + m * 16 + fr;
                const float r = __builtin_amdgcn_rsqf(ssq1[row] * (1.0f / 1024.0f) + EPS);
                if (pn == 1 || pn == 2) {
                    float sq = 0.f;
#pragma unroll
                    for (int bj = 0; bj < 2; ++bj) {
                        if (pn == 2 && bj == 1) {
                            if (wc == 0) {
                                const int pos = row < TP ? row : PAST + ((row - TP) & 31);
                                f32x4 v0 = acc[ai][1][m][0] * r, v1 = acc[ai][1][m][1] * r;
#pragma unroll
                                for (int i = 0; i < 4; ++i) { float c, s; rope_cs(pos, 4 * fq + i, c, s); const float a = v0[i], b = v1[i]; v0[i] = a * c - b * s; v1[i] = b * c + a * s; }
                                float* of; bf16_t* ob;
                                if (row < TP) { of = out + O_KPEP + (size_t)row * 32; ob = KPEP + (size_t)row * 32; }
                                else { const int rs = row - TP; of = out + O_KPES + (size_t)rs * 32; ob = KPES + (size_t)((rs >> 5) * SKV + PAST + (rs & 31)) * 32; }
                                *(f32x4*)(of + 4 * fq) = v0; *(f32x4*)(of + 16 + 4 * fq) = v1;
                                *(u32x2*)(ob + 4 * fq) = (u32x2){cvt_pk_bf16(v0[0], v0[1]), cvt_pk_bf16(v0[2], v0[3])};
                                *(u32x2*)(ob + 16 + 4 * fq) = (u32x2){cvt_pk_bf16(v1[0], v1[1]), cvt_pk_bf16(v1[2], v1[3])};
                            }
                        } else {
#pragma unroll
                            for (int n = 0; n < 2; ++n) {
                                const int col = (pn - 1) * 256 + bj * HALF + wc * 32 + n * 16 + 4 * fq;
                                const f32x4 v = acc[ai][bj][m][n] * r;
                                *(u32x2*)(CQ + (size_t)row * QL + col) = (u32x2){cvt_pk_bf16(v[0], v[1]), cvt_pk_bf16(v[2], v[3])};
                                sq += (v[0] * v[0] + v[1] * v[1]) + (v[2] * v[2] + v[3] * v[3]);
                            }
                        }
                    }
                    sq += __shfl_xor(sq, 16); sq += __shfl_xor(sq, 32); if (fq == 0) atomic_addf(ssqq + row, sq);
                } else if (pn <= 4) {
                    float* cs = nullptr;
                    if (row < TP) { if (row >= TP - 3) cs = out + O_CONVP + (size_t)(row - (TP - 3)) * 512; }
                    else { const int rs = row - TP, t = rs & 31; if (t >= 29) cs = out + O_CONVS + (size_t)((rs >> 5) * 3 + (t - 29)) * 512; }
#pragma unroll
                    for (int bj = 0; bj < 2; ++bj)
#pragma unroll
                        for (int n = 0; n < 2; ++n) {
                            const int col = (pn - 3) * 256 + bj * HALF + wc * 32 + n * 16 + 4 * fq;
                            const f32x4 v = acc[ai][bj][m][n] * r;
                            *(u32x2*)(XBR + (size_t)row * 512 + col) = (u32x2){cvt_pk_bf16(v[0], v[1]), cvt_pk_bf16(v[2], v[3])};
                            if (cs) *(f32x4*)(cs + col) = v;
                        }
                } else {
#pragma unroll
                    for (int bj = 0; bj < 2; ++bj)
#pragma unroll
                        for (int n = 0; n < 2; ++n) {
                            const int col = (pn - 5) * 256 + bj * HALF + wc * 32 + n * 16 + 4 * fq;
                            const f32x4 v = acc[ai][bj][m][n] * r;
                            *(u32x2*)(GG + (size_t)row * 512 + col) = (u32x2){cvt_pk_bf16(gelu_tanh(v[0]), gelu_tanh(v[1])), cvt_pk_bf16(gelu_tanh(v[2]), gelu_tanh(v[3]))};
                        }
                }
            }
    }
};

template <class Epi, class Sched, bool ALIGN_EPI = false, bool SP2 = false>
__device__ __forceinline__ void gemm_phase(PG8_LAS unsigned char* lds, const Gemm g, const Sched& S, const Epi& E) {
    const int tid = threadIdx.x, wid = __builtin_amdgcn_readfirstlane(tid >> 6), lane = tid & 63, wr = wid >> 2, wc = wid & 3, fr = lane & 15, fq = lane >> 4;
    const int K = g.K, nt = K / BK;
    unsigned voffA[2], voffB[2];
#pragma unroll
    for (int i = 0; i < 2; ++i) { int R, C; stage_rc(tid * 16 + i * 8192, R, C); const int Rb = Epi::PERM ? ((R & ~31) + perm32(R & 31)) : R;
        voffA[i] = (unsigned)(R * g.lda + C) * 2u; voffB[i] = (unsigned)(Rb * g.ldb + C) * 2u; }
    const size_t kstep = (size_t)(BK * 2);
    const size_t hstepA = (size_t)HALF * g.lda * 2, hstepB = (size_t)HALF * g.ldb * 2;
    const size_t tstepA = 2 * hstepA, tstepB = 2 * hstepB;
    const unsigned ldsw = (unsigned)wid * 1024u;
    const int aoff = lds_byte(wr * 64 + fr, fq * 8), boff = lds_byte(wc * 32 + fr, fq * 8);
#define PG8_SA(b, h) (((b) * 2 + (h)) * HTB)
#define PG8_SB(b, h) ((4 + (b) * 2 + (h)) * HTB)
#define PG8_STAGE(bufoff, gbase, voff) do { _Pragma("unroll") for (int _i = 0; _i < 2; ++_i) \
        __builtin_amdgcn_global_load_lds((const unsigned*)((const char*)(gbase) + (voff)[_i]), (PG8_LAS unsigned*)(lds + (bufoff) + ldsw + _i * 8192), 16, 0, 0); } while (0)
#define PG8_LDA(dst, b, h) do { _Pragma("unroll") for (int m = 0; m < 4; ++m) _Pragma("unroll") for (int k = 0; k < 2; ++k) dst[m][k] = *(const PG8_LAS bf16x8*)(lds + PG8_SA(b, h) + aoff + m * 2048 + k * 1024); } while (0)
#define PG8_LDB(dst, b, h) do { _Pragma("unroll") for (int n = 0; n < 2; ++n) _Pragma("unroll") for (int k = 0; k < 2; ++k) dst[n][k] = *(const PG8_LAS bf16x8*)(lds + PG8_SB(b, h) + boff + n * 2048 + k * 1024); } while (0)
#define PG8_MMA(ai, bj, At, Bt) do { __builtin_amdgcn_s_setprio(1); _Pragma("unroll") for (int m = 0; m < 4; ++m) _Pragma("unroll") for (int n = 0; n < 2; ++n) _Pragma("unroll") for (int k = 0; k < 2; ++k) \
        acc[ai][bj][m][n] = __builtin_amdgcn_mfma_f32_16x16x32_bf16(Bt[n][k], At[m][k], acc[ai][bj][m][n], 0, 0, 0); __builtin_amdgcn_s_setprio(0); } while (0)
#define PG8_WAIT_V(n) asm volatile("s_waitcnt vmcnt(" #n ")" ::: "memory")
#define PG8_WAIT_L(n) asm volatile("s_waitcnt lgkmcnt(" #n ")" ::: "memory")
#define PG8_BAR __builtin_amdgcn_s_barrier()
#define PG8_SCHED __builtin_amdgcn_sched_barrier(0)
    Unit cur, nxt; int ui = 0;
    if (!S.next(0, cur)) return;
    f32x4 acc[2][2][4][2];
#pragma unroll
    for (int a = 0; a < 2; ++a)
#pragma unroll
        for (int b = 0; b < 2; ++b)
#pragma unroll
            for (int m = 0; m < 4; ++m)
#pragma unroll
                for (int n = 0; n < 2; ++n) acc[a][b][m][n] = (f32x4){0.f, 0.f, 0.f, 0.f};
    bf16x8 At[4][2], B0[2][2], B1[2][2];
    const char* cA = (const char*)g.A + (size_t)cur.pm * tstepA + (size_t)cur.kc * g.kcb; const char* cB = (const char*)g.Bt + (size_t)cur.pn * tstepB + (size_t)cur.kc * g.kcb;
    S.a_ready(cur);
    if constexpr (SP2) {
        PG8_STAGE(PG8_SB(0, 0), cB, voffB); PG8_STAGE(PG8_SB(0, 1), cB + hstepB, voffB); PG8_STAGE(PG8_SA(0, 0), cA, voffA); PG8_STAGE(PG8_SA(0, 1), cA + hstepA, voffA);
        if (wr == 1) PG8_BAR;
        PG8_WAIT_V(2); PG8_BAR;
        PG8_STAGE(PG8_SB(1, 0), cB + kstep, voffB); PG8_STAGE(PG8_SA(1, 0), cA + kstep, voffA); PG8_STAGE(PG8_SB(1, 1), cB + hstepB + kstep, voffB);
        PG8_WAIT_V(6); PG8_BAR;
    } else {
        PG8_STAGE(PG8_SB(0, 0), cB, voffB); PG8_STAGE(PG8_SA(0, 0), cA, voffA); PG8_STAGE(PG8_SB(0, 1), cB + hstepB, voffB); PG8_STAGE(PG8_SA(0, 1), cA + hstepA, voffA);
        if (wr == 1) PG8_BAR;
        PG8_WAIT_V(4); PG8_BAR;
        PG8_STAGE(PG8_SB(1, 0), cB + kstep, voffB); PG8_STAGE(PG8_SA(1, 0), cA + kstep, voffA); PG8_STAGE(PG8_SB(1, 1), cB + hstepB + kstep, voffB);
        PG8_WAIT_V(6); PG8_BAR;
    }
    for (;;) {
        const bool has_next = S.next(ui + 1, nxt);
        float epre[8];
        if constexpr (Epi::PREFETCH) E.prefetch(epre, cur, wr, fr);
        const char* nA = has_next ? (const char*)g.A + (size_t)nxt.pm * tstepA + (size_t)nxt.kc * g.kcb : cA; const char* nB = has_next ? (const char*)g.Bt + (size_t)nxt.pn * tstepB + (size_t)nxt.kc * g.kcb : cB;
_Pragma("unroll 1")
        for (int t = 0; t < nt; t += 2) {
            if constexpr (Epi::MIDSCALE) { if (t == nt / 2) E.midscale(acc, cur, wr, fr); }
            const bool last = (t == nt - 2);
            const char* a1 = cA + (size_t)(t + 1) * kstep;
            const char* a2 = last ? nA : cA + (size_t)(t + 2) * kstep; const char* b2 = last ? nB : cB + (size_t)(t + 2) * kstep;
            const char* a3 = a2 + kstep; const char* b3 = b2 + kstep;
            if (last && has_next) S.a_ready(nxt);
            if constexpr (SP2) {
            PG8_LDB(B0, 0, 0); PG8_LDB(B1, 0, 1); PG8_SCHED; PG8_LDA(At, 0, 0); PG8_STAGE(PG8_SA(1, 1), a1 + hstepA, voffA);
            PG8_WAIT_V(8); PG8_WAIT_L(0); PG8_BAR; PG8_MMA(0, 0, At, B0); PG8_MMA(0, 1, At, B1); PG8_BAR; PG8_SCHED;
            PG8_LDA(At, 0, 1); PG8_STAGE(PG8_SB(0, 0), b2, voffB); PG8_STAGE(PG8_SB(0, 1), b2 + hstepB, voffB); PG8_STAGE(PG8_SA(0, 0), a2, voffA);
            PG8_WAIT_V(8); PG8_WAIT_L(0); PG8_BAR; PG8_MMA(1, 0, At, B0); PG8_MMA(1, 1, At, B1); PG8_BAR; PG8_SCHED;
            PG8_LDB(B0, 1, 0); PG8_LDB(B1, 1, 1); PG8_SCHED; PG8_LDA(At, 1, 0); PG8_STAGE(PG8_SA(0, 1), a2 + hstepA, voffA);
            PG8_WAIT_V(8); PG8_WAIT_L(0); PG8_BAR; PG8_MMA(0, 0, At, B0); PG8_MMA(0, 1, At, B1); PG8_BAR; PG8_SCHED;
            PG8_LDA(At, 1, 1); PG8_STAGE(PG8_SB(1, 0), b3, voffB); PG8_STAGE(PG8_SB(1, 1), b3 + hstepB, voffB); PG8_STAGE(PG8_SA(1, 0), a3, voffA);
            PG8_WAIT_V(8); PG8_WAIT_L(0); PG8_BAR; PG8_MMA(1, 0, At, B0); PG8_MMA(1, 1, At, B1); PG8_BAR; PG8_SCHED;
            } else {
            PG8_LDB(B0, 0, 0); PG8_SCHED; PG8_LDA(At, 0, 0); PG8_STAGE(PG8_SA(1, 1), a1 + hstepA, voffA);
            PG8_WAIT_L(8); PG8_BAR; PG8_WAIT_L(0); PG8_MMA(0, 0, At, B0); PG8_BAR; PG8_SCHED;
            PG8_LDB(B1, 0, 1); PG8_STAGE(PG8_SB(0, 0), b2, voffB);
            PG8_BAR; PG8_WAIT_L(0); PG8_MMA(0, 1, At, B1); PG8_BAR;
            PG8_LDA(At, 0, 1); PG8_STAGE(PG8_SA(0, 0), a2, voffA);
            PG8_BAR; PG8_WAIT_L(0); PG8_MMA(1, 0, At, B0); PG8_BAR; PG8_SCHED;
            PG8_STAGE(PG8_SB(0, 1), b2 + hstepB, voffB);
            PG8_WAIT_V(6); PG8_BAR; PG8_MMA(1, 1, At, B1); PG8_BAR;
            PG8_LDB(B0, 1, 0); PG8_SCHED; PG8_LDA(At, 1, 0); PG8_STAGE(PG8_SA(0, 1), a2 + hstepA, voffA);
            PG8_WAIT_L(8); PG8_BAR; PG8_WAIT_L(0); PG8_MMA(0, 0, At, B0); PG8_BAR; PG8_SCHED;
            PG8_LDB(B1, 1, 1); PG8_STAGE(PG8_SB(1, 0), b3, voffB);
            PG8_BAR; PG8_WAIT_L(0); PG8_MMA(0, 1, At, B1); PG8_BAR;
            PG8_LDA(At, 1, 1); PG8_STAGE(PG8_SA(1, 0), a3, voffA);
            PG8_BAR; PG8_WAIT_L(0); PG8_MMA(1, 0, At, B0); PG8_BAR; PG8_SCHED;
            PG8_STAGE(PG8_SB(1, 1), b3 + hstepB, voffB);
            PG8_WAIT_V(6); PG8_BAR; PG8_MMA(1, 1, At, B1); PG8_BAR;
            }
        }
        if constexpr (ALIGN_EPI) { if (wr == 0) PG8_BAR; }
        if constexpr (!Epi::AFTER_DRAIN) { if constexpr (Epi::PREFETCH) E(acc, cur, wr, wc, fr, fq, epre); else E(acc, cur, wr, wc, fr, fq); S.done(cur); }
        if (!has_next) break;
#pragma unroll
        for (int a = 0; a < 2; ++a)
#pragma unroll
            for (int b = 0; b < 2; ++b)
#pragma unroll
                for (int m = 0; m < 4; ++m)
#pragma unroll
                    for (int n = 0; n < 2; ++n) acc[a][b][m][n] = (f32x4){0.f, 0.f, 0.f, 0.f};
        cur = nxt; cA = nA; cB = nB; ++ui;
        if constexpr (ALIGN_EPI) { if (wr == 1) PG8_BAR; }
    }
    PG8_WAIT_V(0);
    if constexpr (!ALIGN_EPI) { if (wr == 0) PG8_BAR; }
    PG8_BAR;
    if constexpr (Epi::AFTER_DRAIN) { E.fused(acc, cur, wr, wc, fr, fq, lds, wid, lane); S.done(cur); }
#undef PG8_SA
#undef PG8_SB
#undef PG8_STAGE
#undef PG8_LDA
#undef PG8_LDB
#undef PG8_MMA
#undef PG8_WAIT_V
#undef PG8_WAIT_L
#undef PG8_BAR
#undef PG8_SCHED
}
}

#define MFMA32(a, b, c) __builtin_amdgcn_mfma_f32_32x32x16_bf16((a), (b), (c), 0, 0, 0)
__device__ __forceinline__ bf16x8 pack8(const f32x16& p, int b) {
    u32x4 w = (u32x4){pk2(p[b], p[b + 1]), pk2(p[b + 2], p[b + 3]), pk2(p[b + 4], p[b + 5]), pk2(p[b + 6], p[b + 7])};
    return __builtin_bit_cast(bf16x8, w);
}
__device__ __forceinline__ float max3f_(float a, float b, float c) { float r; asm("v_max3_f32 %0, %1, %2, %3" : "=v"(r) : "v"(a), "v"(b), "v"(c)); return r; }
__device__ __forceinline__ float max16(const f32x16& p) {
    float a = max3f_(p[0], p[1], p[2]), b = max3f_(p[3], p[4], p[5]);
    a = max3f_(a, p[6], p[7]); b = max3f_(b, p[8], p[9]); a = max3f_(a, p[10], p[11]); b = max3f_(b, p[12], p[13]);
    return max3f_(a, b, max3f_(p[14], p[15], p[15]));
}
__device__ __forceinline__ bf16x8 cat44(s16x4 a, s16x4 b) { return (bf16x8){a[0], a[1], a[2], a[3], b[0], b[1], b[2], b[3]}; }

struct MlaState { f32x16 o0, o1, negm; float l; };
typedef float f32x2p __attribute__((ext_vector_type(2)));
__device__ __forceinline__ void mla_softmax_pv_prep(MlaState& st, f32x16& p0, f32x16& p1, bf16x8 (&pb)[4], bool first) {
    float mx = fmaxf(max16(p0), max16(p1));
    { auto rr = __builtin_amdgcn_permlane32_swap(__builtin_bit_cast(unsigned, mx), __builtin_bit_cast(unsigned, mx), false, false);
      mx = fmaxf(__builtin_bit_cast(float, rr[0]), __builtin_bit_cast(float, rr[1])); }
    if (first || __any(mx > 8.0f)) {
        const float d = first ? mx : (mx > 8.0f ? mx : 0.f);
#pragma unroll
        for (int r = 0; r < 16; ++r) { p0[r] -= d; p1[r] -= d; st.negm[r] -= d; }
        if (!first) { const float f = __builtin_amdgcn_exp2f(-d); st.l *= f;
#pragma unroll
            for (int r = 0; r < 16; ++r) { st.o0[r] *= f; st.o1[r] *= f; } }
    }
    f32x2p ps = (f32x2p){0.f, 0.f};
#pragma unroll
    for (int r = 0; r < 16; r += 2) {
        p0[r] = __builtin_amdgcn_exp2f(p0[r]); p0[r + 1] = __builtin_amdgcn_exp2f(p0[r + 1]); p1[r] = __builtin_amdgcn_exp2f(p1[r]); p1[r + 1] = __builtin_amdgcn_exp2f(p1[r + 1]);
        ps += (f32x2p){p0[r], p0[r + 1]}; ps += (f32x2p){p1[r], p1[r + 1]};
    }
    st.l += ps[0] + ps[1];
    pb[0] = pack8(p0, 0); pb[1] = pack8(p0, 8); pb[2] = pack8(p1, 0); pb[3] = pack8(p1, 8);
}

constexpr int MLA_KROW = 208, MLA_VROW = 144, MLA_KT = 64 * MLA_KROW  , MLA_STAGE = MLA_KT + 64 * MLA_VROW  ;

__device__ __forceinline__ void mla_prompt_unit(LAS unsigned char* lds, int h, int qb, const bf16_t* __restrict__ Q, const bf16_t* __restrict__ KN, const bf16_t* __restrict__ KPE,
                                                const bf16_t* __restrict__ VT, bf16_t* MERGED, float* ssqa) {
    const int tid = threadIdx.x, lane = tid & 63, w = __builtin_amdgcn_readfirstlane(tid >> 6), r32 = lane & 31, hi = lane >> 5;
    const int q0 = qb * 256 + w * 32;
    bf16x8 qf[6];
    { const bf16_t* qp = Q + (size_t)(q0 + r32) * 768 + h * 96 + hi * 8;
#pragma unroll
      for (int s = 0; s < 6; ++s) qf[s] = *(const bf16x8*)(qp + 16 * s); }
    const int NT = 4 * qb + 4, mylast = 4 * qb + (w >> 1);
    MlaState st; st.l = 0.f;
#pragma unroll
    for (int r = 0; r < 16; ++r) { st.o0[r] = 0.f; st.o1[r] = 0.f; st.negm[r] = 0.f; }
    const int krow = tid >> 3, kch = tid & 7, prow = (tid & 255) >> 2, pch = tid & 3, vd = tid >> 3, vch = tid & 7;
    const bf16_t* ksrc = KN + (size_t)krow * 512 + h * 64 + kch * 8;
    const bf16_t* psrc = KPE + (size_t)prow * 32 + pch * 8;
    const bf16_t* vsrc = VT + (size_t)(h * 64 + vd) * VT_LD + vch * 8;
    const int kdst = krow * MLA_KROW + kch * 16, pdst = prow * MLA_KROW + 128 + pch * 16, vdst = MLA_KT + vd * MLA_VROW + (vch >> 1) * 32 + (vch & 1) * 8;
    u32x4 rk, rp, rv; rp = (u32x4){0, 0, 0, 0};
#define MLA_GLOAD(t) do { rk = *(const u32x4*)(ksrc + (size_t)(t) * 64 * 512); if (tid < 256) rp = *(const u32x4*)(psrc + (size_t)(t) * 64 * 32); rv = *(const u32x4*)(vsrc + (size_t)(t) * 64); } while (0)
#define MLA_LSTORE(b) do { LAS unsigned char* sb_ = lds + (b) * MLA_STAGE; *(LAS u32x4*)(sb_ + kdst) = rk; if (tid < 256) *(LAS u32x4*)(sb_ + pdst) = rp; \
        *(LAS u32x2*)(sb_ + vdst) = (u32x2){rv[0], rv[1]}; *(LAS u32x2*)(sb_ + vdst + 16) = (u32x2){rv[2], rv[3]}; } while (0)
    MLA_GLOAD(0); MLA_LSTORE(0); __syncthreads();
    for (int t = 0; t < NT; ++t) {
        const bool more = (t + 1 < NT);
        if (more) MLA_GLOAD(t + 1);
        if (t <= mylast) {
            const LAS unsigned char* sb = lds + (t & 1) * MLA_STAGE;
            const LAS unsigned char* kb = sb + r32 * MLA_KROW + hi * 16;
            bf16x8 ka[6], kc[6];
#pragma unroll
            for (int s = 0; s < 6; ++s) { ka[s] = *(const LAS bf16x8*)(kb + s * 32); kc[s] = *(const LAS bf16x8*)(kb + 32 * MLA_KROW + s * 32); }
            __builtin_amdgcn_sched_barrier(0);
            f32x16 p0 = st.negm, p1 = st.negm;
#pragma unroll
            for (int s = 0; s < 6; ++s) { p0 = MFMA32(ka[s], qf[s], p0); p1 = MFMA32(kc[s], qf[s], p1); }
            __builtin_amdgcn_sched_barrier(0);
            const LAS unsigned char* vb = sb + MLA_KT + r32 * MLA_VROW + hi * 16;
            bf16x8 va[4], vc[4];
#pragma unroll
            for (int s = 0; s < 4; ++s) {
                va[s] = *(const LAS bf16x8*)(vb + s * 32); vc[s] = *(const LAS bf16x8*)(vb + 32 * MLA_VROW + s * 32);
            }
            __builtin_amdgcn_sched_barrier(0);
            bf16x8 pb[4];
            mla_softmax_pv_prep(st, p0, p1, pb, t == 0);
#pragma unroll
            for (int s = 0; s < 4; ++s) { st.o0 = MFMA32(va[s], pb[s], st.o0); st.o1 = MFMA32(vc[s], pb[s], st.o1); }
        }
        if (more) MLA_LSTORE((t + 1) & 1);
        __syncthreads();
    }
#undef MLA_GLOAD
#undef MLA_LSTORE
    const float l = st.l + __shfl_xor(st.l, 32); const float inv = 1.f / l;
    const int row = q0 + r32; bf16_t* op = MERGED + (size_t)row * DM + h * 64 + 4 * hi; float sq = 0.f;
#pragma unroll
    for (int g = 0; g < 4; ++g) {
        const float a0 = st.o0[4 * g] * inv, a1 = st.o0[4 * g + 1] * inv, a2 = st.o0[4 * g + 2] * inv, a3 = st.o0[4 * g + 3] * inv;
        const float b0 = st.o1[4 * g] * inv, b1 = st.o1[4 * g + 1] * inv, b2 = st.o1[4 * g + 2] * inv, b3 = st.o1[4 * g + 3] * inv;
        *(u32x2*)(op + 8 * g) = (u32x2){pk2(a0, a1), pk2(a2, a3)}; *(u32x2*)(op + 32 + 8 * g) = (u32x2){pk2(b0, b1), pk2(b2, b3)};
        sq += (a0 * a0 + a1 * a1) + (a2 * a2 + a3 * a3) + (b0 * b0 + b1 * b1) + (b2 * b2 + b3 * b3);
    }
    sq += __shfl_xor(sq, 32); if (hi == 0) atomic_addf(ssqa + row, sq);
}

__device__ __forceinline__ void mla_sample_unit(LAS unsigned char* lds, int b, int h, const bf16_t* __restrict__ Q, const bf16_t* __restrict__ KN, const bf16_t* __restrict__ KPE,
                                                const bf16_t* __restrict__ VT, bf16_t* MERGED, float* ssqa) {
    const int tid = threadIdx.x, lane = tid & 63, w = __builtin_amdgcn_readfirstlane(tid >> 6), r32 = lane & 31, hi = lane >> 5;
    const int row = TP + b * 32 + r32;
    bf16x8 qf[6];
    { const bf16_t* qp = Q + (size_t)row * 768 + h * 96 + hi * 8;
#pragma unroll
      for (int s = 0; s < 6; ++s) qf[s] = *(const bf16x8*)(qp + 16 * s); }
    MlaState st; st.l = 0.f;
#pragma unroll
    for (int r = 0; r < 16; ++r) { st.o0[r] = 0.f; st.o1[r] = 0.f; st.negm[r] = 0.f; }
    bf16x8 ka[6], kc[6]; s16x4 va[8], vc[8];
#define MLS_LOAD(t_, KA, KC, VA, VC) do { const size_t kv0_ = (size_t)b * SKV + (t_) * 64; \
        const bf16_t* kp_ = KN + (kv0_ + r32) * 512 + h * 64 + hi * 8; const bf16_t* pp_ = KPE + (kv0_ + r32) * 32 + hi * 8; \
        _Pragma("unroll") for (int s_ = 0; s_ < 4; ++s_) { KA[s_] = *(const bf16x8*)(kp_ + 16 * s_); KC[s_] = *(const bf16x8*)(kp_ + 32 * 512 + 16 * s_); } \
        _Pragma("unroll") for (int s_ = 0; s_ < 2; ++s_) { KA[4 + s_] = *(const bf16x8*)(pp_ + 16 * s_); KC[4 + s_] = *(const bf16x8*)(pp_ + 32 * 32 + 16 * s_); } \
        const bf16_t* vp_ = VT + (size_t)(h * 64 + r32) * VTS_LD + kv0_ + 4 * hi; \
        _Pragma("unroll") for (int s_ = 0; s_ < 4; ++s_) { VA[2 * s_] = *(const s16x4*)(vp_ + 16 * s_); VA[2 * s_ + 1] = *(const s16x4*)(vp_ + 16 * s_ + 8); \
            VC[2 * s_] = *(const s16x4*)(vp_ + (size_t)32 * VTS_LD + 16 * s_); VC[2 * s_ + 1] = *(const s16x4*)(vp_ + (size_t)32 * VTS_LD + 16 * s_ + 8); } } while (0)
    for (int t = w; t < 33; t += 8) {
        MLS_LOAD(t, ka, kc, va, vc);
        __builtin_amdgcn_sched_barrier(0);
        f32x16 p0 = st.negm, p1 = st.negm;
        const bool tail = (t == 32);
#pragma unroll
        for (int s = 0; s < 6; ++s) { p0 = MFMA32(ka[s], qf[s], p0); if (!tail) p1 = MFMA32(kc[s], qf[s], p1); }
        if (tail) {
#pragma unroll
            for (int r = 0; r < 16; ++r) p1[r] = -1e30f;
        }
        bf16x8 pb[4];
        mla_softmax_pv_prep(st, p0, p1, pb, t == w);
#pragma unroll
        for (int s = 0; s < 4; ++s) {
            if (tail && s >= 2) break;
            st.o0 = MFMA32(cat44(va[2 * s], va[2 * s + 1]), pb[s], st.o0); st.o1 = MFMA32(cat44(vc[2 * s], vc[2 * s + 1]), pb[s], st.o1);
        }
    }
#undef MLS_LOAD
    LAS float* Lm = (LAS float*)lds; LAS float* Ll = Lm + 512; LAS float* LO = Lm + 1024;
    const float mref = -st.negm[0];
    Lm[w * 64 + lane] = mref;
    __syncthreads();
    float M = Lm[lane];
#pragma unroll
    for (int k = 1; k < 8; ++k) M = fmaxf(M, Lm[k * 64 + lane]);
    const float f = __builtin_amdgcn_exp2f(mref - M);
    Ll[w * 64 + lane] = st.l * f;
#pragma unroll
    for (int r = 0; r < 16; ++r) { LO[(w * 32 + r) * 64 + lane] = st.o0[r] * f; LO[(w * 32 + 16 + r) * 64 + lane] = st.o1[r] * f; }
    __syncthreads();
    float l = 0.f;
#pragma unroll
    for (int k = 0; k < 8; ++k) l += Ll[k * 64 + lane] + Ll[k * 64 + (lane ^ 32)];
    const float inv = 1.f / l;
    float v[4];
#pragma unroll
    for (int i = 0; i < 4; ++i) { float s = 0.f;
#pragma unroll
        for (int k = 0; k < 8; ++k) s += LO[(k * 32 + 4 * w + i) * 64 + lane];
        v[i] = s * inv; }
    *(u32x2*)(MERGED + (size_t)row * DM + h * 64 + 32 * (w >> 2) + 8 * (w & 3) + 4 * hi) = (u32x2){pk2(v[0], v[1]), pk2(v[2], v[3])};
    float sq = (v[0] * v[0] + v[1] * v[1]) + (v[2] * v[2] + v[3] * v[3]);
    sq += __shfl_xor(sq, 32); if (hi == 0) atomic_addf(ssqa + row, sq);
    __syncthreads();
}

template <class QF, class KF, class VF, class MID>
__device__ __forceinline__ void xattn_wave(QF qfrag, bf16_t* orow  , KF kfrag, VF vfrag, MID mid) {
    bf16x8 pb[16];
    float inv;
    {
        f32x16 S[4][2];
#pragma unroll
        for (int kt = 0; kt < 4; ++kt)
#pragma unroll
            for (int r = 0; r < 16; ++r) { S[kt][0][r] = 0.f; S[kt][1][r] = 0.f; }
#pragma unroll
        for (int s = 0; s < 16; ++s) {
            const bf16x8 qf = qfrag(s);
#pragma unroll
            for (int kt = 0; kt < 4; ++kt) { S[kt][0] = MFMA32(kfrag(kt, 0, s), qf, S[kt][0]); S[kt][1] = MFMA32(kfrag(kt, 1, s), qf, S[kt][1]); }
        }
        float mx = -1e30f;
#pragma unroll
        for (int kt = 0; kt < 4; ++kt) mx = fmaxf(mx, fmaxf(max16(S[kt][0]), max16(S[kt][1])));
        mx = fmaxf(mx, __shfl_xor(mx, 32));
        float l = 0.f;
#pragma unroll
        for (int kt = 0; kt < 4; ++kt) {
#pragma unroll
            for (int r = 0; r < 16; ++r) { S[kt][0][r] = __builtin_amdgcn_exp2f(S[kt][0][r] - mx); S[kt][1][r] = __builtin_amdgcn_exp2f(S[kt][1][r] - mx); l += S[kt][0][r] + S[kt][1][r]; }
            pb[4 * kt] = pack8(S[kt][0], 0); pb[4 * kt + 1] = pack8(S[kt][0], 8); pb[4 * kt + 2] = pack8(S[kt][1], 0); pb[4 * kt + 3] = pack8(S[kt][1], 8);
        }
        l += __shfl_xor(l, 32); inv = 1.f / l;
    }
    mid();
#pragma unroll 1
    for (int db = 0; db < 8; ++db) {
        f32x16 o;
#pragma unroll
        for (int r = 0; r < 16; ++r) o[r] = 0.f;
        bf16x8 vf[16];
#pragma unroll
        for (int s = 0; s < 16; ++s) vf[s] = vfrag(db, s);
        __builtin_amdgcn_sched_barrier(0);
#pragma unroll
        for (int s = 0; s < 16; ++s) o = MFMA32(vf[s], pb[s], o);
#pragma unroll
        for (int g = 0; g < 4; ++g)
            *(u32x2*)(orow + 32 * db + 8 * g) = (u32x2){pk2(o[4 * g] * inv, o[4 * g + 1] * inv), pk2(o[4 * g + 2] * inv, o[4 * g + 3] * inv)};
    }
}

constexpr int XA_KROW = 528, XA_VROW = 528;
__device__ __forceinline__ void xattn_unit(LAS unsigned char* lds, int rowbase, bool single, int h, bf16_t* QM, const bf16_t* __restrict__ MKB, const bf16_t* __restrict__ MVTB, const float* __restrict__ QACC, const float* __restrict__ ssq2) {
    const int tid = threadIdx.x, lane = tid & 63, w = __builtin_amdgcn_readfirstlane(tid >> 6), r32 = lane & 31, hi = lane >> 5;
#pragma unroll 4
    for (int it = 0; it < 16; ++it) { const int idx = it * 512 + tid, rw = idx >> 5, ch = idx & 31;
        *(LAS u32x4*)(lds + rw * XA_KROW + ch * 16) = *(const u32x4*)(MKB + (size_t)rw * DM + h * 256 + ch * 8); }
    __syncthreads();
    const int row = rowbase + (single ? 0 : w * 32) + r32;
    const LAS unsigned char* kb = lds + r32 * XA_KROW + hi * 16;
    const LAS unsigned char* vb = lds + r32 * XA_VROW + hi * 16;
    auto kfrag = [&](int kt, int half, int s) -> bf16x8 { return *(const LAS bf16x8*)(kb + (kt * 64 + half * 32) * XA_KROW + s * 32); };
    auto vfrag = [&](int db, int s) -> bf16x8 { return *(const LAS bf16x8*)(vb + db * 32 * XA_VROW + s * 32); };
    auto mid = [&]() {
        __syncthreads();
#pragma unroll 4
        for (int it = 0; it < 16; ++it) { const int idx = it * 512 + tid, d = idx >> 5, ch = idx & 31;
            const u32x4 v = *(const u32x4*)(MVTB + (size_t)(h * 256 + d) * 256 + ch * 8);
            LAS unsigned char* dp = lds + d * XA_VROW + (ch >> 1) * 32 + (ch & 1) * 8;
            *(LAS u32x2*)dp = (u32x2){v[0], v[1]}; *(LAS u32x2*)(dp + 16) = (u32x2){v[2], v[3]}; }
        __syncthreads();
    };
    if (!single) {
        const bf16_t* qrow = QM + (size_t)row * DM + h * 256 + hi * 8;
        auto qfrag = [&](int s) -> bf16x8 { return *(const bf16x8*)(qrow + 16 * s); };
        xattn_wave(qfrag, QM + (size_t)row * DM + h * 256 + 4 * hi, kfrag, vfrag, mid);
    } else if (w == 0) {
        const float* qrow = QACC + (size_t)(row - TP) * DM + h * 256 + hi * 8; const float sc = XSCALE * __builtin_amdgcn_rsqf(ssq2[row] * (1.0f / 1024.0f) + EPS);
        auto qfrag = [&](int s) -> bf16x8 { const f32x4 a = *(const f32x4*)(qrow + 16 * s) * sc, b = *(const f32x4*)(qrow + 16 * s + 4) * sc;
            return __builtin_bit_cast(bf16x8, (u32x4){pk2(a[0], a[1]), pk2(a[2], a[3]), pk2(b[0], b[1]), pk2(b[2], b[3])}); };
        xattn_wave(qfrag, QM + (size_t)row * DM + h * 256 + 4 * hi, kfrag, vfrag, mid);
    } else mid();
    __syncthreads();
}
struct LruArgs { const bf16_t* XBR; const float* conv_w; const float* conv_b; const float* wa; const float* ba; const float* wx; const float* bx; const float* lam;
                 const float* state_conv; const float* state_lru; bf16_t* HLOC; bf16_t* ACUM; float* ATOT; float* BTOT; float* out; };
__device__ __forceinline__ void lru_l1_unit(LAS unsigned char* lds, int unit, const LruArgs& A) {
    const int c = threadIdx.x, g = __builtin_amdgcn_readfirstlane(c >> 6), j = c & 63, r32 = j & 31, hi = j >> 5;
    const bool samp = unit >= 256; const int b = unit - 256;
    const int row0 = samp ? TP + b * 32 : unit * 64; const int nt = samp ? 32 : 64;
    constexpr int XROW = 1040;
    LAS unsigned char* XCB = lds;
    LAS unsigned* PRE = (LAS unsigned*)(lds + 64 * XROW);
    const float w0 = A.conv_w[c], w1 = A.conv_w[512 + c], w2 = A.conv_w[1024 + c], w3 = A.conv_w[1536 + c], cb = A.conv_b[c];
    float xm3, xm2, xm1;
    if (samp) { xm3 = A.state_conv[(b * 3 + 0) * 512 + c]; xm2 = A.state_conv[(b * 3 + 1) * 512 + c]; xm1 = A.state_conv[(b * 3 + 2) * 512 + c]; }
    else if (unit > 0) { xm3 = bf2f(A.XBR[(size_t)(row0 - 3) * 512 + c]); xm2 = bf2f(A.XBR[(size_t)(row0 - 2) * 512 + c]); xm1 = bf2f(A.XBR[(size_t)(row0 - 1) * 512 + c]); }
    else { xm3 = 0.f; xm2 = 0.f; xm1 = 0.f; }
    {
        unsigned short xraw[64];
#pragma unroll
        for (int t = 0; t < 64; ++t) xraw[t] = (t < nt) ? A.XBR[(size_t)(row0 + t) * 512 + c] : (unsigned short)0;
#pragma unroll
        for (int t = 0; t < 64; ++t) {
            if (t < nt) {
                const float x0 = bf2f(xraw[t]);
                *(LAS bf16_t*)(XCB + t * XROW + c * 2) = (bf16_t)f2bf(cb + w0 * xm3 + w1 * xm2 + w2 * xm1 + w3 * x0);
                xm3 = xm2; xm2 = xm1; xm1 = x0;
            }
        }
    }
    bf16x8 bw[4][4];
#pragma unroll
    for (int nb = 0; nb < 4; ++nb)
#pragma unroll
        for (int ks = 0; ks < 4; ++ks) {
            const float* W = ((nb < 2) ? A.wa : A.wx) + g * 4096 + (16 * ks) * 64 + (nb & 1) * 32;
            const float* Wl = W + (8 * hi) * 64 + r32;
            bw[nb][ks] = __builtin_bit_cast(bf16x8, (u32x4){pk2(Wl[0], Wl[64]), pk2(Wl[128], Wl[192]), pk2(Wl[256], Wl[320]), pk2(Wl[384], Wl[448])});
        }
    const float bav = A.ba[c], bxv = A.bx[c];
    const float lamv = A.lam[c]; const float sp = log1pf(__expf(-lamv));
    float h = samp ? A.state_lru[b * 512 + c] : 0.f, Ac = 1.f;
    asm volatile("s_waitcnt lgkmcnt(0)" ::: "memory");
    for (int mb = 0; mb < (nt >> 5); ++mb) {
        f32x16 C0, C1, C2, C3;
#pragma unroll
        for (int r = 0; r < 16; ++r) { C0[r] = 0.f; C1[r] = 0.f; C2[r] = 0.f; C3[r] = 0.f; }
#pragma unroll
        for (int ks = 0; ks < 4; ++ks) {
            const bf16x8 a = *(const LAS bf16x8*)(XCB + (32 * mb + r32) * XROW + (g * 64 + 16 * ks + 8 * hi) * 2);
            C0 = MFMA32(a, bw[0][ks], C0); C1 = MFMA32(a, bw[1][ks], C1); C2 = MFMA32(a, bw[2][ks], C2); C3 = MFMA32(a, bw[3][ks], C3);
        }
#pragma unroll
        for (int r = 0; r < 16; ++r) { const int tl = (r & 3) + 8 * (r >> 2) + 4 * hi;
            PRE[tl * 512 + g * 64 + r32] = f2bf(C0[r]) | (f2bf(C2[r]) << 16); PRE[tl * 512 + g * 64 + 32 + r32] = f2bf(C1[r]) | (f2bf(C3[r]) << 16); }
        asm volatile("s_waitcnt lgkmcnt(0)" ::: "memory");
#pragma unroll 4
        for (int tl = 0; tl < 32; ++tl) {
            const int t = 32 * mb + tl;
            const unsigned u = PRE[tl * 512 + c];
            const float ra = __builtin_bit_cast(float, u << 16) + bav, ri = __builtin_bit_cast(float, u & 0xffff0000u) + bxv;
            const float xcv = bf2f(*(const LAS bf16_t*)(XCB + t * XROW + c * 2));
            const float rg = __builtin_amdgcn_rcpf(1.f + __builtin_amdgcn_exp2f(-LOG2E * ra)), ig = __builtin_amdgcn_rcpf(1.f + __builtin_amdgcn_exp2f(-LOG2E * ri));
            const float a = __builtin_amdgcn_exp2f((-8.0f * LOG2E) * rg * sp);
            const float bt = __builtin_amdgcn_sqrtf(fmaxf(1.f - a * a, 0.f)) * ig * xcv;
            h = a * h + bt; Ac *= a;
            A.HLOC[(size_t)(row0 + t) * 512 + c] = (bf16_t)f2bf(h); A.ACUM[(size_t)(row0 + t) * 512 + c] = (bf16_t)f2bf(Ac);
        }
        asm volatile("s_waitcnt lgkmcnt(0)" ::: "memory");
    }
    A.ATOT[unit * 512 + c] = Ac; A.BTOT[unit * 512 + c] = h;
    if (samp) A.out[O_LRUS + b * 512 + c] = h;
    __syncthreads();
}
__device__ __forceinline__ void lru_l3_unit(LAS unsigned char* lds, int unit, const bf16_t* __restrict__ HLOC, const bf16_t* __restrict__ ACUM, const bf16_t* __restrict__ GG,
                                            const float* __restrict__ ATOT, const float* __restrict__ BTOT, const float* __restrict__ gain, bf16_t* MERGED, float* out) {
    const int c = threadIdx.x, lane = c & 63, w = __builtin_amdgcn_readfirstlane(c >> 6);
    const bool samp = unit >= 256; const int row0 = samp ? TP + (unit - 256) * 32 : unit * 64; const int nt = samp ? 32 : 64;
    LAS float* HIN = (LAS float*)lds;
    float H = 0.f;
    if (!samp) {
#pragma unroll 32
        for (int k = 0; k < unit; ++k) H = ATOT[k * 512 + c] * H + BTOT[k * 512 + c];
        if (unit == 255) out[O_LRUP + c] = ATOT[255 * 512 + c] * H + BTOT[255 * 512 + c];
    }
    HIN[c] = H;
    __syncthreads();
    float hin[8], gn[8];
#pragma unroll
    for (int k = 0; k < 8; ++k) { hin[k] = HIN[lane * 8 + k]; gn[k] = gain[lane * 8 + k]; }
    for (int t0 = w; t0 < nt; t0 += 32) {
        u32x4 hl[4], ac[4], gg[4];
#pragma unroll
        for (int q = 0; q < 4; ++q) { const size_t off = (size_t)(row0 + t0 + 8 * q) * 512 + lane * 8;
            hl[q] = *(const u32x4*)(HLOC + off); ac[q] = *(const u32x4*)(ACUM + off); gg[q] = *(const u32x4*)(GG + off); }
#pragma unroll
        for (int q = 0; q < 4; ++q) {
            float v[8]; float sq = 0.f;
#pragma unroll
            for (int k = 0; k < 4; ++k) {
                const float h0 = __builtin_bit_cast(float, hl[q][k] << 16) + __builtin_bit_cast(float, ac[q][k] << 16) * hin[2 * k];
                const float h1 = __builtin_bit_cast(float, hl[q][k] & 0xffff0000u) + __builtin_bit_cast(float, ac[q][k] & 0xffff0000u) * hin[2 * k + 1];
                v[2 * k] = __builtin_bit_cast(float, gg[q][k] << 16) * h0; v[2 * k + 1] = __builtin_bit_cast(float, gg[q][k] & 0xffff0000u) * h1;
                sq += v[2 * k] * v[2 * k] + v[2 * k + 1] * v[2 * k + 1];
            }
            const float rs = __builtin_amdgcn_rsqf(wave_sum(sq) * (1.0f / 512.0f) + EPS);
            *(u32x4*)(MERGED + (size_t)(row0 + t0 + 8 * q) * DM + 512 + lane * 8) =
                (u32x4){pk2(v[0] * rs * gn[0], v[1] * rs * gn[1]), pk2(v[2] * rs * gn[2], v[3] * rs * gn[3]), pk2(v[4] * rs * gn[4], v[5] * rs * gn[5]), pk2(v[6] * rs * gn[6], v[7] * rs * gn[7])};
        }
    }
    __syncthreads();
}

__device__ __forceinline__ void sample_finalize_part(int part, const float* __restrict__ xs_old, const float* __restrict__ ACC, float* xs_new, bf16_t* XBs, float* ssq_s, unsigned* flag) {
    const int lane = threadIdx.x & 63, w = __builtin_amdgcn_readfirstlane(threadIdx.x >> 6);
    const int r0 = part * 32 + w * 4;
    f32x4 v[4][4];
#pragma unroll
    for (int q = 0; q < 4; ++q)
#pragma unroll
        for (int j = 0; j < 4; ++j) v[q][j] = *((const f32x4*)(xs_old + (size_t)(r0 + q) * DM) + lane + 64 * j) + *((const f32x4*)(ACC + (size_t)(r0 + q) * DM) + lane + 64 * j);
#pragma unroll
    for (int q = 0; q < 4; ++q) {
        float s = 0.f;
#pragma unroll
        for (int j = 0; j < 4; ++j) s += (v[q][j][0] * v[q][j][0] + v[q][j][1] * v[q][j][1]) + (v[q][j][2] * v[q][j][2] + v[q][j][3] * v[q][j][3]);
        s = wave_sum(s); if (lane == 0) ssq_s[r0 + q] = s;
#pragma unroll
        for (int j = 0; j < 4; ++j) { *((f32x4*)(xs_new + (size_t)(r0 + q) * DM) + lane + 64 * j) = v[q][j]; *((u32x2*)(XBs + (size_t)(r0 + q) * DM) + lane + 64 * j) = (u32x2){pk2(v[q][j][0], v[q][j][1]), pk2(v[q][j][2], v[q][j][3])}; }
    }
    asm volatile("s_waitcnt vmcnt(0)" ::: "memory");
    __syncthreads();
    if (threadIdx.x == 0) { __builtin_amdgcn_fence(__ATOMIC_RELEASE, "agent"); asm volatile("s_waitcnt vmcnt(0)" ::: "memory"); __hip_atomic_fetch_add(flag, 1u, __ATOMIC_RELAXED, __HIP_MEMORY_SCOPE_AGENT); }
}
__device__ __forceinline__ void sample_wait(unsigned* flag, unsigned want) {
    if (threadIdx.x == 0) { while (__hip_atomic_load(flag, __ATOMIC_RELAXED, __HIP_MEMORY_SCOPE_AGENT) < want) __builtin_amdgcn_s_sleep(2);
        __builtin_amdgcn_fence(__ATOMIC_ACQUIRE, "agent"); asm volatile("s_waitcnt vmcnt(0)" ::: "memory"); }
    __syncthreads();
}

__device__ __forceinline__ void tr_item(const float* __restrict__ W, int N, int k0, int n0, bf16_t* WT, int drow0, int ldd, const float* gain, LAS float* scr, int lane) {
    float tv[32];
#pragma unroll
    for (int i = 0; i < 32; ++i) tv[i] = W[(size_t)(k0 + 2 * i + (lane >> 5)) * N + n0 + (lane & 31)];
#pragma unroll
    for (int i = 0; i < 32; ++i) { const int kk = 2 * i + (lane >> 5); float v = tv[i]; if (gain) v *= gain[k0 + kk]; scr[kk * 33 + (lane & 31)] = v; }
    asm volatile("s_waitcnt lgkmcnt(0)" ::: "memory");
    const int cc = lane & 7;
#pragma unroll
    for (int jj = 0; jj < 4; ++jj) { const int n = (lane >> 3) + 8 * jj; const LAS float* s = scr + (8 * cc) * 33 + n;
        u32x4 o; o.x = pk2(s[0 * 33], s[1 * 33]); o.y = pk2(s[2 * 33], s[3 * 33]); o.z = pk2(s[4 * 33], s[5 * 33]); o.w = pk2(s[6 * 33], s[7 * 33]);
        *(u32x4*)(WT + (size_t)(drow0 + n) * ldd + k0 + 8 * cc) = o; }
    asm volatile("s_waitcnt lgkmcnt(0)" ::: "memory");
}

#define XB_TMO      128
#define XB_XCNT(j)  (256  + 64 * (j))
#define XB_XSUB(j)  (1280 + 64 * (j))
#define XB_XGEN(j)  (2304 + 64 * (j))
#define XB_TOP      3328
#define XB_TOPGEN   3392
#define XCD_BAR_WORDS 3456
#define XB_SPIN_CAP (1u << 18)

__device__ __forceinline__ unsigned xb_ld(unsigned* p)              { return __hip_atomic_load(p, __ATOMIC_RELAXED, __HIP_MEMORY_SCOPE_AGENT); }
__device__ __forceinline__ unsigned xb_add(unsigned* p, unsigned v) { return __hip_atomic_fetch_add(p, v, __ATOMIC_RELAXED, __HIP_MEMORY_SCOPE_AGENT); }
__device__ __forceinline__ unsigned xb_xcc_id() { return (unsigned)__builtin_amdgcn_s_getreg((3 << 11) | 20) & 0xFu; }
#define XB_SPIN(cond, bar) do { unsigned _sp = 0; while (cond) { __builtin_amdgcn_s_sleep(1); \
    if ((++_sp & 255u) == 0u) { if (xb_ld(&(bar)[XB_TMO])) break; if (_sp > XB_SPIN_CAP) { atomicAdd(&(bar)[XB_TMO], 1u); break; } } } } while (0)

struct XcdBarrier {
    unsigned* bar; unsigned x;
    volatile LAS unsigned* st;
};

__device__ __forceinline__ XcdBarrier xcd_barrier_post(unsigned* bar, volatile LAS unsigned* st) {
    XcdBarrier b; b.bar = bar; b.x = xb_xcc_id(); b.st = st;
    if (threadIdx.x == 0) (void)xb_add(&bar[XB_XCNT(b.x)], 1u);
    return b;
}
__device__ __forceinline__ void xcd_barrier_complete(unsigned* bar, unsigned x, unsigned& nloc, unsigned& nx) {
    const unsigned G = gridDim.x * gridDim.y * gridDim.z;
    unsigned sum, cnt, mine, sp = 0u;
    for (;;) {
        sum = 0u; cnt = 0u; mine = 0u;
#pragma unroll
        for (unsigned j = 0; j < 16; ++j) { const unsigned c = xb_ld(&bar[XB_XCNT(j)]); sum += c; cnt += (c > 0u) ? 1u : 0u; mine = (j == x) ? c : mine; }
        if (sum == G) break;
        __builtin_amdgcn_s_sleep(1);
        if ((++sp & 255u) == 0u) { if (xb_ld(&bar[XB_TMO])) break; if (sp > XB_SPIN_CAP) { atomicAdd(&bar[XB_TMO], 1u); break; } }
    }
    nloc = mine > 0u ? mine : 1u; nx = cnt > 0u ? cnt : 1u;
}

__device__ __forceinline__ void xcd_barrier(const XcdBarrier& b) {
    asm volatile("s_waitcnt vmcnt(0)" ::: "memory");
    __syncthreads();
    if (threadIdx.x == 0) {
        unsigned* bar = b.bar;
        __builtin_amdgcn_s_waitcnt(0);
        unsigned nloc = b.st[0], nx = b.st[1];
        if (nloc == 0u) { xcd_barrier_complete(bar, b.x, nloc, nx); b.st[0] = nloc; b.st[1] = nx; }
        const unsigned old = xb_add(&bar[XB_XSUB(b.x)], 1u);
        const unsigned gen = old / nloc;
        if (old + 1u == (gen + 1u) * nloc) {
            __builtin_amdgcn_fence(__ATOMIC_RELEASE, "agent");
            asm volatile("s_waitcnt vmcnt(0)" ::: "memory");
            const unsigned og = xb_add(&bar[XB_TOP], 1u);
            const unsigned tg = og / nx;
            if (og + 1u == (tg + 1u) * nx) xb_add(&bar[XB_TOPGEN], 1u);
            else XB_SPIN(xb_ld(&bar[XB_TOPGEN]) == tg, bar);
            __builtin_amdgcn_fence(__ATOMIC_ACQUIRE, "agent");
            xb_add(&bar[XB_XGEN(b.x)], 1u);
            asm volatile("s_waitcnt vmcnt(0)" ::: "memory");
        } else {
            XB_SPIN(xb_ld(&bar[XB_XGEN(b.x)]) == gen, bar);
            __builtin_amdgcn_fence(__ATOMIC_ACQUIRE, "agent");
            asm volatile("s_waitcnt vmcnt(0)" ::: "memory");
        }
    }
    __syncthreads();
}

constexpr int NPHASE = 13;
struct Args { const float* in[40]; float* out; unsigned char* ws; int ph_lo, ph_hi; };
enum { I_XP = 0, I_XS, I_MEM, I_CCKV, I_CKPE, I_SCONV, I_SLRU, I_CMK, I_CMV, I_F1N, I_F1W1, I_F1W3, I_F1W2, I_MIXN, I_WIN, I_QN, I_WUQ, I_KVN, I_WUKV, I_CONVW, I_CONVB,
       I_LWA, I_LBA, I_LWX, I_LBX, I_LAM, I_AON, I_LON, I_WOUT, I_MEMN, I_XAN, I_WMQ, I_WMK, I_WMV, I_WMO, I_F2N, I_F2W1, I_F2W3, I_F2W2, I_FINN };

#define ssq0 ((float*)(ws + WS_SSQ))
#define ssq1 ((float*)(ws + WS_SSQ) + 1 * MT)
#define ssq2 ((float*)(ws + WS_SSQ) + 2 * MT)
#define ssq3 ((float*)(ws + WS_SSQ) + 3 * MT)
#define ssq4 ((float*)(ws + WS_SSQ) + 4 * MT)
#define ssqq ((float*)(ws + WS_SSQ) + 5 * MT)
#define ssqa ((float*)(ws + WS_SSQ) + 6 * MT)
#define W13_1 ((bf16_t*)(ws + WS_W13_1))
#define W2_1 ((bf16_t*)(ws + WS_W2_1))
#define W13_2 ((bf16_t*)(ws + WS_W13_2))
#define W2_2 ((bf16_t*)(ws + WS_W2_2))
#define WIN ((bf16_t*)(ws + WS_WIN))
#define WUQ ((bf16_t*)(ws + WS_WUQ))
#define WK ((bf16_t*)(ws + WS_WK))
#define WV ((bf16_t*)(ws + WS_WV))
#define WOUT ((bf16_t*)(ws + WS_WOUT))
#define WMQ ((bf16_t*)(ws + WS_WMQ))
#define WMKV ((bf16_t*)(ws + WS_WMKV))
#define WMO ((bf16_t*)(ws + WS_WMO))
#define MEMB ((bf16_t*)(ws + WS_MEMB))
#define MKB ((bf16_t*)(ws + WS_MKB))
#define MVTB ((bf16_t*)(ws + WS_MVTB))
#define MVB ((bf16_t*)(ws + WS_MVB))
#define CMKB ((bf16_t*)(ws + WS_CMKB))
#define CMVTB ((bf16_t*)(ws + WS_CMVTB))
#define XB ((bf16_t*)(ws + WS_XB))
#define HLOC ((bf16_t*)(out + O_Y))
#define ACUM ((bf16_t*)(out + O_Y) + (size_t)MT * 512)
#define HID ((bf16_t*)(ws + WS_HID))
#define CQ ((bf16_t*)(ws + WS_CQ))
#define CKVP ((bf16_t*)(ws + WS_CKVP))
#define CKVS ((bf16_t*)(ws + WS_CKVS))
#define XBR ((bf16_t*)(ws + WS_XBR))
#define MERGED ((bf16_t*)(ws + WS_MERGED))
#define GG ((bf16_t*)(ws + WS_GG))
#define Q ((bf16_t*)(ws + WS_Q))
#define KNP ((bf16_t*)(ws + WS_KNP))
#define KNS ((bf16_t*)(ws + WS_KNS))
#define VTP ((bf16_t*)(ws + WS_VTP))
#define VTS (((bf16_t*)(ws + WS_VTP)) + TP)
#define KPEP ((bf16_t*)(ws + WS_KPEP))
#define KPES ((bf16_t*)(ws + WS_KPES))
#define QM ((bf16_t*)(ws + WS_QM))
#define ATOT ((float*)(ws + WS_ATOT))
#define ACCB(i) ((float*)(ws + WS_ACC) + (size_t)(i) * TS * DM)
#define FLAGW(i) ((unsigned*)(ws + WS_BAR) + 3584 + 64 * (i))
#define XSA ((float*)(ws + WS_XSA))
#define XSB ((float*)(ws + WS_XSB))
#define BTOT ((float*)(ws + WS_BTOT))
__global__ void __launch_bounds__(NTHR, 2) mk_fwd(Args a) {
    extern __shared__ __attribute__((aligned(16))) unsigned char lds_raw[];
    LAS unsigned char* lds = (LAS unsigned char*)lds_raw;
    cg::grid_group grid = cg::this_grid();
    const int wave = __builtin_amdgcn_readfirstlane((int)threadIdx.x >> 6);
#define tid ((int)threadIdx.x)
#define lane ((int)threadIdx.x & 63)
    const __attribute__((address_space(4))) char* kargp = (const __attribute__((address_space(4))) char*)__builtin_amdgcn_kernarg_segment_ptr();
#define INP(i) (*(const float* const volatile __attribute__((address_space(4)))*)(kargp + 8 * (i)))
#define out (*(float* const volatile __attribute__((address_space(4)))*)(kargp + 320))
#define ws (*(unsigned char* const volatile __attribute__((address_space(4)))*)(kargp + 328))
#define lo (*(const volatile int __attribute__((address_space(4)))*)(kargp + 336))
#define hi (*(const volatile int __attribute__((address_space(4)))*)(kargp + 340))
#define G ((int)gridDim.x)
#define blk ((int)blockIdx.x)
#define vcu ((G % 8 == 0) ? (blk % 8) * (G / 8) + blk / 8 : blk)
#define gw (blk * NWAVE + wave)
#define NGW (G * NWAVE)
#define gtid ((size_t)blk * NTHR + tid)
#define NGT ((size_t)G * NTHR)
#define X (out + O_Y)
#ifndef PHMASK
#define PHMASK 0x1FFF
#endif
#define IN(k) (((PHMASK >> (k)) & 1) && lo <= (k) && (k) < hi)
    volatile LAS unsigned* xst = (volatile LAS unsigned*)(lds + LDS_EPI + 8192);
    if (tid == 0) { xst[0] = 0u; xst[1] = 0u; }
    __syncthreads();
    { XcdBarrier b0 = xcd_barrier_post((unsigned*)(ws + WS_BAR), xst); (void)b0; }
    if (hi > 1000) grid.sync();
#define SEAM(k) do { if (IN(k) && IN((k) + 1)) { XcdBarrier b_; b_.bar = (unsigned*)(ws + WS_BAR); b_.x = xb_xcc_id(); b_.st = xst; xcd_barrier(b_); } } while (0)

    constexpr int I_FFN = 16 * 88, I_W2 = 44 * 32, I_IN = 16 * 53, I_UQ = 6 * 24, I_UKV = 4 * 32, I_SQ = 16 * 32, I_CMVI = 8 * 128;
    constexpr int NITEMS = 4 * I_FFN + 2 * I_W2 + I_IN + I_UQ + I_UKV + 5 * I_SQ + I_CMVI, NA = 2 * I_FFN + 2 * I_SQ;
    auto do_item = [&](int it) {
        LAS float* scr = (LAS float*)(lds + wave * 16384);
        int r = it;
#define TRJ(NI, W, K_, N_, DST, LDD, GAIN, MAP) if (r < (NI)) { const int nb_ = (N_) / 32, kb = r / nb_, n0 = (r % nb_) * 32; tr_item((W), (N_), kb * 64, n0, (DST), (MAP), (LDD), (GAIN), scr, lane); return; } r -= (NI)
        TRJ(I_FFN, INP(I_F1W1), 1024, FF, W13_1, 1024, INP(I_F1N), (n0 >> 7) * 256 + (n0 & 127));
        TRJ(I_FFN, INP(I_F1W3), 1024, FF, W13_1, 1024, INP(I_F1N), (n0 >> 7) * 256 + 128 + (n0 & 127));
        TRJ(I_SQ, INP(I_WMK), 1024, 1024, WMKV, 1024, (const float*)nullptr, n0);
        TRJ(I_SQ, INP(I_WMV), 1024, 1024, WMKV, 1024, (const float*)nullptr, 1024 + n0);
        TRJ(I_W2, INP(I_F1W2), FF, 1024, W2_1, FF, (const float*)nullptr, n0);
        TRJ(I_IN, INP(I_WIN), 1024, 1696, WIN, 1024, INP(I_MIXN), (n0 < 384 ? 256 + n0 : (n0 < 640 ? n0 - 384 : (n0 < 672 ? n0 : n0 + 96))));
        TRJ(I_UQ, INP(I_WUQ), 384, 768, WUQ, 384, INP(I_QN), n0);
        TRJ(I_UKV, INP(I_WUKV), 256, 1024, WK, 256, (const float*)nullptr, ((n0 & 127) < 64 ? (n0 >> 7) * 64 + (n0 & 127) : 512 + (n0 >> 7) * 64 + (n0 & 127) - 64));
        TRJ(I_SQ, INP(I_WOUT), 1024, 1024, WOUT, 1024, (kb < 8 ? INP(I_AON) : (const float*)nullptr), n0);
        TRJ(I_SQ, INP(I_WMQ), 1024, 1024, WMQ, 1024, INP(I_XAN), n0);
        TRJ(I_SQ, INP(I_WMO), 1024, 1024, WMO, 1024, (const float*)nullptr, n0);
        TRJ(I_FFN, INP(I_F2W1), 1024, FF, W13_2, 1024, INP(I_F2N), (n0 >> 7) * 256 + (n0 & 127));
        TRJ(I_FFN, INP(I_F2W3), 1024, FF, W13_2, 1024, INP(I_F2N), (n0 >> 7) * 256 + 128 + (n0 & 127));
        TRJ(I_W2, INP(I_F2W2), FF, 1024, W2_2, FF, (const float*)nullptr, n0);
        { const int bb = r >> 7, rr = r & 127, kb = rr >> 5, n0 = (rr & 31) * 32;
          tr_item(INP(I_CMV) + (size_t)bb * 256 * 1024, 1024, kb * 64, n0, CMVTB + (size_t)bb * 1024 * 256, n0, 256, (const float*)nullptr, scr, lane); }
#undef TRJ
    };
    if (IN(0)) {
        { const int ngw0_ = NGW; const int nfirst = (G == 256) ? NA : NITEMS;
          for (int it = gw; it < nfirst; it += ngw0_) do_item(it); }
        const float* xp_ = INP(I_XP); const float* xs_ = INP(I_XS); const float* mem_ = INP(I_MEM); const float* cmk_ = INP(I_CMK); const float* memn_ = INP(I_MEMN);
        bf16_t* xb_ = XB; bf16_t* memb_ = MEMB; bf16_t* cmkb_ = CMKB; float* ssq0_ = ssq0; const int ngw_ = NGW;
        for (int m = gw; m < MT + 256 + 2048; m += ngw_) {
            const float* src; bf16_t* dst; int kind;
            if (m < TP) { src = xp_ + (size_t)m * DM; dst = xb_ + (size_t)m * DM; kind = 0; }
            else if (m < MT) { src = xs_ + (size_t)(m - TP) * DM; dst = xb_ + (size_t)m * DM; kind = 0; }
            else if (m < MT + 256) { src = mem_ + (size_t)(m - MT) * DM; dst = memb_ + (size_t)(m - MT) * DM; kind = 1; }
            else { src = cmk_ + (size_t)(m - MT - 256) * DM; dst = cmkb_ + (size_t)(m - MT - 256) * DM; kind = 2; }
            f32x4 v[4]; float s = 0.f;
#pragma unroll
            for (int j = 0; j < 4; ++j) { v[j] = *((const f32x4*)src + lane + 64 * j); s += (v[j][0] * v[j][0] + v[j][1] * v[j][1]) + (v[j][2] * v[j][2] + v[j][3] * v[j][3]); }
            if (kind != 2) s = wave_sum(s);
            if (kind == 0 && lane == 0) ssq0_[m] = s;
            if (kind == 1) { const float rs = __builtin_amdgcn_rsqf(s * (1.0f / 1024.0f) + EPS);
#pragma unroll
                for (int j = 0; j < 4; ++j) v[j] = v[j] * rs * *((const f32x4*)memn_ + lane + 64 * j); }
#pragma unroll
            for (int j = 0; j < 4; ++j) *((u32x2*)dst + lane + 64 * j) = (u32x2){pk2(v[j][0], v[j][1]), pk2(v[j][2], v[j][3])};
        }
        { float* z_ = ssq1; u32x4* wz_ = (u32x4*)(WIN + (size_t)672 * 1024); const size_t ngt_ = NGT;
          for (size_t i = gtid; i < (size_t)6 * MT; i += ngt_) z_[i] = 0.f;
          { f32x4* za_ = (f32x4*)ACCB(0); for (size_t i = gtid; i < (size_t)5 * TS * DM / 4; i += ngt_) za_[i] = (f32x4){0.f, 0.f, 0.f, 0.f}; }
          for (size_t i = gtid; i < (size_t)96 * 1024 / 8; i += ngt_) wz_[i] = (u32x4){0, 0, 0, 0}; }
    }
    SEAM(0);

    if (IN(1)) {
        { pg8::Gemm g{XB, W13_1, MT, 2 * FF, 1024, 1024, 1024}; pg8::Order S; S.init(MT, 2 * FF, G, blk, 0); pg8::EpiUp E{HID, ssq0};
          pg8::gemm_phase<pg8::EpiUp, pg8::Order, true, true>(lds, g, S, E); }
        { pg8::Gemm g{MEMB, WMKV, 256, 2048, 1024, 1024, 1024}; pg8::Order S; S.init(256, 2048, G, blk, 144); pg8::EpiMem E{out + O_MKP, out + O_MVP, MKB, MVB};
          pg8::gemm_phase<pg8::EpiMem, pg8::Order, true, true>(lds, g, S, E); }
        if (G == 256 && blk >= 152) { for (int it = NA + (blk - 152) * NWAVE + wave; it < NITEMS; it += (256 - 152) * NWAVE) do_item(it); }
    }
    SEAM(1);
    if (IN(2)) {
        { pg8::Gemm g{HID, W2_1, TP, 1024, FF, FF, FF}; pg8::Order S; S.init(TP, 1024, G, blk, 0);
          pg8::EpiRes E{XB, ssq1, nullptr, 0.f, 0.5f};
          pg8::gemm_phase<pg8::EpiRes, pg8::Order, true, true>(lds, g, S, E); }
        { pg8::Gemm g{HID, W2_1, TS, 1024, 256, FF, FF, 512}; pg8::Order S; S.init(TS, 1024, G, blk, 0, 64, 11);
          pg8::EpiAcc E{ACCB(0), nullptr, 0.f, 0, 0.5f};
          pg8::gemm_phase<pg8::EpiAcc, pg8::Order, true, true>(lds, g, S, E); }
    }
    SEAM(2);
    if (IN(3)) {
        if (blk >= G - 8) sample_finalize_part(blk - (G - 8), INP(I_XS), ACCB(0), XSA, XB + (size_t)TP * DM, ssq1 + TP, FLAGW(0));
        pg8::EpiWin E{ssq1, INP(I_KVN), out, CQ, ssqq, CKVP, CKVS, KPEP, KPES, XBR, GG, (LAS float*)(lds + LDS_EPI)};
        { pg8::Gemm g{XB, WIN, TP, 1792, 1024, 1024, 1024}; pg8::Order S; S.init(TP, 1792, G, blk, 0);
          pg8::gemm_phase<pg8::EpiWin, pg8::Order, true, true>(lds, g, S, E); }
        { pg8::Gemm g{XB, WIN, TS, 1792, 1024, 1024, 1024}; pg8::Order S; S.init(TS, 1792, G, blk, 192, 64); pg8::Unit u_;
          if (S.next(0, u_)) sample_wait(FLAGW(0), 8u);
          pg8::gemm_phase<pg8::EpiWin, pg8::Order, true, true>(lds, g, S, E); }
        if (G != 256 || blk >= 200) {
        { const f32x4* cckv_ = (const f32x4*)INP(I_CCKV); const f32x4* ckpe_ = (const f32x4*)INP(I_CKPE); bf16_t* ckvs_ = CKVS; bf16_t* kpes_ = KPES; bf16_t* mvtb_ = MVTB; const bf16_t* mvb_ = MVB; const bool idl_ = (G == 256); const size_t ngt_ = idl_ ? (size_t)(256 - 200) * NTHR : NGT; const size_t g0_ = idl_ ? (size_t)(blk - 200) * NTHR + tid : gtid;
          for (size_t i = g0_; i < (size_t)NBAT * PAST * 64; i += ngt_) { const size_t rw = i >> 6; const int c4 = (int)(i & 63); const int b = (int)(rw / PAST), t = (int)(rw % PAST);
              const f32x4 v = cckv_[i]; *(u32x2*)(ckvs_ + ((size_t)b * SKV + t) * 256 + c4 * 4) = (u32x2){pk2(v[0], v[1]), pk2(v[2], v[3])}; }
          for (size_t i = g0_; i < (size_t)NBAT * PAST * 8; i += ngt_) { const size_t rw = i >> 3; const int c4 = (int)(i & 7); const int b = (int)(rw / PAST), t = (int)(rw % PAST);
              const f32x4 v = ckpe_[i]; *(u32x2*)(kpes_ + ((size_t)b * SKV + t) * 32 + c4 * 4) = (u32x2){pk2(v[0], v[1]), pk2(v[2], v[3])}; }
          for (size_t i = g0_; i < (size_t)1024 * 256; i += ngt_) { const int d = (int)(i >> 8), k = (int)(i & 255); mvtb_[i] = mvb_[(size_t)k * DM + d]; } }
        }
    }
    SEAM(3);
    if (IN(4)) {
        { pg8::Gemm g{CQ, WUQ, MT, 768, QL, QL, QL}; pg8::Order S; S.init(MT, 768, G, blk, 0); pg8::EpiQ E{Q, ssqq};
          pg8::gemm_phase<pg8::EpiQ, pg8::Order, true, true>(lds, g, S, E); }
        { pg8::Gemm g{CKVP, WK, TP + MT, 512, 256, 256, 256}; pg8::Order S; S.init(TP + MT, 512, G, blk, 192); pg8::EpiStore E{KNP, 512, nullptr, 0.f, 1.f};
          pg8::gemm_phase<pg8::EpiStore, pg8::Order, true, true>(lds, g, S, E); }
        { pg8::Gemm g{WV, CKVP, 512, TP + MT, 256, 256, 256}; pg8::Order S; S.init(512, TP + MT, G, blk, 192); pg8::EpiStore E{VTP, VT_LD, nullptr, 0.f, 1.f};
          pg8::gemm_phase<pg8::EpiStore, pg8::Order, true, true>(lds, g, S, E); }
        const LruArgs LA{XBR, INP(I_CONVW), INP(I_CONVB), INP(I_LWA), INP(I_LBA), INP(I_LWX), INP(I_LBX), INP(I_LAM), INP(I_SCONV), INP(I_SLRU), HLOC, ACUM, ATOT, BTOT, out};
        { const int g_ = G; for (int u = (blk + g_ - (199 % g_)) % g_; u < 256; u += g_) lru_l1_unit(lds, u, LA); }
    }
    SEAM(4);
    if (IN(5)) {
        const int g_ = G; bf16_t* merged_ = MERGED; float* ssqa_ = ssqa; float* out_ = out;
        { const bf16_t* hloc_ = HLOC; const bf16_t* acum_ = ACUM; const bf16_t* gg_ = GG; const float* atot_ = ATOT; const float* btot_ = BTOT; const float* lon_ = INP(I_LON);
          for (int u = blk; u < 256; u += g_) lru_l3_unit(lds, u, hloc_, acum_, gg_, atot_, btot_, lon_, merged_, out_);
          const LruArgs LA{XBR, INP(I_CONVW), INP(I_CONVB), INP(I_LWA), INP(I_LBA), INP(I_LWX), INP(I_LBX), INP(I_LAM), INP(I_SCONV), INP(I_SLRU), HLOC, ACUM, ATOT, BTOT, out};
          for (int u = (blk + g_ - (128 % g_)) % g_; u < 8; u += g_) { lru_l1_unit(lds, 256 + u, LA); asm volatile("s_waitcnt vmcnt(0)" ::: "memory"); __syncthreads();
              lru_l3_unit(lds, 256 + u, hloc_, acum_, gg_, atot_, btot_, lon_, merged_, out_); } }
        { const bf16_t* q_ = Q; const bf16_t* knp_ = KNP; const bf16_t* kpep_ = KPEP; const bf16_t* vtp_ = VTP;
          for (int p = vcu; p < 256; p += g_) {
              const int h = p >> 5, s = p & 31;
              mla_prompt_unit(lds, h, 63 - s, q_, knp_, kpep_, vtp_, merged_, ssqa_);
              mla_prompt_unit(lds, h, s, q_, knp_, kpep_, vtp_, merged_, ssqa_);
          }
          const bf16_t* kns_ = KNS; const bf16_t* kpes_ = KPES; const bf16_t* vts_ = VTS;
          for (int u = blk; u < 64; u += g_) mla_sample_unit(lds, u >> 3, u & 7, q_, kns_, kpes_, vts_, merged_, ssqa_); }
    }
    SEAM(5);
    if (IN(6)) {
        { pg8::Gemm g{MERGED, WOUT, TP, 1024, 1024, 1024, 1024}; pg8::Order S; S.init(TP, 1024, G, blk, 0);
          pg8::EpiResMid E{{XB, ssq2, nullptr, 0.f, 1.f}, ssqa};
          pg8::gemm_phase<pg8::EpiResMid, pg8::Order, true, true>(lds, g, S, E); }
        { pg8::Gemm g{MERGED, WOUT, TS, 1024, 256, 1024, 1024, 512}; pg8::Order Ss; Ss.init(TS, 1024, G, blk, 0, 64, 4);
          pg8::EpiAcc E{ACCB(1), ssqa, 1.0f / 512.0f, 2, 1.f};
          pg8::gemm_phase<pg8::EpiAcc, pg8::Order, true, true>(lds, g, Ss, E); }
    }
    SEAM(6);
    if (IN(7)) {
        if (blk >= G - 8) sample_finalize_part(blk - (G - 8), XSA, ACCB(1), XSB, XB + (size_t)TP * DM, ssq2 + TP, FLAGW(1));
        { pg8::Gemm g{XB, WMQ, TP, 1024, 1024, 1024, 1024}; pg8::Order S; S.init(TP, 1024, G, blk, 0); pg8::EpiStore E{QM, 1024, ssq2, 1.0f / 1024.0f, XSCALE};
          pg8::gemm_phase<pg8::EpiStore, pg8::Order, true, true>(lds, g, S, E);
          asm volatile("s_waitcnt vmcnt(0)" ::: "memory"); __syncthreads();
          bf16_t* qm_ = QM; const bf16_t* mkb_ = MKB; const bf16_t* mvtb_ = MVTB; pg8::Unit u_;
          for (int i = 0; S.next(i, u_); ++i) xattn_unit(lds, u_.pm * 256, false, u_.pn, qm_, mkb_, mvtb_, nullptr, nullptr); }
        { pg8::Gemm g{XB, WMQ, TS, 1024, 256, 1024, 1024, 512}; pg8::Order S; S.init(TS, 1024, G, blk, 0, 64, 4); pg8::Unit u_;
          if (S.next(0, u_)) sample_wait(FLAGW(1), 8u);
          pg8::EpiAcc E{ACCB(2), nullptr, 0.f, 0, 1.f};
          pg8::gemm_phase<pg8::EpiAcc, pg8::Order, true, true>(lds, g, S, E); }
    }
    SEAM(7);
    if (IN(9)) {
        { const int g_ = G; bf16_t* qm_ = QM; const bf16_t* cmkb_ = CMKB; const bf16_t* cmvtb_ = CMVTB; const float* qacc_ = ACCB(2); const float* ssq2_ = ssq2;
          for (int u = g_ - 1 - blk; u < 32; u += g_) { const int b = u >> 2;
              xattn_unit(lds, TP + b * 32, true, u & 3, qm_, cmkb_ + (size_t)b * 256 * DM, cmvtb_ + (size_t)b * 1024 * 256, qacc_, ssq2_);
              asm volatile("s_waitcnt vmcnt(0)" ::: "memory"); __syncthreads();
              if (tid == 0) { __builtin_amdgcn_fence(__ATOMIC_RELEASE, "agent"); asm volatile("s_waitcnt vmcnt(0)" ::: "memory"); __hip_atomic_fetch_add(FLAGW(3), 1u, __ATOMIC_RELAXED, __HIP_MEMORY_SCOPE_AGENT); } } }
        { pg8::Gemm g{QM, WMO, TP, 1024, 1024, 1024, 1024}; pg8::Order S; S.init(TP, 1024, G, blk, 0);
          pg8::EpiRes E{XB, ssq3, nullptr, 0.f, 1.f};
          pg8::gemm_phase<pg8::EpiRes, pg8::Order, true, true>(lds, g, S, E); }
        { pg8::Gemm g{QM, WMO, TS, 1024, 256, 1024, 1024, 512}; pg8::Order S; S.init(TS, 1024, G, blk, 0, 64, 4); pg8::Unit u_;
          if (S.next(0, u_)) sample_wait(FLAGW(3), 32u);
          pg8::EpiAcc E{ACCB(3), nullptr, 0.f, 0, 1.f};
          pg8::gemm_phase<pg8::EpiAcc, pg8::Order, true, true>(lds, g, S, E); }
    }
    SEAM(9);
    if (IN(10)) {
        if (blk >= G - 8) sample_finalize_part(blk - (G - 8), XSB, ACCB(3), XSA, XB + (size_t)TP * DM, ssq3 + TP, FLAGW(2));
        pg8::EpiUp E{HID, ssq3};
        { pg8::Gemm g{XB, W13_2, TP, 2 * FF, 1024, 1024, 1024}; pg8::Order S; S.init(TP, 2 * FF, G, blk, 0);
          pg8::gemm_phase<pg8::EpiUp, pg8::Order, true, true>(lds, g, S, E); }
        { pg8::Gemm g{XB, W13_2, TS, 2 * FF, 1024, 1024, 1024}; pg8::Order S; S.init(TS, 2 * FF, G, blk, 128, 64); pg8::Unit u_;
          if (S.next(0, u_)) sample_wait(FLAGW(2), 8u);
          pg8::gemm_phase<pg8::EpiUp, pg8::Order, true, true>(lds, g, S, E); }
    }
    SEAM(10);
    if (IN(11)) {
        { pg8::Gemm g{HID, W2_2, TP, 1024, FF, FF, FF}; pg8::Order S; S.init(TP, 1024, G, blk, 0);
          pg8::EpiRes E{XB, ssq4, nullptr, 0.f, 0.5f};
          pg8::gemm_phase<pg8::EpiRes, pg8::Order, true, true>(lds, g, S, E); }
        { pg8::Gemm g{HID, W2_2, TS, 1024, 256, FF, FF, 512}; pg8::Order S; S.init(TS, 1024, G, blk, 0, 64, 11);
          pg8::EpiAcc E{ACCB(4), nullptr, 0.f, 0, 0.5f};
          pg8::gemm_phase<pg8::EpiAcc, pg8::Order, true, true>(lds, g, S, E); }
    }
    SEAM(11);
    if (IN(12)) {
        float* x_ = X; const float* s4_ = ssq4; const f32x4* fn_ = (const f32x4*)INP(I_FINN); const int ngw_ = NGW; const float* xs_ = XSA; const float* acc_ = ACCB(4); const bf16_t* xb12_ = XB;
        for (int m = gw; m < MT; m += ngw_) {
            f32x4* xr = (f32x4*)(x_ + (size_t)m * DM);
            if (m < TP) {
                const float rs = __builtin_amdgcn_rsqf(s4_[m] * (1.0f / 1024.0f) + EPS);
                const u32x2* xbr = (const u32x2*)(xb12_ + (size_t)m * DM);
#pragma unroll
                for (int j = 0; j < 4; ++j) { const u32x2 b = xbr[lane + 64 * j]; const f32x4 v = (f32x4){__builtin_bit_cast(float, b[0] << 16), __builtin_bit_cast(float, b[0] & 0xffff0000u), __builtin_bit_cast(float, b[1] << 16), __builtin_bit_cast(float, b[1] & 0xffff0000u)};
                    xr[lane + 64 * j] = v * rs * fn_[lane + 64 * j]; }
            } else {
                const size_t r = (size_t)(m - TP) * DM; f32x4 v[4]; float s = 0.f;
#pragma unroll
                for (int j = 0; j < 4; ++j) { v[j] = *((const f32x4*)(xs_ + r) + lane + 64 * j) + *((const f32x4*)(acc_ + r) + lane + 64 * j);
                    s += (v[j][0] * v[j][0] + v[j][1] * v[j][1]) + (v[j][2] * v[j][2] + v[j][3] * v[j][3]); }
                const float rs = __builtin_amdgcn_rsqf(wave_sum(s) * (1.0f / 1024.0f) + EPS);
#pragma unroll
                for (int j = 0; j < 4; ++j) xr[lane + 64 * j] = v[j] * rs * fn_[lane + 64 * j];
            }
        }
    }
#undef IN
#undef SEAM
}

#undef INP
#undef X
#undef tid
#undef lane
#undef out
#undef ws
#undef lo
#undef hi
#undef G
#undef blk
#undef vcu
#undef gw
#undef NGW
#undef gtid
#undef NGT
#ifndef MK_N_LAUNCHES
#define MK_N_LAUNCHES 1
#endif
extern "C" void kernel_launch(void* const* d_in, const int* in_sizes, int n_in, void* d_out, int out_size, void* d_ws, size_t ws_size, hipStream_t stream) {
    static int grid = 0;
    if (grid == 0) {
        int dev = 0, cus = 0, per_cu = 0;
        hipGetDevice(&dev);
        hipDeviceGetAttribute(&cus, hipDeviceAttributeMultiprocessorCount, dev);
        if (hipFuncSetAttribute((const void*)mk_fwd, hipFuncAttributeMaxDynamicSharedMemorySize, LDS_BYTES) != hipSuccess) fprintf(stderr, "kernel_launch: hipFuncSetAttribute failed\n");
        if (hipOccupancyMaxActiveBlocksPerMultiprocessor(&per_cu, (const void*)mk_fwd, NTHR, LDS_BYTES) != hipSuccess || per_cu < 1) { fprintf(stderr, "kernel_launch: occupancy query gave %d\n", per_cu); per_cu = 1; }
        (void)hipGetLastError();
        grid = cus * per_cu;
        if (n_in != 40 || ws_size < WS_END) { fprintf(stderr, "kernel_launch: unexpected n_in %d / ws %zu\n", n_in, ws_size); }
    }
    (void)hipMemsetAsync((unsigned char*)d_ws + WS_BAR, 0, 16384, stream);
    Args a{};
    for (int i = 0; i < 40; ++i) a.in[i] = (const float*)d_in[i];
    a.out = (float*)d_out; a.ws = (unsigned char*)d_ws;
#if MK_N_LAUNCHES == 1
    a.ph_lo = 0; a.ph_hi = NPHASE;
    void* args[] = {&a};
    hipError_t e = hipLaunchCooperativeKernel((const void*)mk_fwd, dim3(grid), dim3(NTHR), args, LDS_BYTES, stream);
    if (e != hipSuccess) fprintf(stderr, "kernel_launch: cooperative launch failed: %s (grid %d)\n", hipGetErrorString(e), grid);
#else
    for (int p = 0; p < NPHASE; ++p) { a.ph_lo = p; a.ph_hi = p + 1; hipLaunchKernelGGL(mk_fwd, dim3(grid), dim3(NTHR), LDS_BYTES, stream, a); }
#endif
}
```

```cpp
#include <hip/hip_runtime.h>
#include <hip/hip_cooperative_groups.h>
#include <cstdio>
#include <cstdint>
namespace cg = cooperative_groups;

#define LAS __attribute__((address_space(3)))
typedef unsigned short bf16_t;
typedef short bf16x8 __attribute__((ext_vector_type(8)));
typedef short s16x4 __attribute__((ext_vector_type(4)));
typedef float f32x4 __attribute__((ext_vector_type(4)));
typedef float f32x16 __attribute__((ext_vector_type(16)));
typedef unsigned u32x4 __attribute__((ext_vector_type(4)));
typedef unsigned u32x2 __attribute__((ext_vector_type(2)));

constexpr int TP = 16384, TS = 256, MT = TP + TS, DM = 1024, FF = 2816, QL = 384, KVL = 256, NBAT = 8, DSEQ = 32, PAST = 2048, SKV = PAST + DSEQ  ;
constexpr int VT_LD = 33152;
constexpr int VTS_LD = VT_LD;
constexpr float EPS = 1e-6f;
constexpr float LOG2E = 1.4426950408889634f;
constexpr float QSCALE = 0.10206207261596575f * LOG2E;
constexpr float XSCALE = 0.0625f * LOG2E;
constexpr int NTHR = 512, NWAVE = 8;
constexpr int LDS_BYTES = 147456;
constexpr int LDS_EPI = 131072;

constexpr size_t O_Y = 0, O_YS = 16777216, O_CKVP = 17039360, O_KPEP = 21233664, O_CONVP = 21757952, O_LRUP = 21759488,
                 O_MKP = 21760000, O_MVP = 22022144, O_CKVS = 22284288, O_KPES = 22349824, O_CONVS = 22358016, O_LRUS = 22370304;

constexpr size_t U64K = 65536;
constexpr size_t WS_SSQ = 0;
constexpr size_t WS_BAR = 466944;
constexpr size_t WS_ATOT = 16 * U64K, WS_BTOT = 32 * U64K;
constexpr size_t WS_W13_1 = 64 * U64K;
constexpr size_t WS_W2_1 = WS_W13_1 + 176 * U64K;
constexpr size_t WS_W13_2 = WS_W2_1 + 88 * U64K;
constexpr size_t WS_W2_2 = WS_W13_2 + 176 * U64K;
constexpr size_t WS_WIN = WS_W2_2 + 88 * U64K;
constexpr size_t WS_WUQ = WS_WIN + 56 * U64K;
constexpr size_t WS_WK = WS_WUQ + 9 * U64K;
constexpr size_t WS_WV = WS_WK + 4 * U64K;
constexpr size_t WS_WOUT = WS_WV + 4 * U64K;
constexpr size_t WS_WMQ = WS_WOUT + 32 * U64K;
constexpr size_t WS_WMKV = WS_WMQ + 32 * U64K;
constexpr size_t WS_WMO = WS_WMKV + 64 * U64K;
constexpr size_t WS_MEMB = 52 * 16 * U64K;
constexpr size_t WS_MKB = WS_MEMB + 8 * U64K, WS_MVTB = WS_MKB + 8 * U64K, WS_MVB = WS_MVTB + 8 * U64K, WS_CMKB = WS_MVB + 8 * U64K, WS_CMVTB = WS_CMKB + 64 * U64K;
constexpr size_t WS_XB = 62 * 16 * U64K;
constexpr size_t WS_HLOC = WS_XB, WS_ACUM = WS_XB + 260 * U64K;
constexpr size_t WS_R = 95 * 16 * U64K;
constexpr size_t WS_HID = WS_R;
constexpr size_t WS_CQ = WS_R;
constexpr size_t WS_CKVP = WS_CQ + 195 * U64K;
constexpr size_t WS_CKVS = WS_CKVP + 128 * U64K;
constexpr size_t WS_XBR = WS_CKVS + 130 * U64K;
constexpr size_t WS_MERGED = WS_R;
constexpr size_t WS_GG = WS_R + 720 * U64K;
constexpr size_t WS_Q = WS_GG + 260 * U64K;
constexpr size_t WS_KNP = WS_Q + 390 * U64K;
constexpr size_t WS_KNS = WS_KNP + 256 * U64K;
constexpr size_t WS_VTP = WS_KNS + 261 * U64K;
constexpr size_t WS_VTS = WS_VTP + 256 * U64K;
constexpr size_t WS_KPEP = WS_VTS + 262 * U64K;
constexpr size_t WS_KPES = WS_KPEP + 16 * U64K;
constexpr size_t WS_QM = WS_R + 768 * U64K;
constexpr size_t WS_END = WS_KPES + 17 * U64K;
constexpr size_t WS_ACC = 248 * 16 * U64K;
constexpr size_t WS_XSA = 253 * 16 * U64K, WS_XSB = 254 * 16 * U64K;
static_assert(WS_WMO + 32 * U64K <= WS_MEMB && WS_CMVTB + 64 * U64K <= WS_XB && WS_XB + 520 * U64K <= WS_R, "ws map 1");
static_assert(WS_XBR + 260 * U64K <= WS_GG && WS_END <= WS_ACC && WS_HID + (size_t)MT * FF * 2 <= 256u * 16 * U64K, "ws map 2");

__device__ __forceinline__ unsigned f2bf(float f) { unsigned u = __builtin_bit_cast(unsigned, f); return (u + 0x7fffu + ((u >> 16) & 1u)) >> 16; }
__device__ __forceinline__ unsigned pk2(float lo, float hi) { unsigned r; asm volatile("v_cvt_pk_bf16_f32 %0, %1, %2" : "=v"(r) : "v"(lo), "v"(hi)); return r; }
__device__ __forceinline__ float bf2f(unsigned short b) { return __builtin_bit_cast(float, (unsigned)b << 16); }
__device__ __forceinline__ float wave_sum(float v) {
#pragma unroll
    for (int o = 1; o < 64; o <<= 1) v += __shfl_xor(v, o);
    return v;
}
__device__ __forceinline__ void atomic_addf(float* p, float v) { __hip_atomic_fetch_add(p, v, __ATOMIC_RELAXED, __HIP_MEMORY_SCOPE_AGENT); }
__device__ __forceinline__ float sigmoidf_(float x) { return 1.f / (1.f + __expf(-x)); }
__device__ __forceinline__ float gelu_tanh(float v) { const float u = 1.5957691216057308f * (v + 0.044715f * v * v * v); return v * __builtin_amdgcn_rcpf(1.f + __builtin_amdgcn_exp2f(-LOG2E * u)); }
__device__ __forceinline__ void rope_cs(int pos, int j, float& c, float& s) {
    const float inv = __builtin_amdgcn_exp2f(-0.8304820237218406f * (float)j);
    const float ang = (float)pos * inv;
    const float k = rintf(ang * 0.15915494309189535f);
    float r = fmaf(-k, 6.28125f, ang); r = fmaf(-k, 0.0019353071795864769f, r);
    c = __cosf(r); s = __sinf(r);
}
namespace pg8 {
#define PG8_LAS __attribute__((address_space(3)))
typedef unsigned short bf16_t;
typedef short bf16x8 __attribute__((ext_vector_type(8)));
typedef float f32x4 __attribute__((ext_vector_type(4)));
typedef unsigned u32x4 __attribute__((ext_vector_type(4)));
constexpr int BM = 256, BK = 64, HALF = 128, HTB = HALF * BK * 2  , STAGE_BYTES = 8 * HTB, NXCD = 8, WGM = 8;

__host__ __device__ __forceinline__ int lds_byte(int r, int c) { const int st = (r >> 4) * 2 + (c >> 5), rr = r & 15, cc = c & 31, ob = rr * 64 + cc * 2; return st * 1024 + (ob ^ (((ob >> 9) & 1) << 5)); }
__host__ __device__ __forceinline__ void stage_rc(int b, int& R, int& C) { const int st = b / 1024, sb = b % 1024, swz = sb ^ (((sb >> 9) & 1) << 5); R = (st >> 1) * 16 + swz / 64; C = (st & 1) * 32 + (swz % 64) / 2; }
__host__ __device__ __forceinline__ int perm32(int rho) { const int n = rho >> 4, i = rho & 15; return 8 * (i >> 2) + 4 * n + (i & 3); }

struct Unit { int pm, pn, kc; };
struct Gemm { const bf16_t* A; const bf16_t* Bt; int M, N, K, lda, ldb, kcb; };

struct StaticOrder {
    int nM, nN, nwg, G, c;
    __host__ __device__ void init(int M, int N, int G_, int c_) { nM = M / BM; nN = N / BM; nwg = nM * nN; G = G_; c = c_; }
    __host__ __device__ bool next(int i, Unit& u) const {
        const long L = (long)i * G + c; if (L >= nwg) return false;
        int wgid = (int)L; { const int q = nwg / NXCD, r = nwg % NXCD, xcd = wgid % NXCD, off = wgid / NXCD; wgid = (xcd < r ? xcd * (q + 1) : r * (q + 1) + (xcd - r) * q) + off; }
        const int nig = WGM * nN, gid = wgid / nig, fm = gid * WGM, gsz = (nM - fm) < WGM ? (nM - fm) : WGM;
        u.pm = fm + ((wgid % nig) % gsz); u.pn = (wgid % nig) / gsz; u.kc = 0; return true;
    }
    __device__ __forceinline__ void a_ready(const Unit&) const {}
    __device__ __forceinline__ void done(const Unit&) const {}
};

__device__ __forceinline__ unsigned cvt_pk_bf16(float lo, float hi) { unsigned r; asm volatile("v_cvt_pk_bf16_f32 %0, %1, %2" : "=v"(r) : "v"(lo), "v"(hi)); return r; }

struct Order {
    int nM, nN, nK, nwg, G, c, pmo;
    __device__ __forceinline__ void init(int M, int N, int G_, int blk, int rot, int pm_off = 0, int nK_ = 1) { nM = M / BM; nN = N / BM; nK = nK_; nwg = nM * nN * nK_; G = G_; c = (blk + G_ - (rot % G_)) % G_; pmo = pm_off; }
    __device__ __forceinline__ bool next(int i, Unit& u) const {
        const long L = (long)i * G + c; if (L >= nwg) return false;
        int wgid = (int)L; { const int q = nwg / NXCD, r = nwg % NXCD, xcd = wgid % NXCD, off = wgid / NXCD; wgid = (xcd < r ? xcd * (q + 1) : r * (q + 1) + (xcd - r) * q) + off; }
        u.kc = wgid % nK; wgid /= nK;
        const int nig = WGM * nN, gid = wgid / nig, fm = gid * WGM, gsz = (nM - fm) < WGM ? (nM - fm) : WGM;
        u.pm = pmo + fm + ((wgid % nig) % gsz); u.pn = (wgid % nig) / gsz; return true;
    }
    __device__ __forceinline__ void a_ready(const Unit&) const {}
    __device__ __forceinline__ void done(const Unit&) const {}
};

struct EpiAcc {
    static constexpr bool PERM = false, AFTER_DRAIN = false, MIDSCALE = false, PREFETCH = false;
    float* ACC; const float* rs_in; float rs_invn; int kc_lim; float alpha;
    __device__ __forceinline__ void operator()(const f32x4 (&acc)[2][2][4][2], const Unit& u, int wr, int wc, int fr, int fq) const {
        const int col0 = u.pn * BM + wc * 32 + 4 * fq;
#pragma unroll
        for (int ai = 0; ai < 2; ++ai)
#pragma unroll
            for (int m = 0; m < 4; ++m) {
                const int rl = ai * HALF + wr * 64 + m * 16 + fr;
                float sc = alpha; if (rs_in && u.kc < kc_lim) sc *= __builtin_amdgcn_rsqf(rs_in[TP + rl] * rs_invn + EPS);
#pragma unroll
                for (int bj = 0; bj < 2; ++bj)
#pragma unroll
                    for (int n = 0; n < 2; ++n) {
                        float* p = ACC + (size_t)rl * DM + col0 + bj * HALF + n * 16; const f32x4 v = acc[ai][bj][m][n] * sc;
                        atomic_addf(p, v[0]); atomic_addf(p + 1, v[1]); atomic_addf(p + 2, v[2]); atomic_addf(p + 3, v[3]);
                    }
            }
    }
};

struct EpiUp {
    static constexpr bool PERM = true, AFTER_DRAIN = false, MIDSCALE = false, PREFETCH = true;
    bf16_t* H; const float* ssq;
    __device__ __forceinline__ void prefetch(float (&pre)[8], const Unit& u, int wr, int fr) const {
#pragma unroll
        for (int ai = 0; ai < 2; ++ai)
#pragma unroll
            for (int m = 0; m < 4; ++m) pre[ai * 4 + m] = ssq[u.pm * BM + ai * HALF + wr * 64 + m * 16 + fr];
    }
    __device__ __forceinline__ void operator()(const f32x4 (&acc)[2][2][4][2], const Unit& u, int wr, int wc, int fr, int fq, const float (&pre)[8]) const {
        const int col = u.pn * 128 + wc * 32 + 8 * fq;
#pragma unroll
        for (int ai = 0; ai < 2; ++ai)
#pragma unroll
            for (int m = 0; m < 4; ++m) {
                const int row = u.pm * BM + ai * HALF + wr * 64 + m * 16 + fr;
                const float r = __builtin_amdgcn_rsqf(pre[ai * 4 + m] * (1.0f / 1024.0f) + EPS);
                const float rl = -LOG2E * r, r2 = r * r;
                typedef float f32x2e __attribute__((ext_vector_type(2)));
                unsigned w[4];
#pragma unroll
                for (int n = 0; n < 2; ++n) {
                    const f32x4 ag = acc[ai][0][m][n], au = acc[ai][1][m][n];
#pragma unroll
                    for (int hh = 0; hh < 2; ++hh) {
                        const f32x2e g2 = (f32x2e){ag[2 * hh], ag[2 * hh + 1]}, u2 = (f32x2e){au[2 * hh], au[2 * hh + 1]};
                        const f32x2e e2 = g2 * rl; f32x2e d2 = (f32x2e){__builtin_amdgcn_exp2f(e2[0]), __builtin_amdgcn_exp2f(e2[1])} + 1.0f;
                        const f32x2e rc2 = (f32x2e){__builtin_amdgcn_rcpf(d2[0]), __builtin_amdgcn_rcpf(d2[1])};
                        const f32x2e v2 = (g2 * u2) * (rc2 * r2);
                        w[2 * n + hh] = cvt_pk_bf16(v2[0], v2[1]);
                    }
                }
                *(u32x4*)(H + (size_t)row * FF + col) = (u32x4){w[0], w[1], w[2], w[3]};
            }
    }
};

struct EpiRes {
    static constexpr bool PERM = true, AFTER_DRAIN = false, MIDSCALE = false, PREFETCH = false;
    bf16_t* XB; float* ssq_out; const float* rs_in; float rs_invn; float alpha;
    __device__ __forceinline__ void operator()(const f32x4 (&acc)[2][2][4][2], const Unit& u, int wr, int wc, int fr, int fq) const {
        const int col0 = u.pn * BM + wc * 32 + 8 * fq;
#pragma unroll
        for (int ai = 0; ai < 2; ++ai)
#pragma unroll
            for (int m = 0; m < 4; ++m) {
                const int row = u.pm * BM + ai * HALF + wr * 64 + m * 16 + fr;
                float sc = alpha; if (rs_in) sc *= __builtin_amdgcn_rsqf(rs_in[row] * rs_invn + EPS);
                typedef float f32x2r __attribute__((ext_vector_type(2)));
                f32x2r sq2 = (f32x2r){0.f, 0.f};
#pragma unroll
                for (int bj = 0; bj < 2; ++bj) {
                    bf16_t* p = XB + (size_t)row * DM + col0 + bj * HALF;
                    const u32x4 b = *(const u32x4*)p; f32x2r o2[4];
#pragma unroll
                    for (int k = 0; k < 4; ++k) {
                        const f32x2r x2 = (f32x2r){__builtin_bit_cast(float, b[k] << 16), __builtin_bit_cast(float, b[k] & 0xffff0000u)};
                        const f32x4 av = acc[ai][bj][m][k >> 1];
                        const f32x2r a2 = (k & 1) ? (f32x2r){av[2], av[3]} : (f32x2r){av[0], av[1]};
                        o2[k] = x2 + a2 * sc; sq2 += o2[k] * o2[k];
                    }
                    *(u32x4*)p = (u32x4){cvt_pk_bf16(o2[0][0], o2[0][1]), cvt_pk_bf16(o2[1][0], o2[1][1]), cvt_pk_bf16(o2[2][0], o2[2][1]), cvt_pk_bf16(o2[3][0], o2[3][1])};
                }
                float sq = sq2[0] + sq2[1];
                if (ssq_out) { sq += __shfl_xor(sq, 16); sq += __shfl_xor(sq, 32); if (fq == 0) atomic_addf(ssq_out + row, sq); }
            }
    }
};

struct EpiResMid : EpiRes {
    static constexpr bool MIDSCALE = true;
    const float* ssqa;
    __device__ __forceinline__ void midscale(f32x4 (&acc)[2][2][4][2], const Unit& u, int wr, int fr) const {
#pragma unroll
        for (int ai = 0; ai < 2; ++ai)
#pragma unroll
            for (int m = 0; m < 4; ++m) {
                const float f = __builtin_amdgcn_rsqf(ssqa[u.pm * BM + ai * HALF + wr * 64 + m * 16 + fr] * (1.0f / 512.0f) + EPS);
#pragma unroll
                for (int bj = 0; bj < 2; ++bj)
#pragma unroll
                    for (int n = 0; n < 2; ++n) acc[ai][bj][m][n] *= f;
            }
    }
};

struct EpiStore {
    static constexpr bool PERM = true, AFTER_DRAIN = false, MIDSCALE = false, PREFETCH = false;
    bf16_t* O; int ldc; const float* rs_in; float rs_invn; float scale;
    __device__ __forceinline__ void operator()(const f32x4 (&acc)[2][2][4][2], const Unit& u, int wr, int wc, int fr, int fq) const {
        const int col0 = u.pn * BM + wc * 32 + 8 * fq;
#pragma unroll
        for (int ai = 0; ai < 2; ++ai)
#pragma unroll
            for (int m = 0; m < 4; ++m) {
                const int row = u.pm * BM + ai * HALF + wr * 64 + m * 16 + fr;
                float sc = scale; if (rs_in) sc *= __builtin_amdgcn_rsqf(rs_in[row] * rs_invn + EPS);
#pragma unroll
                for (int bj = 0; bj < 2; ++bj) {
                    const f32x4 v0 = acc[ai][bj][m][0] * sc, v1 = acc[ai][bj][m][1] * sc;
                    *(u32x4*)(O + (size_t)row * ldc + col0 + bj * HALF) = (u32x4){cvt_pk_bf16(v0[0], v0[1]), cvt_pk_bf16(v0[2], v0[3]), cvt_pk_bf16(v1[0], v1[1]), cvt_pk_bf16(v1[2], v1[3])};
                }
            }
    }
};

struct EpiMem {
    static constexpr bool PERM = false, AFTER_DRAIN = false, MIDSCALE = false, PREFETCH = false;
    float* outk; float* outv; bf16_t* KB; bf16_t* VB;
    __device__ __forceinline__ void operator()(const f32x4 (&acc)[2][2][4][2], const Unit& u, int wr, int wc, int fr, int fq) const {
        const bool isv = u.pn >= 4; const int col0 = (u.pn & 3) * BM + wc * 32 + 4 * fq;
        float* of = isv ? outv : outk; bf16_t* ob = isv ? VB : KB;
#pragma unroll
        for (int ai = 0; ai < 2; ++ai)
#pragma unroll
            for (int m = 0; m < 4; ++m) {
                const int row = ai * HALF + wr * 64 + m * 16 + fr;
#pragma unroll
                for (int bj = 0; bj < 2; ++bj)
#pragma unroll
                    for (int n = 0; n < 2; ++n) {
                        const int col = col0 + bj * HALF + n * 16; const f32x4 o = acc[ai][bj][m][n];
                        *(f32x4*)(of + (size_t)row * DM + col) = o;
                        *(u32x2*)(ob + (size_t)row * DM + col) = (u32x2){cvt_pk_bf16(o[0], o[1]), cvt_pk_bf16(o[2], o[3])};
                    }
            }
    }
};

struct EpiQ {
    static constexpr bool PERM = false, AFTER_DRAIN = false, MIDSCALE = false, PREFETCH = false;
    bf16_t* Q; const float* ssqq;
    __device__ __forceinline__ void operator()(const f32x4 (&acc)[2][2][4][2], const Unit& u, int wr, int wc, int fr, int fq) const {
#pragma unroll
        for (int ai = 0; ai < 2; ++ai)
#pragma unroll
            for (int m = 0; m < 4; ++m) {
                const int row = u.pm * BM + ai * HALF + wr * 64 + m * 16 + fr;
                const float sc = QSCALE * __builtin_amdgcn_rsqf(ssqq[row] * (1.0f / 384.0f) + EPS);
                const int pos = row < TP ? row : PAST + ((row - TP) & 31);
#pragma unroll
                for (int bj = 0; bj < 2; ++bj) {
                    const int gidx = u.pn * 8 + bj * 4 + wc; const int c0 = gidx * 32 + 4 * fq;
                    f32x4 v0 = acc[ai][bj][m][0] * sc, v1 = acc[ai][bj][m][1] * sc;
                    if (gidx % 3 == 2) {
#pragma unroll
                        for (int i = 0; i < 4; ++i) { float c, s; rope_cs(pos, 4 * fq + i, c, s); const float a = v0[i], b = v1[i]; v0[i] = a * c - b * s; v1[i] = b * c + a * s; }
                    }
                    *(u32x2*)(Q + (size_t)row * 768 + c0) = (u32x2){cvt_pk_bf16(v0[0], v0[1]), cvt_pk_bf16(v0[2], v0[3])};
                    *(u32x2*)(Q + (size_t)row * 768 + c0 + 16) = (u32x2){cvt_pk_bf16(v1[0], v1[1]), cvt_pk_bf16(v1[2], v1[3])};
                }
            }
    }
};

struct EpiWin {
    static constexpr bool PERM = false, AFTER_DRAIN = false, MIDSCALE = false, PREFETCH = false;
    const float* ssq1; const float* kvg; float* out; bf16_t* CQ; float* ssqq; bf16_t* CKVP; bf16_t* CKVS; bf16_t* KPEP; bf16_t* KPES; bf16_t* XBR; bf16_t* GG; LAS float* P;
    __device__ __forceinline__ void operator()(const f32x4 (&acc)[2][2][4][2], const Unit& u, int wr, int wc, int fr, int fq) const {
        const int pn = u.pn;
        if (pn == 0) {
#pragma unroll
            for (int ai = 0; ai < 2; ++ai)
#pragma unroll
                for (int m = 0; m < 4; ++m) {
                    const int row = u.pm * BM + ai * HALF + wr * 64 + m * 16 + fr;
                    const float r = __builtin_amdgcn_rsqf(ssq1[row] * (1.0f / 1024.0f) + EPS);
                    float sq = 0.f;
#pragma unroll
                    for (int bj = 0; bj < 2; ++bj)
#pragma unroll
                        for (int n = 0; n < 2; ++n) { const f32x4 v = acc[ai][bj][m][n] * r; sq += (v[0] * v[0] + v[1] * v[1]) + (v[2] * v[2] + v[3] * v[3]); }
                    sq += __shfl_xor(sq, 16); sq += __shfl_xor(sq, 32);
                    if (fq == 0) P[(ai * HALF + wr * 64 + m * 16 + fr) * 4 + wc] = sq;
                }
            asm volatile("s_waitcnt lgkmcnt(0)" ::: "memory"); __builtin_amdgcn_s_barrier(); asm volatile("" ::: "memory");
#pragma unroll
            for (int ai = 0; ai < 2; ++ai)
#pragma unroll
                for (int m = 0; m < 4; ++m) {
                    const int rl = ai * HALF + wr * 64 + m * 16 + fr; const int row = u.pm * BM + rl;
                    const f32x4 pp = *(const LAS f32x4*)(P + rl * 4);
                    const float rk = __builtin_amdgcn_rsqf(((pp[0] + pp[1]) + (pp[2] + pp[3])) * (1.0f / 256.0f) + EPS) * __builtin_amdgcn_rsqf(ssq1[row] * (1.0f / 1024.0f) + EPS);
                    float* of; bf16_t* ob;
                    if (row < TP) { of = out + O_CKVP + (size_t)row * 256; ob = CKVP + (size_t)row * 256; }
                    else { const int rs = row - TP; of = out + O_CKVS + (size_t)rs * 256; ob = CKVS + (size_t)((rs >> 5) * SKV + PAST + (rs & 31)) * 256; }
#pragma unroll
                    for (int bj = 0; bj < 2; ++bj)
#pragma unroll
                        for (int n = 0; n < 2; ++n) {
                            const int col = bj * HALF + wc * 32 + n * 16 + 4 * fq;
                            const f32x4 o = acc[ai][bj][m][n] * rk * *(const f32x4*)(kvg + col);
                            *(f32x4*)(of + col) = o; *(u32x2*)(ob + col) = (u32x2){cvt_pk_bf16(o[0], o[1]), cvt_pk_bf16(o[2], o[3])};
                        }
                }
            asm volatile("s_waitcnt lgkmcnt(0)" ::: "memory"); __builtin_amdgcn_s_barrier(); asm volatile("" ::: "memory");
            return;
        }
#pragma unroll
        for (int ai = 0; ai < 2; ++ai)
#pragma unroll
            for (int m = 0; m < 4; ++m) {
                const int row = u.pm * BM + ai * HALF + wr * 64 + m * 16 + fr;
                const float r = __builtin_amdgcn_rsqf(ssq1[row] * (1.0f / 1024.0f) + EPS);
                if (pn == 1 || pn == 2) {
                    float sq = 0.f;
#pragma unroll
                    for (int bj = 0; bj < 2; ++bj) {
                        if (pn == 2 && bj == 1) {
                            if (wc == 0) {
                                const int pos = row < TP ? row : PAST + ((row - TP) & 31);
                                f32x4 v0 = acc[ai][1][m][0] * r, v1 = acc[ai][1][m][1] * r;
#pragma unroll
                                for (int i = 0; i < 4; ++i) { float c, s; rope_cs(pos, 4 * fq + i, c, s); const float a = v0[i], b = v1[i]; v0[i] = a * c - b * s; v1[i] = b * c + a * s; }
                                float* of; bf16_t* ob;
                                if (row < TP) { of = out + O_KPEP + (size_t)row * 32; ob = KPEP + (size_t)row * 32; }
                                else { const int rs = row - TP; of = out + O_KPES + (size_t)rs * 32; ob = KPES + (size_t)((rs >> 5) * SKV + PAST + (rs & 31)) * 32; }
                                *(f32x4*)(of + 4 * fq) = v0; *(f32x4*)(of + 16 + 4 * fq) = v1;
                                *(u32x2*)(ob + 4 * fq) = (u32x2){cvt_pk_bf16(v0[0], v0[1]), cvt_pk_bf16(v0[2], v0[3])};
                                *(u32x2*)(ob + 16 + 4 * fq) = (u32x2){cvt_pk_bf16(v1[0], v1[1]), cvt_pk_bf16(v1[2], v1[3])};
                            }
                        } else {
#pragma unroll
                            for (int n = 0; n < 2; ++n) {
                                const int col = (pn - 1) * 256 + bj * HALF + wc * 32 + n * 16 + 4 * fq;
                                const f32x4 v = acc[ai][bj][m][n] * r;
                                *(u32x2*)(CQ + (size_t)row * QL + col) = (u32x2){cvt_pk_bf16(v[0], v[1]), cvt_pk_bf16(v[2], v[3])};
                                sq += (v[0] * v[0] + v[1] * v[1]) + (v[2] * v[2] + v[3] * v[3]);
                            }
                        }
                    }
                    sq += __shfl_xor(sq, 16); sq += __shfl_xor(sq, 32); if (fq == 0) atomic_addf(ssqq + row, sq);
                } else if (pn <= 4) {
                    float* cs = nullptr;
                    if (row < TP) { if (row >= TP - 3) cs = out + O_CONVP + (size_t)(row - (TP - 3)) * 512; }
                    else { const int rs = row - TP, t = rs & 31; if (t >= 29) cs = out + O_CONVS + (size_t)((rs >> 5) * 3 + (t - 29)) * 512; }
#pragma unroll
                    for (int bj = 0; bj < 2; ++bj)
#pragma unroll
                        for (int n = 0; n < 2; ++n) {
                            const int col = (pn - 3) * 256 + bj * HALF + wc * 32 + n * 16 + 4 * fq;
                            const f32x4 v = acc[ai][bj][m][n] * r;
                            *(u32x2*)(XBR + (size_t)row * 512 + col) = (u32x2){cvt_pk_bf16(v[0], v[1]), cvt_pk_bf16(v[2], v[3])};
                            if (cs) *(f32x4*)(cs + col) = v;
                        }
                } else {
#pragma unroll
                    for (int bj = 0; bj < 2; ++bj)
#pragma unroll
                        for (int n = 0; n < 2; ++n) {
                            const int col = (pn - 5) * 256 + bj * HALF + wc * 32 + n * 16 + 4 * fq;
                            const f32x4 v = acc[ai][bj][m][n] * r;
                            *(u32x2*)(GG + (size_t)row * 512 + col) = (u32x2){cvt_pk_bf16(gelu_tanh(v[0]), gelu_tanh(v[1])), cvt_pk_bf16(gelu_tanh(v[2]), gelu_tanh(v[3]))};
                        }
                }
            }
    }
};

template <class Epi, class Sched, bool ALIGN_EPI = false, bool SP2 = false>
__device__ __forceinline__ void gemm_phase(PG8_LAS unsigned char* lds, const Gemm g, const Sched& S, const Epi& E) {
    const int tid = threadIdx.x, wid = __builtin_amdgcn_readfirstlane(tid >> 6), lane = tid & 63, wr = wid >> 2, wc = wid & 3, fr = lane & 15, fq = lane >> 4;
    const int K = g.K, nt = K / BK;
    unsigned voffA[2], voffB[2];
#pragma unroll
    for (int i = 0; i < 2; ++i) { int R, C; stage_rc(tid * 16 + i * 8192, R, C); const int Rb = Epi::PERM ? ((R & ~31) + perm32(R & 31)) : R;
        voffA[i] = (unsigned)(R * g.lda + C) * 2u; voffB[i] = (unsigned)(Rb * g.ldb + C) * 2u; }
    const size_t kstep = (size_t)(BK * 2);
    const size_t hstepA = (size_t)HALF * g.lda * 2, hstepB = (size_t)HALF * g.ldb * 2;
    const size_t tstepA = 2 * hstepA, tstepB = 2 * hstepB;
    const unsigned ldsw = (unsigned)wid * 1024u;
    const int aoff = lds_byte(wr * 64 + fr, fq * 8), boff = lds_byte(wc * 32 + fr, fq * 8);
#define PG8_SA(b, h) (((b) * 2 + (h)) * HTB)
#define PG8_SB(b, h) ((4 + (b) * 2 + (h)) * HTB)
#define PG8_STAGE(bufoff, gbase, voff) do { _Pragma("unroll") for (int _i = 0; _i < 2; ++_i) \
        __builtin_amdgcn_global_load_lds((const unsigned*)((const char*)(gbase) + (voff)[_i]), (PG8_LAS unsigned*)(lds + (bufoff) + ldsw + _i * 8192), 16, 0, 0); } while (0)
#define PG8_LDA(dst, b, h) do { _Pragma("unroll") for (int m = 0; m < 4; ++m) _Pragma("unroll") for (int k = 0; k < 2; ++k) dst[m][k] = *(const PG8_LAS bf16x8*)(lds + PG8_SA(b, h) + aoff + m * 2048 + k * 1024); } while (0)
#define PG8_LDB(dst, b, h) do { _Pragma("unroll") for (int n = 0; n < 2; ++n) _Pragma("unroll") for (int k = 0; k < 2; ++k) dst[n][k] = *(const PG8_LAS bf16x8*)(lds + PG8_SB(b, h) + boff + n * 2048 + k * 1024); } while (0)
#define PG8_MMA(ai, bj, At, Bt) do { __builtin_amdgcn_s_setprio(1); _Pragma("unroll") for (int m = 0; m < 4; ++m) _Pragma("unroll") for (int n = 0; n < 2; ++n) _Pragma("unroll") for (int k = 0; k < 2; ++k) \
        acc[ai][bj][m][n] = __builtin_amdgcn_mfma_f32_16x16x32_bf16(Bt[n][k], At[m][k], acc[ai][bj][m][n], 0, 0, 0); __builtin_amdgcn_s_setprio(0); } while (0)
#define PG8_WAIT_V(n) asm volatile("s_waitcnt vmcnt(" #n ")" ::: "memory")
#define PG8_WAIT_L(n) asm volatile("s_waitcnt lgkmcnt(" #n ")" ::: "memory")
#define PG8_BAR __builtin_amdgcn_s_barrier()
#define PG8_SCHED __builtin_amdgcn_sched_barrier(0)
    Unit cur, nxt; int ui = 0;
    if (!S.next(0, cur)) return;
    f32x4 acc[2][2][4][2];
#pragma unroll
    for (int a = 0; a < 2; ++a)
#pragma unroll
        for (int b = 0; b < 2; ++b)
#pragma unroll
            for (int m = 0; m < 4; ++m)
#pragma unroll
                for (int n = 0; n < 2; ++n) acc[a][b][m][n] = (f32x4){0.f, 0.f, 0.f, 0.f};
    bf16x8 At[4][2], B0[2][2], B1[2][2];
    const char* cA = (const char*)g.A + (size_t)cur.pm * tstepA + (size_t)cur.kc * g.kcb; const char* cB = (const char*)g.Bt + (size_t)cur.pn * tstepB + (size_t)cur.kc * g.kcb;
    S.a_ready(cur);
    if constexpr (SP2) {
        PG8_STAGE(PG8_SB(0, 0), cB, voffB); PG8_STAGE(PG8_SB(0, 1), cB + hstepB, voffB); PG8_STAGE(PG8_SA(0, 0), cA, voffA); PG8_STAGE(PG8_SA(0, 1), cA + hstepA, voffA);
        if (wr == 1) PG8_BAR;
        PG8_WAIT_V(2); PG8_BAR;
        PG8_STAGE(PG8_SB(1, 0), cB + kstep, voffB); PG8_STAGE(PG8_SA(1, 0), cA + kstep, voffA); PG8_STAGE(PG8_SB(1, 1), cB + hstepB + kstep, voffB);
        PG8_WAIT_V(6); PG8_BAR;
    } else {
        PG8_STAGE(PG8_SB(0, 0), cB, voffB); PG8_STAGE(PG8_SA(0, 0), cA, voffA); PG8_STAGE(PG8_SB(0, 1), cB + hstepB, voffB); PG8_STAGE(PG8_SA(0, 1), cA + hstepA, voffA);
        if (wr == 1) PG8_BAR;
        PG8_WAIT_V(4); PG8_BAR;
        PG8_STAGE(PG8_SB(1, 0), cB + kstep, voffB); PG8_STAGE(PG8_SA(1, 0), cA + kstep, voffA); PG8_STAGE(PG8_SB(1, 1), cB + hstepB + kstep, voffB);
        PG8_WAIT_V(6); PG8_BAR;
    }
    for (;;) {
        const bool has_next = S.next(ui + 1, nxt);
        float epre[8];
        if constexpr (Epi::PREFETCH) E.prefetch(epre, cur, wr, fr);
        const char* nA = has_next ? (const char*)g.A + (size_t)nxt.pm * tstepA + (size_t)nxt.kc * g.kcb : cA; const char* nB = has_next ? (const char*)g.Bt + (size_t)nxt.pn * tstepB + (size_t)nxt.kc * g.kcb : cB;
_Pragma("unroll 1")
        for (int t = 0; t < nt; t += 2) {
            if constexpr (Epi::MIDSCALE) { if (t == nt / 2) E.midscale(acc, cur, wr, fr); }
            const bool last = (t == nt - 2);
            const char* a1 = cA + (size_t)(t + 1) * kstep;
            const char* a2 = last ? nA : cA + (size_t)(t + 2) * kstep; const char* b2 = last ? nB : cB + (size_t)(t + 2) * kstep;
            const char* a3 = a2 + kstep; const char* b3 = b2 + kstep;
            if (last && has_next) S.a_ready(nxt);
            if constexpr (SP2) {
            PG8_LDB(B0, 0, 0); PG8_LDB(B1, 0, 1); PG8_SCHED; PG8_LDA(At, 0, 0); PG8_STAGE(PG8_SA(1, 1), a1 + hstepA, voffA);
            PG8_WAIT_V(8); PG8_WAIT_L(0); PG8_BAR; PG8_MMA(0, 0, At, B0); PG8_MMA(0, 1, At, B1); PG8_BAR; PG8_SCHED;
            PG8_LDA(At, 0, 1); PG8_STAGE(PG8_SB(0, 0), b2, voffB); PG8_STAGE(PG8_SB(0, 1), b2 + hstepB, voffB); PG8_STAGE(PG8_SA(0, 0), a2, voffA);
            PG8_WAIT_V(8); PG8_WAIT_L(0); PG8_BAR; PG8_MMA(1, 0, At, B0); PG8_MMA(1, 1, At, B1); PG8_BAR; PG8_SCHED;
            PG8_LDB(B0, 1, 0); PG8_LDB(B1, 1, 1); PG8_SCHED; PG8_LDA(At, 1, 0); PG8_STAGE(PG8_SA(0, 1), a2 + hstepA, voffA);
            PG8_WAIT_V(8); PG8_WAIT_L(0); PG8_BAR; PG8_MMA(0, 0, At, B0); PG8_MMA(0, 1, At, B1); PG8_BAR; PG8_SCHED;
            PG8_LDA(At, 1, 1); PG8_STAGE(PG8_SB(1, 0), b3, voffB); PG8_STAGE(PG8_SB(1, 1), b3 + hstepB, voffB); PG8_STAGE(PG8_SA(1, 0), a3, voffA);
            PG8_WAIT_V(8); PG8_WAIT_L(0); PG8_BAR; PG8_MMA(1, 0, At, B0); PG8_MMA(1, 1, At, B1); PG8_BAR; PG8_SCHED;
            } else {
            PG8_LDB(B0, 0, 0); PG8_SCHED; PG8_LDA(At, 0, 0); PG8_STAGE(PG8_SA(1, 1), a1 + hstepA, voffA);
            PG8_WAIT_L(8); PG8_BAR; PG8_WAIT_L(0); PG8_MMA(0, 0, At, B0); PG8_BAR; PG8_SCHED;
            PG8_LDB(B1, 0, 1); PG8_STAGE(PG8_SB(0, 0), b2, voffB);
            PG8_BAR; PG8_WAIT_L(0); PG8_MMA(0, 1, At, B1); PG8_BAR;
            PG8_LDA(At, 0, 1); PG8_STAGE(PG8_SA(0, 0), a2, voffA);
            PG8_BAR; PG8_WAIT_L(0); PG8_MMA(1, 0, At, B0); PG8_BAR; PG8_SCHED;
            PG8_STAGE(PG8_SB(0, 1), b2 + hstepB, voffB);
            PG8_WAIT_V(6); PG8_BAR; PG8_MMA(1, 1, At, B1); PG8_BAR;
            PG8_LDB(B0, 1, 0); PG8_SCHED; PG8_LDA(At, 1, 0); PG8_STAGE(PG8_SA(0, 1), a2 + hstepA, voffA);
            PG8_WAIT_L(8); PG8_BAR; PG8_WAIT_L(0); PG8_MMA(0, 0, At, B0); PG8_BAR; PG8_SCHED;
            PG8_LDB(B1, 1, 1); PG8_STAGE(PG8_SB(1, 0), b3, voffB);
            PG8_BAR; PG8_WAIT_L(0); PG8_MMA(0, 1, At, B1); PG8_BAR;
            PG8_LDA(At, 1, 1); PG8_STAGE(PG8_SA(1, 0), a3, voffA);
            PG8_BAR; PG8_WAIT_L(0); PG8_MMA(1, 0, At, B0); PG8_BAR; PG8_SCHED;
            PG8_STAGE(PG8_SB(1, 1), b3 + hstepB, voffB);
            PG8_WAIT_V(6); PG8_BAR; PG8_MMA(1, 1, At, B1); PG8_BAR;
            }
        }
        if constexpr (ALIGN_EPI) { if (wr == 0) PG8_BAR; }
        if constexpr (!Epi::AFTER_DRAIN) { if constexpr (Epi::PREFETCH) E(acc, cur, wr, wc, fr, fq, epre); else E(acc, cur, wr, wc, fr, fq); S.done(cur); }
        if (!has_next) break;
#pragma unroll
        for (int a = 0; a < 2; ++a)
#pragma unroll
            for (int b = 0; b < 2; ++b)
#pragma unroll
                for (int m = 0; m < 4; ++m)
#pragma unroll
                    for (int n = 0; n < 2; ++n) acc[a][b][m][n] = (f32x4){0.f, 0.f, 0.f, 0.f};
        cur = nxt; cA = nA; cB = nB; ++ui;
        if constexpr (ALIGN_EPI) { if (wr == 1) PG8_BAR; }
    }
    PG8_WAIT_V(0);
    if constexpr (!ALIGN_EPI) { if (wr == 0) PG8_BAR; }
    PG8_BAR;
    if constexpr (Epi::AFTER_DRAIN) { E.fused(acc, cur, wr, wc, fr, fq, lds, wid, lane); S.done(cur); }
#undef PG8_SA
#undef PG8_SB
#undef PG8_STAGE
#undef PG8_LDA
#undef PG8_LDB
#undef PG8_MMA
#undef PG8_WAIT_V
#undef PG8_WAIT_L
#undef PG8_BAR
#undef PG8_SCHED
}
}

#define MFMA32(a, b, c) __builtin_amdgcn_mfma_f32_32x32x16_bf16((a), (b), (c), 0, 0, 0)
__device__ __forceinline__ bf16x8 pack8(const f32x16& p, int b) {
    u32x4 w = (u32x4){pk2(p[b], p[b + 1]), pk2(p[b + 2], p[b + 3]), pk2(p[b + 4], p[b + 5]), pk2(p[b + 6], p[b + 7])};
    return __builtin_bit_cast(bf16x8, w);
}
__device__ __forceinline__ float max3f_(float a, float b, float c) { float r; asm("v_max3_f32 %0, %1, %2, %3" : "=v"(r) : "v"(a), "v"(b), "v"(c)); return r; }
__device__ __forceinline__ float max16(const f32x16& p) {
    float a = max3f_(p[0], p[1], p[2]), b = max3f_(p[3], p[4], p[5]);
    a = max3f_(a, p[6], p[7]); b = max3f_(b, p[8], p[9]); a = max3f_(a, p[10], p[11]); b = max3f_(b, p[12], p[13]);
    return max3f_(a, b, max3f_(p[14], p[15], p[15]));
}
__device__ __forceinline__ bf16x8 cat44(s16x4 a, s16x4 b) { return (bf16x8){a[0], a[1], a[2], a[3], b[0], b[1], b[2], b[3]}; }

struct MlaState { f32x16 o0, o1, negm; float l; };
typedef float f32x2p __attribute__((ext_vector_type(2)));
__device__ __forceinline__ void mla_softmax_pv_prep(MlaState& st, f32x16& p0, f32x16& p1, bf16x8 (&pb)[4], bool first) {
    float mx = fmaxf(max16(p0), max16(p1));
    { auto rr = __builtin_amdgcn_permlane32_swap(__builtin_bit_cast(unsigned, mx), __builtin_bit_cast(unsigned, mx), false, false);
      mx = fmaxf(__builtin_bit_cast(float, rr[0]), __builtin_bit_cast(float, rr[1])); }
    if (first || __any(mx > 8.0f)) {
        const float d = first ? mx : (mx > 8.0f ? mx : 0.f);
#pragma unroll
        for (int r = 0; r < 16; ++r) { p0[r] -= d; p1[r] -= d; st.negm[r] -= d; }
        if (!first) { const float f = __builtin_amdgcn_exp2f(-d); st.l *= f;
#pragma unroll
            for (int r = 0; r < 16; ++r) { st.o0[r] *= f; st.o1[r] *= f; } }
    }
    f32x2p ps = (f32x2p){0.f, 0.f};
#pragma unroll
    for (int r = 0; r < 16; r += 2) {
        p0[r] = __builtin_amdgcn_exp2f(p0[r]); p0[r + 1] = __builtin_amdgcn_exp2f(p0[r + 1]); p1[r] = __builtin_amdgcn_exp2f(p1[r]); p1[r + 1] = __builtin_amdgcn_exp2f(p1[r + 1]);
        ps += (f32x2p){p0[r], p0[r + 1]}; ps += (f32x2p){p1[r], p1[r + 1]};
    }
    st.l += ps[0] + ps[1];
    pb[0] = pack8(p0, 0); pb[1] = pack8(p0, 8); pb[2] = pack8(p1, 0); pb[3] = pack8(p1, 8);
}

constexpr int MLA_KROW = 208, MLA_VROW = 144, MLA_KT = 64 * MLA_KROW  , MLA_STAGE = MLA_KT + 64 * MLA_VROW  ;

__device__ __forceinline__ void mla_prompt_unit(LAS unsigned char* lds, int h, int qb, const bf16_t* __restrict__ Q, const bf16_t* __restrict__ KN, const bf16_t* __restrict__ KPE,
                                                const bf16_t* __restrict__ VT, bf16_t* MERGED, float* ssqa) {
    const int tid = threadIdx.x, lane = tid & 63, w = __builtin_amdgcn_readfirstlane(tid >> 6), r32 = lane & 31, hi = lane >> 5;
    const int q0 = qb * 256 + w * 32;
    bf16x8 qf[6];
    { const bf16_t* qp = Q + (size_t)(q0 + r32) * 768 + h * 96 + hi * 8;
#pragma unroll
      for (int s = 0; s < 6; ++s) qf[s] = *(const bf16x8*)(qp + 16 * s); }
    const int NT = 4 * qb + 4, mylast = 4 * qb + (w >> 1);
    MlaState st; st.l = 0.f;
#pragma unroll
    for (int r = 0; r < 16; ++r) { st.o0[r] = 0.f; st.o1[r] = 0.f; st.negm[r] = 0.f; }
    const int krow = tid >> 3, kch = tid & 7, prow = (tid & 255) >> 2, pch = tid & 3, vd = tid >> 3, vch = tid & 7;
    const bf16_t* ksrc = KN + (size_t)krow * 512 + h * 64 + kch * 8;
    const bf16_t* psrc = KPE + (size_t)prow * 32 + pch * 8;
    const bf16_t* vsrc = VT + (size_t)(h * 64 + vd) * VT_LD + vch * 8;
    const int kdst = krow * MLA_KROW + kch * 16, pdst = prow * MLA_KROW + 128 + pch * 16, vdst = MLA_KT + vd * MLA_VROW + (vch >> 1) * 32 + (vch & 1) * 8;
    u32x4 rk, rp, rv; rp = (u32x4){0, 0, 0, 0};
#define MLA_GLOAD(t) do { rk = *(const u32x4*)(ksrc + (size_t)(t) * 64 * 512); if (tid < 256) rp = *(const u32x4*)(psrc + (size_t)(t) * 64 * 32); rv = *(const u32x4*)(vsrc + (size_t)(t) * 64); } while (0)
#define MLA_LSTORE(b) do { LAS unsigned char* sb_ = lds + (b) * MLA_STAGE; *(LAS u32x4*)(sb_ + kdst) = rk; if (tid < 256) *(LAS u32x4*)(sb_ + pdst) = rp; \
        *(LAS u32x2*)(sb_ + vdst) = (u32x2){rv[0], rv[1]}; *(LAS u32x2*)(sb_ + vdst + 16) = (u32x2){rv[2], rv[3]}; } while (0)
    MLA_GLOAD(0); MLA_LSTORE(0); __syncthreads();
    for (int t = 0; t < NT; ++t) {
        const bool more = (t + 1 < NT);
        if (more) MLA_GLOAD(t + 1);
        if (t <= mylast) {
            const LAS unsigned char* sb = lds + (t & 1) * MLA_STAGE;
            const LAS unsigned char* kb = sb + r32 * MLA_KROW + hi * 16;
            bf16x8 ka[6], kc[6];
#pragma unroll
            for (int s = 0; s < 6; ++s) { ka[s] = *(const LAS bf16x8*)(kb + s * 32); kc[s] = *(const LAS bf16x8*)(kb + 32 * MLA_KROW + s * 32); }
            __builtin_amdgcn_sched_barrier(0);
            f32x16 p0 = st.negm, p1 = st.negm;
#pragma unroll
            for (int s = 0; s < 6; ++s) { p0 = MFMA32(ka[s], qf[s], p0); p1 = MFMA32(kc[s], qf[s], p1); }
            __builtin_amdgcn_sched_barrier(0);
            const LAS unsigned char* vb = sb + MLA_KT + r32 * MLA_VROW + hi * 16;
            bf16x8 va[4], vc[4];
#pragma unroll
            for (int s = 0; s < 4; ++s) {
                va[s] = *(const LAS bf16x8*)(vb + s * 32); vc[s] = *(const LAS bf16x8*)(vb + 32 * MLA_VROW + s * 32);
            }
            __builtin_amdgcn_sched_barrier(0);
            bf16x8 pb[4];
            mla_softmax_pv_prep(st, p0, p1, pb, t == 0);
#pragma unroll
            for (int s = 0; s < 4; ++s) { st.o0 = MFMA32(va[s], pb[s], st.o0); st.o1 = MFMA32(vc[s], pb[s], st.o1); }
        }
        if (more) MLA_LSTORE((t + 1) & 1);
        __syncthreads();
    }
#undef MLA_GLOAD
#undef MLA_LSTORE
    const float l = st.l + __shfl_xor(st.l, 32); const float inv = 1.f / l;
    const int row = q0 + r32; bf16_t* op = MERGED + (size_t)row * DM + h * 64 + 4 * hi; float sq = 0.f;
#pragma unroll
    for (int g = 0; g < 4; ++g) {
        const float a0 = st.o0[4 * g] * inv, a1 = st.o0[4 * g + 1] * inv, a2 = st.o0[4 * g + 2] * inv, a3 = st.o0[4 * g + 3] * inv;
        const float b0 = st.o1[4 * g] * inv, b1 = st.o1[4 * g + 1] * inv, b2 = st.o1[4 * g + 2] * inv, b3 = st.o1[4 * g + 3] * inv;
        *(u32x2*)(op + 8 * g) = (u32x2){pk2(a0, a1), pk2(a2, a3)}; *(u32x2*)(op + 32 + 8 * g) = (u32x2){pk2(b0, b1), pk2(b2, b3)};
        sq += (a0 * a0 + a1 * a1) + (a2 * a2 + a3 * a3) + (b0 * b0 + b1 * b1) + (b2 * b2 + b3 * b3);
    }
    sq += __shfl_xor(sq, 32); if (hi == 0) atomic_addf(ssqa + row, sq);
}

__device__ __forceinline__ void mla_sample_unit(LAS unsigned char* lds, int b, int h, const bf16_t* __restrict__ Q, const bf16_t* __restrict__ KN, const bf16_t* __restrict__ KPE,
                                                const bf16_t* __restrict__ VT, bf16_t* MERGED, float* ssqa) {
    const int tid = threadIdx.x, lane = tid & 63, w = __builtin_amdgcn_readfirstlane(tid >> 6), r32 = lane & 31, hi = lane >> 5;
    const int row = TP + b * 32 + r32;
    bf16x8 qf[6];
    { const bf16_t* qp = Q + (size_t)row * 768 + h * 96 + hi * 8;
#pragma unroll
      for (int s = 0; s < 6; ++s) qf[s] = *(const bf16x8*)(qp + 16 * s); }
    MlaState st; st.l = 0.f;
#pragma unroll
    for (int r = 0; r < 16; ++r) { st.o0[r] = 0.f; st.o1[r] = 0.f; st.negm[r] = 0.f; }
    bf16x8 ka[6], kc[6]; s16x4 va[8], vc[8];
#define MLS_LOAD(t_, KA, KC, VA, VC) do { const size_t kv0_ = (size_t)b * SKV + (t_) * 64; \
        const bf16_t* kp_ = KN + (kv0_ + r32) * 512 + h * 64 + hi * 8; const bf16_t* pp_ = KPE + (kv0_ + r32) * 32 + hi * 8; \
        _Pragma("unroll") for (int s_ = 0; s_ < 4; ++s_) { KA[s_] = *(const bf16x8*)(kp_ + 16 * s_); KC[s_] = *(const bf16x8*)(kp_ + 32 * 512 + 16 * s_); } \
        _Pragma("unroll") for (int s_ = 0; s_ < 2; ++s_) { KA[4 + s_] = *(const bf16x8*)(pp_ + 16 * s_); KC[4 + s_] = *(const bf16x8*)(pp_ + 32 * 32 + 16 * s_); } \
        const bf16_t* vp_ = VT + (size_t)(h * 64 + r32) * VTS_LD + kv0_ + 4 * hi; \
        _Pragma("unroll") for (int s_ = 0; s_ < 4; ++s_) { VA[2 * s_] = *(const s16x4*)(vp_ + 16 * s_); VA[2 * s_ + 1] = *(const s16x4*)(vp_ + 16 * s_ + 8); \
            VC[2 * s_] = *(const s16x4*)(vp_ + (size_t)32 * VTS_LD + 16 * s_); VC[2 * s_ + 1] = *(const s16x4*)(vp_ + (size_t)32 * VTS_LD + 16 * s_ + 8); } } while (0)
    for (int t = w; t < 33; t += 8) {
        MLS_LOAD(t, ka, kc, va, vc);
        __builtin_amdgcn_sched_barrier(0);
        f32x16 p0 = st.negm, p1 = st.negm;
        const bool tail = (t == 32);
#pragma unroll
        for (int s = 0; s < 6; ++s) { p0 = MFMA32(ka[s], qf[s], p0); if (!tail) p1 = MFMA32(kc[s], qf[s], p1); }
        if (tail) {
#pragma unroll
            for (int r = 0; r < 16; ++r) p1[r] = -1e30f;
        }
        bf16x8 pb[4];
        mla_softmax_pv_prep(st, p0, p1, pb, t == w);
#pragma unroll
        for (int s = 0; s < 4; ++s) {
            if (tail && s >= 2) break;
            st.o0 = MFMA32(cat44(va[2 * s], va[2 * s + 1]), pb[s], st.o0); st.o1 = MFMA32(cat44(vc[2 * s], vc[2 * s + 1]), pb[s], st.o1);
        }
    }
#undef MLS_LOAD
    LAS float* Lm = (LAS float*)lds; LAS float* Ll = Lm + 512; LAS float* LO = Lm + 1024;
    const float mref = -st.negm[0];
    Lm[w * 64 + lane] = mref;
    __syncthreads();
    float M = Lm[lane];
#pragma unroll
    for (int k = 1; k < 8; ++k) M = fmaxf(M, Lm[k * 64 + lane]);
    const float f = __builtin_amdgcn_exp2f(mref - M);
    Ll[w * 64 + lane] = st.l * f;
#pragma unroll
    for (int r = 0; r < 16; ++r) { LO[(w * 32 + r) * 64 + lane] = st.o0[r] * f; LO[(w * 32 + 16 + r) * 64 + lane] = st.o1[r] * f; }
    __syncthreads();
    float l = 0.f;
#pragma unroll
    for (int k = 0; k < 8; ++k) l += Ll[k * 64 + lane] + Ll[k * 64 + (lane ^ 32)];
    const float inv = 1.f / l;
    float v[4];
#pragma unroll
    for (int i = 0; i < 4; ++i) { float s = 0.f;
#pragma unroll
        for (int k = 0; k < 8; ++k) s += LO[(k * 32 + 4 * w + i) * 64 + lane];
        v[i] = s * inv; }
    *(u32x2*)(MERGED + (size_t)row * DM + h * 64 + 32 * (w >> 2) + 8 * (w & 3) + 4 * hi) = (u32x2){pk2(v[0], v[1]), pk2(v[2], v[3])};
    float sq = (v[0] * v[0] + v[1] * v[1]) + (v[2] * v[2] + v[3] * v[3]);
    sq += __shfl_xor(sq, 32); if (hi == 0) atomic_addf(ssqa + row, sq);
    __syncthreads();
}

template <class QF, class KF, class VF, class MID>
__device__ __forceinline__ void xattn_wave(QF qfrag, bf16_t* orow  , KF kfrag, VF vfrag, MID mid) {
    bf16x8 pb[16];
    float inv;
    {
        f32x16 S[4][2];
#pragma unroll
        for (int kt = 0; kt < 4; ++kt)
#pragma unroll
            for (int r = 0; r < 16; ++r) { S[kt][0][r] = 0.f; S[kt][1][r] = 0.f; }
#pragma unroll
        for (int s = 0; s < 16; ++s) {
            const bf16x8 qf = qfrag(s);
#pragma unroll
            for (int kt = 0; kt < 4; ++kt) { S[kt][0] = MFMA32(kfrag(kt, 0, s), qf, S[kt][0]); S[kt][1] = MFMA32(kfrag(kt, 1, s), qf, S[kt][1]); }
        }
        float mx = -1e30f;
#pragma unroll
        for (int kt = 0; kt < 4; ++kt) mx = fmaxf(mx, fmaxf(max16(S[kt][0]), max16(S[kt][1])));
        mx = fmaxf(mx, __shfl_xor(mx, 32));
        float l = 0.f;
#pragma unroll
        for (int kt = 0; kt < 4; ++kt) {
#pragma unroll
            for (int r = 0; r < 16; ++r) { S[kt][0][r] = __builtin_amdgcn_exp2f(S[kt][0][r] - mx); S[kt][1][r] = __builtin_amdgcn_exp2f(S[kt][1][r] - mx); l += S[kt][0][r] + S[kt][1][r]; }
            pb[4 * kt] = pack8(S[kt][0], 0); pb[4 * kt + 1] = pack8(S[kt][0], 8); pb[4 * kt + 2] = pack8(S[kt][1], 0); pb[4 * kt + 3] = pack8(S[kt][1], 8);
        }
        l += __shfl_xor(l, 32); inv = 1.f / l;
    }
    mid();
#pragma unroll 1
    for (int db = 0; db < 8; ++db) {
        f32x16 o;
#pragma unroll
        for (int r = 0; r < 16; ++r) o[r] = 0.f;
        bf16x8 vf[16];
#pragma unroll
        for (int s = 0; s < 16; ++s) vf[s] = vfrag(db, s);
        __builtin_amdgcn_sched_barrier(0);
#pragma unroll
        for (int s = 0; s < 16; ++s) o = MFMA32(vf[s], pb[s], o);
#pragma unroll
        for (int g = 0; g < 4; ++g)
            *(u32x2*)(orow + 32 * db + 8 * g) = (u32x2){pk2(o[4 * g] * inv, o[4 * g + 1] * inv), pk2(o[4 * g + 2] * inv, o[4 * g + 3] * inv)};
    }
}

constexpr int XA_KROW = 528, XA_VROW = 528;
__device__ __forceinline__ void xattn_unit(LAS unsigned char* lds, int rowbase, bool single, int h, bf16_t* QM, const bf16_t* __restrict__ MKB, const bf16_t* __restrict__ MVTB, const float* __restrict__ QACC, const float* __restrict__ ssq2) {
    const int tid = threadIdx.x, lane = tid & 63, w = __builtin_amdgcn_readfirstlane(tid >> 6), r32 = lane & 31, hi = lane >> 5;
#pragma unroll 4
    for (int it = 0; it < 16; ++it) { const int idx = it * 512 + tid, rw = idx >> 5, ch = idx & 31;
        *(LAS u32x4*)(lds + rw * XA_KROW + ch * 16) = *(const u32x4*)(MKB + (size_t)rw * DM + h * 256 + ch * 8); }
    __syncthreads();
    const int row = rowbase + (single ? 0 : w * 32) + r32;
    const LAS unsigned char* kb = lds + r32 * XA_KROW + hi * 16;
    const LAS unsigned char* vb = lds + r32 * XA_VROW + hi * 16;
    auto kfrag = [&](int kt, int half, int s) -> bf16x8 { return *(const LAS bf16x8*)(kb + (kt * 64 + half * 32) * XA_KROW + s * 32); };
    auto vfrag = [&](int db, int s) -> bf16x8 { return *(const LAS bf16x8*)(vb + db * 32 * XA_VROW + s * 32); };
    auto mid = [&]() {
        __syncthreads();
#pragma unroll 4
        for (int it = 0; it < 16; ++it) { const int idx = it * 512 + tid, d = idx >> 5, ch = idx & 31;
            const u32x4 v = *(const u32x4*)(MVTB + (size_t)(h * 256 + d) * 256 + ch * 8);
            LAS unsigned char* dp = lds + d * XA_VROW + (ch >> 1) * 32 + (ch & 1) * 8;
            *(LAS u32x2*)dp = (u32x2){v[0], v[1]}; *(LAS u32x2*)(dp + 16) = (u32x2){v[2], v[3]}; }
        __syncthreads();
    };
    if (!single) {
        const bf16_t* qrow = QM + (size_t)row * DM + h * 256 + hi * 8;
        auto qfrag = [&](int s) -> bf16x8 { return *(const bf16x8*)(qrow + 16 * s); };
        xattn_wave(qfrag, QM + (size_t)row * DM + h * 256 + 4 * hi, kfrag, vfrag, mid);
    } else if (w == 0) {
        const float* qrow = QACC + (size_t)(row - TP) * DM + h * 256 + hi * 8; const float sc = XSCALE * __builtin_amdgcn_rsqf(ssq2[row] * (1.0f / 1024.0f) + EPS);
        auto qfrag = [&](int s) -> bf16x8 { const f32x4 a = *(const f32x4*)(qrow + 16 * s) * sc, b = *(const f32x4*)(qrow + 16 * s + 4) * sc;
            return __builtin_bit_cast(bf16x8, (u32x4){pk2(a[0], a[1]), pk2(a[2], a[3]), pk2(b[0], b[1]), pk2(b[2], b[3])}); };
        xattn_wave(qfrag, QM + (size_t)row * DM + h * 256 + 4 * hi, kfrag, vfrag, mid);
    } else mid();
    __syncthreads();
}
struct LruArgs { const bf16_t* XBR; const float* conv_w; const float* conv_b; const float* wa; const float* ba; const float* wx; const float* bx; const float* lam;
                 const float* state_conv; const float* state_lru; bf16_t* HLOC; bf16_t* ACUM; float* ATOT; float* BTOT; float* out; };
__device__ __forceinline__ void lru_l1_unit(LAS unsigned char* lds, int unit, const LruArgs& A) {
    const int c = threadIdx.x, g = __builtin_amdgcn_readfirstlane(c >> 6), j = c & 63, r32 = j & 31, hi = j >> 5;
    const bool samp = unit >= 256; const int b = unit - 256;
    const int row0 = samp ? TP + b * 32 : unit * 64; const int nt = samp ? 32 : 64;
    constexpr int XROW = 1040;
    LAS unsigned char* XCB = lds;
    LAS unsigned* PRE = (LAS unsigned*)(lds + 64 * XROW);
    const float w0 = A.conv_w[c], w1 = A.conv_w[512 + c], w2 = A.conv_w[1024 + c], w3 = A.conv_w[1536 + c], cb = A.conv_b[c];
    float xm3, xm2, xm1;
    if (samp) { xm3 = A.state_conv[(b * 3 + 0) * 512 + c]; xm2 = A.state_conv[(b * 3 + 1) * 512 + c]; xm1 = A.state_conv[(b * 3 + 2) * 512 + c]; }
    else if (unit > 0) { xm3 = bf2f(A.XBR[(size_t)(row0 - 3) * 512 + c]); xm2 = bf2f(A.XBR[(size_t)(row0 - 2) * 512 + c]); xm1 = bf2f(A.XBR[(size_t)(row0 - 1) * 512 + c]); }
    else { xm3 = 0.f; xm2 = 0.f; xm1 = 0.f; }
    {
        unsigned short xraw[64];
#pragma unroll
        for (int t = 0; t < 64; ++t) xraw[t] = (t < nt) ? A.XBR[(size_t)(row0 + t) * 512 + c] : (unsigned short)0;
#pragma unroll
        for (int t = 0; t < 64; ++t) {
            if (t < nt) {
                const float x0 = bf2f(xraw[t]);
                *(LAS bf16_t*)(XCB + t * XROW + c * 2) = (bf16_t)f2bf(cb + w0 * xm3 + w1 * xm2 + w2 * xm1 + w3 * x0);
                xm3 = xm2; xm2 = xm1; xm1 = x0;
            }
        }
    }
    bf16x8 bw[4][4];
#pragma unroll
    for (int nb = 0; nb < 4; ++nb)
#pragma unroll
        for (int ks = 0; ks < 4; ++ks) {
            const float* W = ((nb < 2) ? A.wa : A.wx) + g * 4096 + (16 * ks) * 64 + (nb & 1) * 32;
            const float* Wl = W + (8 * hi) * 64 + r32;
            bw[nb][ks] = __builtin_bit_cast(bf16x8, (u32x4){pk2(Wl[0], Wl[64]), pk2(Wl[128], Wl[192]), pk2(Wl[256], Wl[320]), pk2(Wl[384], Wl[448])});
        }
    const float bav = A.ba[c], bxv = A.bx[c];
    const float lamv = A.lam[c]; const float sp = log1pf(__expf(-lamv));
    float h = samp ? A.state_lru[b * 512 + c] : 0.f, Ac = 1.f;
    asm volatile("s_waitcnt lgkmcnt(0)" ::: "memory");
    for (int mb = 0; mb < (nt >> 5); ++mb) {
        f32x16 C0, C1, C2, C3;
#pragma unroll
        for (int r = 0; r < 16; ++r) { C0[r] = 0.f; C1[r] = 0.f; C2[r] = 0.f; C3[r] = 0.f; }
#pragma unroll
        for (int ks = 0; ks < 4; ++ks) {
            const bf16x8 a = *(const LAS bf16x8*)(XCB + (32 * mb + r32) * XROW + (g * 64 + 16 * ks + 8 * hi) * 2);
            C0 = MFMA32(a, bw[0][ks], C0); C1 = MFMA32(a, bw[1][ks], C1); C2 = MFMA32(a, bw[2][ks], C2); C3 = MFMA32(a, bw[3][ks], C3);
        }
#pragma unroll
        for (int r = 0; r < 16; ++r) { const int tl = (r & 3) + 8 * (r >> 2) + 4 * hi;
            PRE[tl * 512 + g * 64 + r32] = f2bf(C0[r]) | (f2bf(C2[r]) << 16); PRE[tl * 512 + g * 64 + 32 + r32] = f2bf(C1[r]) | (f2bf(C3[r]) << 16); }
        asm volatile("s_waitcnt lgkmcnt(0)" ::: "memory");
#pragma unroll 4
        for (int tl = 0; tl < 32; ++tl) {
            const int t = 32 * mb + tl;
            const unsigned u = PRE[tl * 512 + c];
            const float ra = __builtin_bit_cast(float, u << 16) + bav, ri = __builtin_bit_cast(float, u & 0xffff0000u) + bxv;
            const float xcv = bf2f(*(const LAS bf16_t*)(XCB + t * XROW + c * 2));
            const float rg = __builtin_amdgcn_rcpf(1.f + __builtin_amdgcn_exp2f(-LOG2E * ra)), ig = __builtin_amdgcn_rcpf(1.f + __builtin_amdgcn_exp2f(-LOG2E * ri));
            const float a = __builtin_amdgcn_exp2f((-8.0f * LOG2E) * rg * sp);
            const float bt = __builtin_amdgcn_sqrtf(fmaxf(1.f - a * a, 0.f)) * ig * xcv;
            h = a * h + bt; Ac *= a;
            A.HLOC[(size_t)(row0 + t) * 512 + c] = (bf16_t)f2bf(h); A.ACUM[(size_t)(row0 + t) * 512 + c] = (bf16_t)f2bf(Ac);
        }
        asm volatile("s_waitcnt lgkmcnt(0)" ::: "memory");
    }
    A.ATOT[unit * 512 + c] = Ac; A.BTOT[unit * 512 + c] = h;
    if (samp) A.out[O_LRUS + b * 512 + c] = h;
    __syncthreads();
}
__device__ __forceinline__ void lru_l3_unit(LAS unsigned char* lds, int unit, const bf16_t* __restrict__ HLOC, const bf16_t* __restrict__ ACUM, const bf16_t* __restrict__ GG,
                                            const float* __restrict__ ATOT, const float* __restrict__ BTOT, const float* __restrict__ gain, bf16_t* MERGED, float* out) {
    const int c = threadIdx.x, lane = c & 63, w = __builtin_amdgcn_readfirstlane(c >> 6);
    const bool samp = unit >= 256; const int row0 = samp ? TP + (unit - 256) * 32 : unit * 64; const int nt = samp ? 32 : 64;
    LAS float* HIN = (LAS float*)lds;
    float H = 0.f;
    if (!samp) {
#pragma unroll 32
        for (int k = 0; k < unit; ++k) H = ATOT[k * 512 + c] * H + BTOT[k * 512 + c];
        if (unit == 255) out[O_LRUP + c] = ATOT[255 * 512 + c] * H + BTOT[255 * 512 + c];
    }
    HIN[c] = H;
    __syncthreads();
    float hin[8], gn[8];
#pragma unroll
    for (int k = 0; k < 8; ++k) { hin[k] = HIN[lane * 8 + k]; gn[k] = gain[lane * 8 + k]; }
    for (int t0 = w; t0 < nt; t0 += 32) {
        u32x4 hl[4], ac[4], gg[4];
#pragma unroll
        for (int q = 0; q < 4; ++q) { const size_t off = (size_t)(row0 + t0 + 8 * q) * 512 + lane * 8;
            hl[q] = *(const u32x4*)(HLOC + off); ac[q] = *(const u32x4*)(ACUM + off); gg[q] = *(const u32x4*)(GG + off); }
#pragma unroll
        for (int q = 0; q < 4; ++q) {
            float v[8]; float sq = 0.f;
#pragma unroll
            for (int k = 0; k < 4; ++k) {
                const float h0 = __builtin_bit_cast(float, hl[q][k] << 16) + __builtin_bit_cast(float, ac[q][k] << 16) * hin[2 * k];
                const float h1 = __builtin_bit_cast(float, hl[q][k] & 0xffff0000u) + __builtin_bit_cast(float, ac[q][k] & 0xffff0000u) * hin[2 * k + 1];
                v[2 * k] = __builtin_bit_cast(float, gg[q][k] << 16) * h0; v[2 * k + 1] = __builtin_bit_cast(float, gg[q][k] & 0xffff0000u) * h1;
                sq += v[2 * k] * v[2 * k] + v[2 * k + 1] * v[2 * k + 1];
            }
            const float rs = __builtin_amdgcn_rsqf(wave_sum(sq) * (1.0f / 512.0f) + EPS);
            *(u32x4*)(MERGED + (size_t)(row0 + t0 + 8 * q) * DM + 512 + lane * 8) =
                (u32x4){pk2(v[0] * rs * gn[0], v[1] * rs * gn[1]), pk2(v[2] * rs * gn[2], v[3] * rs * gn[3]), pk2(v[4] * rs * gn[4], v[5] * rs * gn[5]), pk2(v[6] * rs * gn[6], v[7] * rs * gn[7])};
        }
    }
    __syncthreads();
}

__device__ __forceinline__ void sample_finalize_part(int part, const float* __restrict__ xs_old, const float* __restrict__ ACC, float* xs_new, bf16_t* XBs, float* ssq_s, unsigned* flag) {
    const int lane = threadIdx.x & 63, w = __builtin_amdgcn_readfirstlane(threadIdx.x >> 6);
    const int r0 = part * 32 + w * 4;
    f32x4 v[4][4];
#pragma unroll
    for (int q = 0; q < 4; ++q)
#pragma unroll
        for (int j = 0; j < 4; ++j) v[q][j] = *((const f32x4*)(xs_old + (size_t)(r0 + q) * DM) + lane + 64 * j) + *((const f32x4*)(ACC + (size_t)(r0 + q) * DM) + lane + 64 * j);
#pragma unroll
    for (int q = 0; q < 4; ++q) {
        float s = 0.f;
#pragma unroll
        for (int j = 0; j < 4; ++j) s += (v[q][j][0] * v[q][j][0] + v[q][j][1] * v[q][j][1]) + (v[q][j][2] * v[q][j][2] + v[q][j][3] * v[q][j][3]);
        s = wave_sum(s); if (lane == 0) ssq_s[r0 + q] = s;
#pragma unroll
        for (int j = 0; j < 4; ++j) { *((f32x4*)(xs_new + (size_t)(r0 + q) * DM) + lane + 64 * j) = v[q][j]; *((u32x2*)(XBs + (size_t)(r0 + q) * DM) + lane + 64 * j) = (u32x2){pk2(v[q][j][0], v[q][j][1]), pk2(v[q][j][2], v[q][j][3])}; }
    }
    asm volatile("s_waitcnt vmcnt(0)" ::: "memory");
    __syncthreads();
    if (threadIdx.x == 0) { __builtin_amdgcn_fence(__ATOMIC_RELEASE, "agent"); asm volatile("s_waitcnt vmcnt(0)" ::: "memory"); __hip_atomic_fetch_add(flag, 1u, __ATOMIC_RELAXED, __HIP_MEMORY_SCOPE_AGENT); }
}
__device__ __forceinline__ void sample_wait(unsigned* flag, unsigned want) {
    if (threadIdx.x == 0) { while (__hip_atomic_load(flag, __ATOMIC_RELAXED, __HIP_MEMORY_SCOPE_AGENT) < want) __builtin_amdgcn_s_sleep(2);
        __builtin_amdgcn_fence(__ATOMIC_ACQUIRE, "agent"); asm volatile("s_waitcnt vmcnt(0)" ::: "memory"); }
    __syncthreads();
}

__device__ __forceinline__ void tr_item(const float* __restrict__ W, int N, int k0, int n0, bf16_t* WT, int drow0, int ldd, const float* gain, LAS float* scr, int lane) {
    float tv[32];
#pragma unroll
    for (int i = 0; i < 32; ++i) tv[i] = W[(size_t)(k0 + 2 * i + (lane >> 5)) * N + n0 + (lane & 31)];
#pragma unroll
    for (int i = 0; i < 32; ++i) { const int kk = 2 * i + (lane >> 5); float v = tv[i]; if (gain) v *= gain[k0 + kk]; scr[kk * 33 + (lane & 31)] = v; }
    asm volatile("s_waitcnt lgkmcnt(0)" ::: "memory");
    const int cc = lane & 7;
#pragma unroll
    for (int jj = 0; jj < 4; ++jj) { const int n = (lane >> 3) + 8 * jj; const LAS float* s = scr + (8 * cc) * 33 + n;
        u32x4 o; o.x = pk2(s[0 * 33], s[1 * 33]); o.y = pk2(s[2 * 33], s[3 * 33]); o.z = pk2(s[4 * 33], s[5 * 33]); o.w = pk2(s[6 * 33], s[7 * 33]);
        *(u32x4*)(WT + (size_t)(drow0 + n) * ldd + k0 + 8 * cc) = o; }
    asm volatile("s_waitcnt lgkmcnt(0)" ::: "memory");
}

#define XB_TMO      128
#define XB_XCNT(j)  (256  + 64 * (j))
#define XB_XSUB(j)  (1280 + 64 * (j))
#define XB_XGEN(j)  (2304 + 64 * (j))
#define XB_TOP      3328
#define XB_TOPGEN   3392
#define XCD_BAR_WORDS 3456
#define XB_SPIN_CAP (1u << 18)

__device__ __forceinline__ unsigned xb_ld(unsigned* p)              { return __hip_atomic_load(p, __ATOMIC_RELAXED, __HIP_MEMORY_SCOPE_AGENT); }
__device__ __forceinline__ unsigned xb_add(unsigned* p, unsigned v) { return __hip_atomic_fetch_add(p, v, __ATOMIC_RELAXED, __HIP_MEMORY_SCOPE_AGENT); }
__device__ __forceinline__ unsigned xb_xcc_id() { return (unsigned)__builtin_amdgcn_s_getreg((3 << 11) | 20) & 0xFu; }
#define XB_SPIN(cond, bar) do { unsigned _sp = 0; while (cond) { __builtin_amdgcn_s_sleep(1); \
    if ((++_sp & 255u) == 0u) { if (xb_ld(&(bar)[XB_TMO])) break; if (_sp > XB_SPIN_CAP) { atomicAdd(&(bar)[XB_TMO], 1u); break; } } } } while (0)

struct XcdBarrier {
    unsigned* bar; unsigned x;
    volatile LAS unsigned* st;
};

__device__ __forceinline__ XcdBarrier xcd_barrier_post(unsigned* bar, volatile LAS unsigned* st) {
    XcdBarrier b; b.bar = bar; b.x = xb_xcc_id(); b.st = st;
    if (threadIdx.x == 0) (void)xb_add(&bar[XB_XCNT(b.x)], 1u);
    return b;
}
__device__ __forceinline__ void xcd_barrier_complete(unsigned* bar, unsigned x, unsigned& nloc, unsigned& nx) {
    const unsigned G = gridDim.x * gridDim.y * gridDim.z;
    unsigned sum, cnt, mine, sp = 0u;
    for (;;) {
        sum = 0u; cnt = 0u; mine = 0u;
#pragma unroll
        for (unsigned j = 0; j < 16; ++j) { const unsigned c = xb_ld(&bar[XB_XCNT(j)]); sum += c; cnt += (c > 0u) ? 1u : 0u; mine = (j == x) ? c : mine; }
        if (sum == G) break;
        __builtin_amdgcn_s_sleep(1);
        if ((++sp & 255u) == 0u) { if (xb_ld(&bar[XB_TMO])) break; if (sp > XB_SPIN_CAP) { atomicAdd(&bar[XB_TMO], 1u); break; } }
    }
    nloc = mine > 0u ? mine : 1u; nx = cnt > 0u ? cnt : 1u;
}

__device__ __forceinline__ void xcd_barrier(const XcdBarrier& b) {
    asm volatile("s_waitcnt vmcnt(0)" ::: "memory");
    __syncthreads();
    if (threadIdx.x == 0) {
        unsigned* bar = b.bar;
        __builtin_amdgcn_s_waitcnt(0);
        unsigned nloc = b.st[0], nx = b.st[1];
        if (nloc == 0u) { xcd_barrier_complete(bar, b.x, nloc, nx); b.st[0] = nloc; b.st[1] = nx; }
        const unsigned old = xb_add(&bar[XB_XSUB(b.x)], 1u);
        const unsigned gen = old / nloc;
        if (old + 1u == (gen + 1u) * nloc) {
            __builtin_amdgcn_fence(__ATOMIC_RELEASE, "agent");
            asm volatile("s_waitcnt vmcnt(0)" ::: "memory");
            const unsigned og = xb_add(&bar[XB_TOP], 1u);
            const unsigned tg = og / nx;
            if (og + 1u == (tg + 1u) * nx) xb_add(&bar[XB_TOPGEN], 1u);
            else XB_SPIN(xb_ld(&bar[XB_TOPGEN]) == tg, bar);
            __builtin_amdgcn_fence(__ATOMIC_ACQUIRE, "agent");
            xb_add(&bar[XB_XGEN(b.x)], 1u);
            asm volatile("s_waitcnt vmcnt(0)" ::: "memory");
        } else {
            XB_SPIN(xb_ld(&bar[XB_XGEN(b.x)]) == gen, bar);
            __builtin_amdgcn_fence(__ATOMIC_ACQUIRE, "agent");
            asm volatile("s_waitcnt vmcnt(0)" ::: "memory");
        }
    }
    __syncthreads();
}

constexpr int NPHASE = 13;
struct Args { const float* in[40]; float* out; unsigned char* ws; int ph_lo, ph_hi; };
enum { I_XP = 0, I_XS, I_MEM, I_CCKV, I_CKPE, I_SCONV, I_SLRU, I_CMK, I_CMV, I_F1N, I_F1W1, I_F1W3, I_F1W2, I_MIXN, I_WIN, I_QN, I_WUQ, I_KVN, I_WUKV, I_CONVW, I_CONVB,
       I_LWA, I_LBA, I_LWX, I_LBX, I_LAM, I_AON, I_LON, I_WOUT, I_MEMN, I_XAN, I_WMQ, I_WMK, I_WMV, I_WMO, I_F2N, I_F2W1, I_F2W3, I_F2W2, I_FINN };

#define ssq0 ((float*)(ws + WS_SSQ))
#define ssq1 ((float*)(ws + WS_SSQ) + 1 * MT)
#define ssq2 ((float*)(ws + WS_SSQ) + 2 * MT)
#define ssq3 ((float*)(ws + WS_SSQ) + 3 * MT)
#define ssq4 ((float*)(ws + WS_SSQ) + 4 * MT)
#define ssqq ((float*)(ws + WS_SSQ) + 5 * MT)
#define ssqa ((float*)(ws + WS_SSQ) + 6 * MT)
#define W13_1 ((bf16_t*)(ws + WS_W13_1))
#define W2_1 ((bf16_t*)(ws + WS_W2_1))
#define W13_2 ((bf16_t*)(ws + WS_W13_2))
#define W2_2 ((bf16_t*)(ws + WS_W2_2))
#define WIN ((bf16_t*)(ws + WS_WIN))
#define WUQ ((bf16_t*)(ws + WS_WUQ))
#define WK ((bf16_t*)(ws + WS_WK))
#define WV ((bf16_t*)(ws + WS_WV))
#define WOUT ((bf16_t*)(ws + WS_WOUT))
#define WMQ ((bf16_t*)(ws + WS_WMQ))
#define WMKV ((bf16_t*)(ws + WS_WMKV))
#define WMO ((bf16_t*)(ws + WS_WMO))
#define MEMB ((bf16_t*)(ws + WS_MEMB))
#define MKB ((bf16_t*)(ws + WS_MKB))
#define MVTB ((bf16_t*)(ws + WS_MVTB))
#define MVB ((bf16_t*)(ws + WS_MVB))
#define CMKB ((bf16_t*)(ws + WS_CMKB))
#define CMVTB ((bf16_t*)(ws + WS_CMVTB))
#define XB ((bf16_t*)(ws + WS_XB))
#define HLOC ((bf16_t*)(out + O_Y))
#define ACUM ((bf16_t*)(out + O_Y) + (size_t)MT * 512)
#define HID ((bf16_t*)(ws + WS_HID))
#define CQ ((bf16_t*)(ws + WS_CQ))
#define CKVP ((bf16_t*)(ws + WS_CKVP))
#define CKVS ((bf16_t*)(ws + WS_CKVS))
#define XBR ((bf16_t*)(ws + WS_XBR))
#define MERGED ((bf16_t*)(ws + WS_MERGED))
#define GG ((bf16_t*)(ws + WS_GG))
#define Q ((bf16_t*)(ws + WS_Q))
#define KNP ((bf16_t*)(ws + WS_KNP))
#define KNS ((bf16_t*)(ws + WS_KNS))
#define VTP ((bf16_t*)(ws + WS_VTP))
#define VTS (((bf16_t*)(ws + WS_VTP)) + TP)
#define KPEP ((bf16_t*)(ws + WS_KPEP))
#define KPES ((bf16_t*)(ws + WS_KPES))
#define QM ((bf16_t*)(ws + WS_QM))
#define ATOT ((float*)(ws + WS_ATOT))
#define ACCB(i) ((float*)(ws + WS_ACC) + (size_t)(i) * TS * DM)
#define FLAGW(i) ((unsigned*)(ws + WS_BAR) + 3584 + 64 * (i))
#define XSA ((float*)(ws + WS_XSA))
#define XSB ((float*)(ws + WS_XSB))
#define BTOT ((float*)(ws + WS_BTOT))
__global__ void __launch_bounds__(NTHR, 2) mk_fwd(Args a) {
    extern __shared__ __attribute__((aligned(16))) unsigned char lds_raw[];
    LAS unsigned char* lds = (LAS unsigned char*)lds_raw;
    cg::grid_group grid = cg::this_grid();
    const int wave = __builtin_amdgcn_readfirstlane((int)threadIdx.x >> 6);
#define tid ((int)threadIdx.x)
#define lane ((int)threadIdx.x & 63)
    const __attribute__((address_space(4))) char* kargp = (const __attribute__((address_space(4))) char*)__builtin_amdgcn_kernarg_segment_ptr();
#define INP(i) (*(const float* const volatile __attribute__((address_space(4)))*)(kargp + 8 * (i)))
#define out (*(float* const volatile __attribute__((address_space(4)))*)(kargp + 320))
#define ws (*(unsigned char* const volatile __attribute__((address_space(4)))*)(kargp + 328))
#define lo (*(const volatile int __attribute__((address_space(4)))*)(kargp + 336))
#define hi (*(const volatile int __attribute__((address_space(4)))*)(kargp + 340))
#define G ((int)gridDim.x)
#define blk ((int)blockIdx.x)
#define vcu ((G % 8 == 0) ? (blk % 8) * (G / 8) + blk / 8 : blk)
#define gw (blk * NWAVE + wave)
#define NGW (G * NWAVE)
#define gtid ((size_t)blk * NTHR + tid)
#define NGT ((size_t)G * NTHR)
#define X (out + O_Y)
#ifndef PHMASK
#define PHMASK 0x1FFF
#endif
#define IN(k) (((PHMASK >> (k)) & 1) && lo <= (k) && (k) < hi)
    volatile LAS unsigned* xst = (volatile LAS unsigned*)(lds + LDS_EPI + 8192);
    if (tid == 0) { xst[0] = 0u; xst[1] = 0u; }
    __syncthreads();
    { XcdBarrier b0 = xcd_barrier_post((unsigned*)(ws + WS_BAR), xst); (void)b0; }
    if (hi > 1000) grid.sync();
#define SEAM(k) do { if (IN(k) && IN((k) + 1)) { XcdBarrier b_; b_.bar = (unsigned*)(ws + WS_BAR); b_.x = xb_xcc_id(); b_.st = xst; xcd_barrier(b_); } } while (0)

    constexpr int I_FFN = 16 * 88, I_W2 = 44 * 32, I_IN = 16 * 53, I_UQ = 6 * 24, I_UKV = 4 * 32, I_SQ = 16 * 32, I_CMVI = 8 * 128;
    constexpr int NITEMS = 4 * I_FFN + 2 * I_W2 + I_IN + I_UQ + I_UKV + 5 * I_SQ + I_CMVI, NA = 2 * I_FFN + 2 * I_SQ;
    auto do_item = [&](int it) {
        LAS float* scr = (LAS float*)(lds + wave * 16384);
        int r = it;
#define TRJ(NI, W, K_, N_, DST, LDD, GAIN, MAP) if (r < (NI)) { const int nb_ = (N_) / 32, kb = r / nb_, n0 = (r % nb_) * 32; tr_item((W), (N_), kb * 64, n0, (DST), (MAP), (LDD), (GAIN), scr, lane); return; } r -= (NI)
        TRJ(I_FFN, INP(I_F1W1), 1024, FF, W13_1, 1024, INP(I_F1N), (n0 >> 7) * 256 + (n0 & 127));
        TRJ(I_FFN, INP(I_F1W3), 1024, FF, W13_1, 1024, INP(I_F1N), (n0 >> 7) * 256 + 128 + (n0 & 127));
        TRJ(I_SQ, INP(I_WMK), 1024, 1024, WMKV, 1024, (const float*)nullptr, n0);
        TRJ(I_SQ, INP(I_WMV), 1024, 1024, WMKV, 1024, (const float*)nullptr, 1024 + n0);
        TRJ(I_W2, INP(I_F1W2), FF, 1024, W2_1, FF, (const float*)nullptr, n0);
        TRJ(I_IN, INP(I_WIN), 1024, 1696, WIN, 1024, INP(I_MIXN), (n0 < 384 ? 256 + n0 : (n0 < 640 ? n0 - 384 : (n0 < 672 ? n0 : n0 + 96))));
        TRJ(I_UQ, INP(I_WUQ), 384, 768, WUQ, 384, INP(I_QN), n0);
        TRJ(I_UKV, INP(I_WUKV), 256, 1024, WK, 256, (const float*)nullptr, ((n0 & 127) < 64 ? (n0 >> 7) * 64 + (n0 & 127) : 512 + (n0 >> 7) * 64 + (n0 & 127) - 64));
        TRJ(I_SQ, INP(I_WOUT), 1024, 1024, WOUT, 1024, (kb < 8 ? INP(I_AON) : (const float*)nullptr), n0);
        TRJ(I_SQ, INP(I_WMQ), 1024, 1024, WMQ, 1024, INP(I_XAN), n0);
        TRJ(I_SQ, INP(I_WMO), 1024, 1024, WMO, 1024, (const float*)nullptr, n0);
        TRJ(I_FFN, INP(I_F2W1), 1024, FF, W13_2, 1024, INP(I_F2N), (n0 >> 7) * 256 + (n0 & 127));
        TRJ(I_FFN, INP(I_F2W3), 1024, FF, W13_2, 1024, INP(I_F2N), (n0 >> 7) * 256 + 128 + (n0 & 127));
        TRJ(I_W2, INP(I_F2W2), FF, 1024, W2_2, FF, (const float*)nullptr, n0);
        { const int bb = r >> 7, rr = r & 127, kb = rr >> 5, n0 = (rr & 31) * 32;
          tr_item(INP(I_CMV) + (size_t)bb * 256 * 1024, 1024, kb * 64, n0, CMVTB + (size_t)bb * 1024 * 256, n0, 256, (const float*)nullptr, scr, lane); }
#undef TRJ
    };
    if (IN(0)) {
        { const int ngw0_ = NGW; const int nfirst = (G == 256) ? NA : NITEMS;
          for (int it = gw; it < nfirst; it += ngw0_) do_item(it); }
        const float* xp_ = INP(I_XP); const float* xs_ = INP(I_XS); const float* mem_ = INP(I_MEM); const float* cmk_ = INP(I_CMK); const float* memn_ = INP(I_MEMN);
        bf16_t* xb_ = XB; bf16_t* memb_ = MEMB; bf16_t* cmkb_ = CMKB; float* ssq0_ = ssq0; const int ngw_ = NGW;
        for (int m = gw; m < MT + 256 + 2048; m += ngw_) {
            const float* src; bf16_t* dst; int kind;
            if (m < TP) { src = xp_ + (size_t)m * DM; dst = xb_ + (size_t)m * DM; kind = 0; }
            else if (m < MT) { src = xs_ + (size_t)(m - TP) * DM; dst = xb_ + (size_t)m * DM; kind = 0; }
            else if (m < MT + 256) { src = mem_ + (size_t)(m - MT) * DM; dst = memb_ + (size_t)(m - MT) * DM; kind = 1; }
            else { src = cmk_ + (size_t)(m - MT - 256) * DM; dst = cmkb_ + (size_t)(m - MT - 256) * DM; kind = 2; }
            f32x4 v[4]; float s = 0.f;
#pragma unroll
            for (int j = 0; j < 4; ++j) { v[j] = *((const f32x4*)src + lane + 64 * j); s += (v[j][0] * v[j][0] + v[j][1] * v[j][1]) + (v[j][2] * v[j][2] + v[j][3] * v[j][3]); }
            if (kind != 2) s = wave_sum(s);
            if (kind == 0 && lane == 0) ssq0_[m] = s;
            if (kind == 1) { const float rs = __builtin_amdgcn_rsqf(s * (1.0f / 1024.0f) + EPS);
#pragma unroll
                for (int j = 0; j < 4; ++j) v[j] = v[j] * rs * *((const f32x4*)memn_ + lane + 64 * j); }
#pragma unroll
            for (int j = 0; j < 4; ++j) *((u32x2*)dst + lane + 64 * j) = (u32x2){pk2(v[j][0], v[j][1]), pk2(v[j][2], v[j][3])};
        }
        { float* z_ = ssq1; u32x4* wz_ = (u32x4*)(WIN + (size_t)672 * 1024); const size_t ngt_ = NGT;
          for (size_t i = gtid; i < (size_t)6 * MT; i += ngt_) z_[i] = 0.f;
          { f32x4* za_ = (f32x4*)ACCB(0); for (size_t i = gtid; i < (size_t)5 * TS * DM / 4; i += ngt_) za_[i] = (f32x4){0.f, 0.f, 0.f, 0.f}; }
          for (size_t i = gtid; i < (size_t)96 * 1024 / 8; i += ngt_) wz_[i] = (u32x4){0, 0, 0, 0}; }
    }
    SEAM(0);

    if (IN(1)) {
        { pg8::Gemm g{XB, W13_1, MT, 2 * FF, 1024, 1024, 1024}; pg8::Order S; S.init(MT, 2 * FF, G, blk, 0); pg8::EpiUp E{HID, ssq0};
          pg8::gemm_phase<pg8::EpiUp, pg8::Order, true, true>(lds, g, S, E); }
        { pg8::Gemm g{MEMB, WMKV, 256, 2048, 1024, 1024, 1024}; pg8::Order S; S.init(256, 2048, G, blk, 144); pg8::EpiMem E{out + O_MKP, out + O_MVP, MKB, MVB};
          pg8::gemm_phase<pg8::EpiMem, pg8::Order, true, true>(lds, g, S, E); }
        if (G == 256 && blk >= 152) { for (int it = NA + (blk - 152) * NWAVE + wave; it < NITEMS; it += (256 - 152) * NWAVE) do_item(it); }
    }
    SEAM(1);
    if (IN(2)) {
        { pg8::Gemm g{HID, W2_1, TP, 1024, FF, FF, FF}; pg8::Order S; S.init(TP, 1024, G, blk, 0);
          pg8::EpiRes E{XB, ssq1, nullptr, 0.f, 0.5f};
          pg8::gemm_phase<pg8::EpiRes, pg8::Order, true, true>(lds, g, S, E); }
        { pg8::Gemm g{HID, W2_1, TS, 1024, 256, FF, FF, 512}; pg8::Order S; S.init(TS, 1024, G, blk, 0, 64, 11);
          pg8::EpiAcc E{ACCB(0), nullptr, 0.f, 0, 0.5f};
          pg8::gemm_phase<pg8::EpiAcc, pg8::Order, true, true>(lds, g, S, E); }
    }
    SEAM(2);
    if (IN(3)) {
        if (blk >= G - 8) sample_finalize_part(blk - (G - 8), INP(I_XS), ACCB(0), XSA, XB + (size_t)TP * DM, ssq1 + TP, FLAGW(0));
        pg8::EpiWin E{ssq1, INP(I_KVN), out, CQ, ssqq, CKVP, CKVS, KPEP, KPES, XBR, GG, (LAS float*)(lds + LDS_EPI)};
        { pg8::Gemm g{XB, WIN, TP, 1792, 1024, 1024, 1024}; pg8::Order S; S.init(TP, 1792, G, blk, 0);
          pg8::gemm_phase<pg8::EpiWin, pg8::Order, true, true>(lds, g, S, E); }
        { pg8::Gemm g{XB, WIN, TS, 1792, 1024, 1024, 1024}; pg8::Order S; S.init(TS, 1792, G, blk, 192, 64); pg8::Unit u_;
          if (S.next(0, u_)) sample_wait(FLAGW(0), 8u);
          pg8::gemm_phase<pg8::EpiWin, pg8::Order, true, true>(lds, g, S, E); }
        if (G != 256 || blk >= 200) {
        { const f32x4* cckv_ = (const f32x4*)INP(I_CCKV); const f32x4* ckpe_ = (const f32x4*)INP(I_CKPE); bf16_t* ckvs_ = CKVS; bf16_t* kpes_ = KPES; bf16_t* mvtb_ = MVTB; const bf16_t* mvb_ = MVB; const bool idl_ = (G == 256); const size_t ngt_ = idl_ ? (size_t)(256 - 200) * NTHR : NGT; const size_t g0_ = idl_ ? (size_t)(blk - 200) * NTHR + tid : gtid;
          for (size_t i = g0_; i < (size_t)NBAT * PAST * 64; i += ngt_) { const size_t rw = i >> 6; const int c4 = (int)(i & 63); const int b = (int)(rw / PAST), t = (int)(rw % PAST);
              const f32x4 v = cckv_[i]; *(u32x2*)(ckvs_ + ((size_t)b * SKV + t) * 256 + c4 * 4) = (u32x2){pk2(v[0], v[1]), pk2(v[2], v[3])}; }
          for (size_t i = g0_; i < (size_t)NBAT * PAST * 8; i += ngt_) { const size_t rw = i >> 3; const int c4 = (int)(i & 7); const int b = (int)(rw / PAST), t = (int)(rw % PAST);
              const f32x4 v = ckpe_[i]; *(u32x2*)(kpes_ + ((size_t)b * SKV + t) * 32 + c4 * 4) = (u32x2){pk2(v[0], v[1]), pk2(v[2], v[3])}; }
          for (size_t i = g0_; i < (size_t)1024 * 256; i += ngt_) { const int d = (int)(i >> 8), k = (int)(i & 255); mvtb_[i] = mvb_[(size_t)k * DM + d]; } }
        }
    }
    SEAM(3);
    if (IN(4)) {
        { pg8::Gemm g{CQ, WUQ, MT, 768, QL, QL, QL}; pg8::Order S; S.init(MT, 768, G, blk, 0); pg8::EpiQ E{Q, ssqq};
          pg8::gemm_phase<pg8::EpiQ, pg8::Order, true, true>(lds, g, S, E); }
        { pg8::Gemm g{CKVP, WK, TP + MT, 512, 256, 256, 256}; pg8::Order S; S.init(TP + MT, 512, G, blk, 192); pg8::EpiStore E{KNP, 512, nullptr, 0.f, 1.f};
          pg8::gemm_phase<pg8::EpiStore, pg8::Order, true, true>(lds, g, S, E); }
        { pg8::Gemm g{WV, CKVP, 512, TP + MT, 256, 256, 256}; pg8::Order S; S.init(512, TP + MT, G, blk, 192); pg8::EpiStore E{VTP, VT_LD, nullptr, 0.f, 1.f};
          pg8::gemm_phase<pg8::EpiStore, pg8::Order, true, true>(lds, g, S, E); }
        const LruArgs LA{XBR, INP(I_CONVW), INP(I_CONVB), INP(I_LWA), INP(I_LBA), INP(I_LWX), INP(I_LBX), INP(I_LAM), INP(I_SCONV), INP(I_SLRU), HLOC, ACUM, ATOT, BTOT, out};
        { const int g_ = G; for (int u = (blk + g_ - (199 % g_)) % g_; u < 256; u += g_) lru_l1_unit(lds, u, LA); }
    }
    SEAM(4);
    if (IN(5)) {
        const int g_ = G; bf16_t* merged_ = MERGED; float* ssqa_ = ssqa; float* out_ = out;
        { const bf16_t* hloc_ = HLOC; const bf16_t* acum_ = ACUM; const bf16_t* gg_ = GG; const float* atot_ = ATOT; const float* btot_ = BTOT; const float* lon_ = INP(I_LON);
          for (int u = blk; u < 256; u += g_) lru_l3_unit(lds, u, hloc_, acum_, gg_, atot_, btot_, lon_, merged_, out_);
          const LruArgs LA{XBR, INP(I_CONVW), INP(I_CONVB), INP(I_LWA), INP(I_LBA), INP(I_LWX), INP(I_LBX), INP(I_LAM), INP(I_SCONV), INP(I_SLRU), HLOC, ACUM, ATOT, BTOT, out};
          for (int u = (blk + g_ - (128 % g_)) % g_; u < 8; u += g_) { lru_l1_unit(lds, 256 + u, LA); asm volatile("s_waitcnt vmcnt(0)" ::: "memory"); __syncthreads();
              lru_l3_unit(lds, 256 + u, hloc_, acum_, gg_, atot_, btot_, lon_, merged_, out_); } }
        { const bf16_t* q_ = Q; const bf16_t* knp_ = KNP; const bf16_t* kpep_ = KPEP; const bf16_t* vtp_ = VTP;
          for (int p = vcu; p < 256; p += g_) {
              const int h = p >> 5, s = p & 31;
              mla_prompt_unit(lds, h, 63 - s, q_, knp_, kpep_, vtp_, merged_, ssqa_);
              mla_prompt_unit(lds, h, s, q_, knp_, kpep_, vtp_, merged_, ssqa_);
          }
          const bf16_t* kns_ = KNS; const bf16_t* kpes_ = KPES; const bf16_t* vts_ = VTS;
          for (int u = blk; u < 64; u += g_) mla_sample_unit(lds, u >> 3, u & 7, q_, kns_, kpes_, vts_, merged_, ssqa_); }
    }
    SEAM(5);
    if (IN(6)) {
        { pg8::Gemm g{MERGED, WOUT, TP, 1024, 1024, 1024, 1024}; pg8::Order S; S.init(TP, 1024, G, blk, 0);
          pg8::EpiResMid E{{XB, ssq2, nullptr, 0.f, 1.f}, ssqa};
          pg8::gemm_phase<pg8::EpiResMid, pg8::Order, true, true>(lds, g, S, E); }
        { pg8::Gemm g{MERGED, WOUT, TS, 1024, 256, 1024, 1024, 512}; pg8::Order Ss; Ss.init(TS, 1024, G, blk, 0, 64, 4);
          pg8::EpiAcc E{ACCB(1), ssqa, 1.0f / 512.0f, 2, 1.f};
          pg8::gemm_phase<pg8::EpiAcc, pg8::Order, true, true>(lds, g, Ss, E); }
    }
    SEAM(6);
    if (IN(7)) {
        if (blk >= G - 8) sample_finalize_part(blk - (G - 8), XSA, ACCB(1), XSB, XB + (size_t)TP * DM, ssq2 + TP, FLAGW(1));
        { pg8::Gemm g{XB, WMQ, TP, 1024, 1024, 1024, 1024}; pg8::Order S; S.init(TP, 1024, G, blk, 0); pg8::EpiStore E{QM, 1024, ssq2, 1.0f / 1024.0f, XSCALE};
          pg8::gemm_phase<pg8::EpiStore, pg8::Order, true, true>(lds, g, S, E);
          asm volatile("s_waitcnt vmcnt(0)" ::: "memory"); __syncthreads();
          bf16_t* qm_ = QM; const bf16_t* mkb_ = MKB; const bf16_t* mvtb_ = MVTB; pg8::Unit u_;
          for (int i = 0; S.next(i, u_); ++i) xattn_unit(lds, u_.pm * 256, false, u_.pn, qm_, mkb_, mvtb_, nullptr, nullptr); }
        { pg8::Gemm g{XB, WMQ, TS, 1024, 256, 1024, 1024, 512}; pg8::Order S; S.init(TS, 1024, G, blk, 0, 64, 4); pg8::Unit u_;
          if (S.next(0, u_)) sample_wait(FLAGW(1), 8u);
          pg8::EpiAcc E{ACCB(2), nullptr, 0.f, 0, 1.f};
          pg8::gemm_phase<pg8::EpiAcc, pg8::Order, true, true>(lds, g, S, E); }
    }
    SEAM(7);
    if (IN(9)) {
        { const int g_ = G; bf16_t* qm_ = QM; const bf16_t* cmkb_ = CMKB; const bf16_t* cmvtb_ = CMVTB; const float* qacc_ = ACCB(2); const float* ssq2_ = ssq2;
          for (int u = g_ - 1 - blk; u < 32; u += g_) { const int b = u >> 2;
              xattn_unit(lds, TP + b * 32, true, u & 3, qm_, cmkb_ + (size_t)b * 256 * DM, cmvtb_ + (size_t)b * 1024 * 256, qacc_, ssq2_);
              asm volatile("s_waitcnt vmcnt(0)" ::: "memory"); __syncthreads();
              if (tid == 0) { __builtin_amdgcn_fence(__ATOMIC_RELEASE, "agent"); asm volatile("s_waitcnt vmcnt(0)" ::: "memory"); __hip_atomic_fetch_add(FLAGW(3), 1u, __ATOMIC_RELAXED, __HIP_MEMORY_SCOPE_AGENT); } } }
        { pg8::Gemm g{QM, WMO, TP, 1024, 1024, 1024, 1024}; pg8::Order S; S.init(TP, 1024, G, blk, 0);
          pg8::EpiRes E{XB, ssq3, nullptr, 0.f, 1.f};
          pg8::gemm_phase<pg8::EpiRes, pg8::Order, true, true>(lds, g, S, E); }
        { pg8::Gemm g{QM, WMO, TS, 1024, 256, 1024, 1024, 512}; pg8::Order S; S.init(TS, 1024, G, blk, 0, 64, 4); pg8::Unit u_;
          if (S.next(0, u_)) sample_wait(FLAGW(3), 32u);
          pg8::EpiAcc E{ACCB(3), nullptr, 0.f, 0, 1.f};
          pg8::gemm_phase<pg8::EpiAcc, pg8::Order, true, true>(lds, g, S, E); }
    }
    SEAM(9);
    if (IN(10)) {
        if (blk >= G - 8) sample_finalize_part(blk - (G - 8), XSB, ACCB(3), XSA, XB + (size_t)TP * DM, ssq3 + TP, FLAGW(2));
        pg8::EpiUp E{HID, ssq3};
        { pg8::Gemm g{XB, W13_2, TP, 2 * FF, 1024, 1024, 1024}; pg8::Order S; S.init(TP, 2 * FF, G, blk, 0);
          pg8::gemm_phase<pg8::EpiUp, pg8::Order, true, true>(lds, g, S, E); }
        { pg8::Gemm g{XB, W13_2, TS, 2 * FF, 1024, 1024, 1024}; pg8::Order S; S.init(TS, 2 * FF, G, blk, 128, 64); pg8::Unit u_;
          if (S.next(0, u_)) sample_wait(FLAGW(2), 8u);
          pg8::gemm_phase<pg8::EpiUp, pg8::Order, true, true>(lds, g, S, E); }
    }
    SEAM(10);
    if (IN(11)) {
        { pg8::Gemm g{HID, W2_2, TP, 1024, FF, FF, FF}; pg8::Order S; S.init(TP, 1024, G, blk, 0);
          pg8::EpiRes E{XB, ssq4, nullptr, 0.f, 0.5f};
          pg8::gemm_phase<pg8::EpiRes, pg8::Order, true, true>(lds, g, S, E); }
        { pg8::Gemm g{HID, W2_2, TS, 1024, 256, FF, FF, 512}; pg8::Order S; S.init(TS, 1024, G, blk, 0, 64, 11);
          pg8::EpiAcc E{ACCB(4), nullptr, 0.f, 0, 0.5f};
          pg8::gemm_phase<pg8::EpiAcc, pg8::Order, true, true>(lds, g, S, E); }
    }
    SEAM(11);
    if (IN(12)) {
        float* x_ = X; const float* s4_ = ssq4; const f32x4* fn_ = (const f32x4*)INP(I_FINN); const int ngw_ = NGW; const float* xs_ = XSA; const float* acc_ = ACCB(4); const bf16_t* xb12_ = XB;
        for (int m = gw; m < MT; m += ngw_) {
            f32x4* xr = (f32x4*)(x_ + (size_t)m * DM);
            if (m < TP) {
                const float rs = __builtin_amdgcn_rsqf(s4_[m] * (1.0f / 1024.0f) + EPS);
                const u32x2* xbr = (const u32x2*)(xb12_ + (size_t)m * DM);
#pragma unroll
                for (int j = 0; j < 4; ++j) { const u32x2 b = xbr[lane + 64 * j]; const f32x4 v = (f32x4){__builtin_bit_cast(float, b[0] << 16), __builtin_bit_cast(float, b[0] & 0xffff0000u), __builtin_bit_cast(float, b[1] << 16), __builtin_bit_cast(float, b[1] & 0xffff0000u)};
                    xr[lane + 64 * j] = v * rs * fn_[lane + 64 * j]; }
            } else {
                const size_t r = (size_t)(m - TP) * DM; f32x4 v[4]; float s = 0.f;
#pragma unroll
                for (int j = 0; j < 4; ++j) { v[j] = *((const f32x4*)(xs_ + r) + lane + 64 * j) + *((const f32x4*)(acc_ + r) + lane + 64 * j);
                    s += (v[j][0] * v[j][0] + v[j][1] * v[j][1]) + (v[j][2] * v[j][2] + v[j][3] * v[j][3]); }
                const float rs = __builtin_amdgcn_rsqf(wave_sum(s) * (1.0f / 1024.0f) + EPS);
#pragma unroll
                for (int j = 0; j < 4; ++j) xr[lane + 64 * j] = v[j] * rs * fn_[lane + 64 * j];
            }
        }
    }
#undef IN
#undef SEAM
}

#undef INP
#undef X
#undef tid
#undef lane
#undef out
#undef ws
#undef lo
#undef hi
#undef G
#undef blk
#undef vcu
#undef gw
#undef NGW
#undef gtid
#undef NGT
#ifndef MK_N_LAUNCHES
#define MK_N_LAUNCHES 1
#endif
extern "C" void kernel_launch(void* const* d_in, const int* in_sizes, int n_in, void* d_out, int out_size, void* d_ws, size_t ws_size, hipStream_t stream) {
    static int grid = 0;
    if (grid == 0) {
        int dev = 0, cus = 0, per_cu = 0;
        hipGetDevice(&dev);
        hipDeviceGetAttribute(&cus, hipDeviceAttributeMultiprocessorCount, dev);
        if (hipFuncSetAttribute((const void*)mk_fwd, hipFuncAttributeMaxDynamicSharedMemorySize, LDS_BYTES) != hipSuccess) fprintf(stderr, "kernel_launch: hipFuncSetAttribute failed\n");
        if (hipOccupancyMaxActiveBlocksPerMultiprocessor(&per_cu, (const void*)mk_fwd, NTHR, LDS_BYTES) != hipSuccess || per_cu < 1) { fprintf(stderr, "kernel_launch: occupancy query gave %d\n", per_cu); per_cu = 1; }
        (void)hipGetLastError();
        grid = cus * per_cu;
        if (n_in != 40 || ws_size < WS_END) { fprintf(stderr, "kernel_launch: unexpected n_in %d / ws %zu\n", n_in, ws_size); }
    }
    (void)hipMemsetAsync((unsigned char*)d_ws + WS_BAR, 0, 16384, stream);
    Args a{};
    for (int i = 0; i < 40; ++i) a.in[i] = (const float*)d_in[i];
    a.out = (float*)d_out; a.ws = (unsigned char*)d_ws;
#if MK_N_LAUNCHES == 1
    a.ph_lo = 0; a.ph_hi = NPHASE;
    void* args[] = {&a};
    hipError_t e = hipLaunchCooperativeKernel((const void*)mk_fwd, dim3(grid), dim3(NTHR), args, LDS_BYTES, stream);
    if (e != hipSuccess) fprintf(stderr, "kernel_launch: cooperative launch failed: %s (grid %d)\n", hipGetErrorString(e), grid);
#else
    for (int p = 0; p < NPHASE; ++p) { a.ph_lo = p; a.ph_hi = p + 1; hipLaunchKernelGGL(mk_fwd, dim3(grid), dim3(NTHR), LDS_BYTES, stream, a); }
#endif
}
```

```cpp
#include <hip/hip_runtime.h>
#include <hip/hip_cooperative_groups.h>
#include <cstdio>
#include <cstdint>
namespace cg = cooperative_groups;

#define LAS __attribute__((address_space(3)))
typedef unsigned short bf16_t;
typedef short bf16x8 __attribute__((ext_vector_type(8)));
typedef short s16x4 __attribute__((ext_vector_type(4)));
typedef float f32x4 __attribute__((ext_vector_type(4)));
typedef float f32x16 __attribute__((ext_vector_type(16)));
typedef unsigned u32x4 __attribute__((ext_vector_type(4)));
typedef unsigned u32x2 __attribute__((ext_vector_type(2)));

constexpr int TP = 16384, TS = 256, MT = TP + TS, DM = 1024, FF = 2816, QL = 384, KVL = 256, NBAT = 8, DSEQ = 32, PAST = 2048, SKV = PAST + DSEQ  ;
constexpr int VT_LD = 33152;
constexpr int VTS_LD = VT_LD;
constexpr float EPS = 1e-6f;
constexpr float LOG2E = 1.4426950408889634f;
constexpr float QSCALE = 0.10206207261596575f * LOG2E;
constexpr float XSCALE = 0.0625f * LOG2E;
constexpr int NTHR = 512, NWAVE = 8;
constexpr int LDS_BYTES = 147456;
constexpr int LDS_EPI = 131072;

constexpr size_t O_Y = 0, O_YS = 16777216, O_CKVP = 17039360, O_KPEP = 21233664, O_CONVP = 21757952, O_LRUP = 21759488,
                 O_MKP = 21760000, O_MVP = 22022144, O_CKVS = 22284288, O_KPES = 22349824, O_CONVS = 22358016, O_LRUS = 22370304;

constexpr size_t U64K = 65536;
constexpr size_t WS_SSQ = 0;
constexpr size_t WS_BAR = 466944;
constexpr size_t WS_ATOT = 16 * U64K, WS_BTOT = 32 * U64K;
constexpr size_t WS_W13_1 = 64 * U64K;
constexpr size_t WS_W2_1 = WS_W13_1 + 176 * U64K;
constexpr size_t WS_W13_2 = WS_W2_1 + 88 * U64K;
constexpr size_t WS_W2_2 = WS_W13_2 + 176 * U64K;
constexpr size_t WS_WIN = WS_W2_2 + 88 * U64K;
constexpr size_t WS_WUQ = WS_WIN + 56 * U64K;
constexpr size_t WS_WK = WS_WUQ + 9 * U64K;
constexpr size_t WS_WV = WS_WK + 4 * U64K;
constexpr size_t WS_WOUT = WS_WV + 4 * U64K;
constexpr size_t WS_WMQ = WS_WOUT + 32 * U64K;
constexpr size_t WS_WMKV = WS_WMQ + 32 * U64K;
constexpr size_t WS_WMO = WS_WMKV + 64 * U64K;
constexpr size_t WS_MEMB = 52 * 16 * U64K;
constexpr size_t WS_MKB = WS_MEMB + 8 * U64K, WS_MVTB = WS_MKB + 8 * U64K, WS_MVB = WS_MVTB + 8 * U64K, WS_CMKB = WS_MVB + 8 * U64K, WS_CMVTB = WS_CMKB + 64 * U64K;
constexpr size_t WS_XB = 62 * 16 * U64K;
constexpr size_t WS_HLOC = WS_XB, WS_ACUM = WS_XB + 260 * U64K;
constexpr size_t WS_R = 95 * 16 * U64K;
constexpr size_t WS_HID = WS_R;
constexpr size_t WS_CQ = WS_R;
constexpr size_t WS_CKVP = WS_CQ + 195 * U64K;
constexpr size_t WS_CKVS = WS_CKVP + 128 * U64K;
constexpr size_t WS_XBR = WS_CKVS + 130 * U64K;
constexpr size_t WS_MERGED = WS_R;
constexpr size_t WS_GG = WS_R + 720 * U64K;
constexpr size_t WS_Q = WS_GG + 260 * U64K;
constexpr size_t WS_KNP = WS_Q + 390 * U64K;
constexpr size_t WS_KNS = WS_KNP + 256 * U64K;
constexpr size_t WS_VTP = WS_KNS + 261 * U64K;
constexpr size_t WS_VTS = WS_VTP + 256 * U64K;
constexpr size_t WS_KPEP = WS_VTS + 262 * U64K;
constexpr size_t WS_KPES = WS_KPEP + 16 * U64K;
constexpr size_t WS_QM = WS_R + 768 * U64K;
constexpr size_t WS_END = WS_KPES + 17 * U64K;
constexpr size_t WS_ACC = 248 * 16 * U64K;
constexpr size_t WS_XSA = 253 * 16 * U64K, WS_XSB = 254 * 16 * U64K;
static_assert(WS_WMO + 32 * U64K <= WS_MEMB && WS_CMVTB + 64 * U64K <= WS_XB && WS_XB + 520 * U64K <= WS_R, "ws map 1");
static_assert(WS_XBR + 260 * U64K <= WS_GG && WS_END <= WS_ACC && WS_HID + (size_t)MT * FF * 2 <= 256u * 16 * U64K, "ws map 2");

__device__ __forceinline__ unsigned f2bf(float f) { unsigned u = __builtin_bit_cast(unsigned, f); return (u + 0x7fffu + ((u >> 16) & 1u)) >> 16; }
__device__ __forceinline__ unsigned pk2(float lo, float hi) { unsigned r; asm volatile("v_cvt_pk_bf16_f32 %0, %1, %2" : "=v"(r) : "v"(lo), "v"(hi)); return r; }
__device__ __forceinline__ float bf2f(unsigned short b) { return __builtin_bit_cast(float, (unsigned)b << 16); }
__device__ __forceinline__ float wave_sum(float v) {
#pragma unroll
    for (int o = 1; o < 64; o <<= 1) v += __shfl_xor(v, o);
    return v;
}
__device__ __forceinline__ void atomic_addf(float* p, float v) { __hip_atomic_fetch_add(p, v, __ATOMIC_RELAXED, __HIP_MEMORY_SCOPE_AGENT); }
__device__ __forceinline__ float sigmoidf_(float x) { return 1.f / (1.f + __expf(-x)); }
__device__ __forceinline__ float gelu_tanh(float v) { const float u = 1.5957691216057308f * (v + 0.044715f * v * v * v); return v * __builtin_amdgcn_rcpf(1.f + __builtin_amdgcn_exp2f(-LOG2E * u)); }
__device__ __forceinline__ void rope_cs(int pos, int j, float& c, float& s) {
    const float inv = __builtin_amdgcn_exp2f(-0.8304820237218406f * (float)j);
    const float ang = (float)pos * inv;
    const float k = rintf(ang * 0.15915494309189535f);
    float r = fmaf(-k, 6.28125f, ang); r = fmaf(-k, 0.0019353071795864769f, r);
    c = __cosf(r); s = __sinf(r);
}
namespace pg8 {
#define PG8_LAS __attribute__((address_space(3)))
typedef unsigned short bf16_t;
typedef short bf16x8 __attribute__((ext_vector_type(8)));
typedef float f32x4 __attribute__((ext_vector_type(4)));
typedef unsigned u32x4 __attribute__((ext_vector_type(4)));
constexpr int BM = 256, BK = 64, HALF = 128, HTB = HALF * BK * 2  , STAGE_BYTES = 8 * HTB, NXCD = 8, WGM = 8;

__host__ __device__ __forceinline__ int lds_byte(int r, int c) { const int st = (r >> 4) * 2 + (c >> 5), rr = r & 15, cc = c & 31, ob = rr * 64 + cc * 2; return st * 1024 + (ob ^ (((ob >> 9) & 1) << 5)); }
__host__ __device__ __forceinline__ void stage_rc(int b, int& R, int& C) { const int st = b / 1024, sb = b % 1024, swz = sb ^ (((sb >> 9) & 1) << 5); R = (st >> 1) * 16 + swz / 64; C = (st & 1) * 32 + (swz % 64) / 2; }
__host__ __device__ __forceinline__ int perm32(int rho) { const int n = rho >> 4, i = rho & 15; return 8 * (i >> 2) + 4 * n + (i & 3); }

struct Unit { int pm, pn, kc; };
struct Gemm { const bf16_t* A; const bf16_t* Bt; int M, N, K, lda, ldb, kcb; };

struct StaticOrder {
    int nM, nN, nwg, G, c;
    __host__ __device__ void init(int M, int N, int G_, int c_) { nM = M / BM; nN = N / BM; nwg = nM * nN; G = G_; c = c_; }
    __host__ __device__ bool next(int i, Unit& u) const {
        const long L = (long)i * G + c; if (L >= nwg) return false;
        int wgid = (int)L; { const int q = nwg / NXCD, r = nwg % NXCD, xcd = wgid % NXCD, off = wgid / NXCD; wgid = (xcd < r ? xcd * (q + 1) : r * (q + 1) + (xcd - r) * q) + off; }
        const int nig = WGM * nN, gid = wgid / nig, fm = gid * WGM, gsz = (nM - fm) < WGM ? (nM - fm) : WGM;
        u.pm = fm + ((wgid % nig) % gsz); u.pn = (wgid % nig) / gsz; u.kc = 0; return true;
    }
    __device__ __forceinline__ void a_ready(const Unit&) const {}
    __device__ __forceinline__ void done(const Unit&) const {}
};

__device__ __forceinline__ unsigned cvt_pk_bf16(float lo, float hi) { unsigned r; asm volatile("v_cvt_pk_bf16_f32 %0, %1, %2" : "=v"(r) : "v"(lo), "v"(hi)); return r; }

struct Order {
    int nM, nN, nK, nwg, G, c, pmo;
    __device__ __forceinline__ void init(int M, int N, int G_, int blk, int rot, int pm_off = 0, int nK_ = 1) { nM = M / BM; nN = N / BM; nK = nK_; nwg = nM * nN * nK_; G = G_; c = (blk + G_ - (rot % G_)) % G_; pmo = pm_off; }
    __device__ __forceinline__ bool next(int i, Unit& u) const {
        const long L = (long)i * G + c; if (L >= nwg) return false;
        int wgid = (int)L; { const int q = nwg / NXCD, r = nwg % NXCD, xcd = wgid % NXCD, off = wgid / NXCD; wgid = (xcd < r ? xcd * (q + 1) : r * (q + 1) + (xcd - r) * q) + off; }
        u.kc = wgid % nK; wgid /= nK;
        const int nig = WGM * nN, gid = wgid / nig, fm = gid * WGM, gsz = (nM - fm) < WGM ? (nM - fm) : WGM;
        u.pm = pmo + fm + ((wgid % nig) % gsz); u.pn = (wgid % nig) / gsz; return true;
    }
    __device__ __forceinline__ void a_ready(const Unit&) const {}
    __device__ __forceinline__ void done(const Unit&) const {}
};

struct EpiAcc {
    static constexpr bool PERM = false, AFTER_DRAIN = false, MIDSCALE = false, PREFETCH = false;
    float* ACC; const float* rs_in; float rs_invn; int kc_lim; float alpha;
    __device__ __forceinline__ void operator()(const f32x4 (&acc)[2][2][4][2], const Unit& u, int wr, int wc, int fr, int fq) const {
        const int col0 = u.pn * BM + wc * 32 + 4 * fq;
#pragma unroll
        for (int ai = 0; ai < 2; ++ai)
#pragma unroll
            for (int m = 0; m < 4; ++m) {
                const int rl = ai * HALF + wr * 64 + m * 16 + fr;
                float sc = alpha; if (rs_in && u.kc < kc_lim) sc *= __builtin_amdgcn_rsqf(rs_in[TP + rl] * rs_invn + EPS);
#pragma unroll
                for (int bj = 0; bj < 2; ++bj)
#pragma unroll
                    for (int n = 0; n < 2; ++n) {
                        float* p = ACC + (size_t)rl * DM + col0 + bj * HALF + n * 16; const f32x4 v = acc[ai][bj][m][n] * sc;
                        atomic_addf(p, v[0]); atomic_addf(p + 1, v[1]); atomic_addf(p + 2, v[2]); atomic_addf(p + 3, v[3]);
                    }
            }
    }
};

struct EpiUp {
    static constexpr bool PERM = true, AFTER_DRAIN = false, MIDSCALE = false, PREFETCH = true;
    bf16_t* H; const float* ssq;
    __device__ __forceinline__ void prefetch(float (&pre)[8], const Unit& u, int wr, int fr) const {
#pragma unroll
        for (int ai = 0; ai < 2; ++ai)
#pragma unroll
            for (int m = 0; m < 4; ++m) pre[ai * 4 + m] = ssq[u.pm * BM + ai * HALF + wr * 64 + m * 16 + fr];
    }
    __device__ __forceinline__ void operator()(const f32x4 (&acc)[2][2][4][2], const Unit& u, int wr, int wc, int fr, int fq, const float (&pre)[8]) const {
        const int col = u.pn * 128 + wc * 32 + 8 * fq;
#pragma unroll
        for (int ai = 0; ai < 2; ++ai)
#pragma unroll
            for (int m = 0; m < 4; ++m) {
                const int row = u.pm * BM + ai * HALF + wr * 64 + m * 16 + fr;
                const float r = __builtin_amdgcn_rsqf(pre[ai * 4 + m] * (1.0f / 1024.0f) + EPS);
                const float rl = -LOG2E * r, r2 = r * r;
                typedef float f32x2e __attribute__((ext_vector_type(2)));
                unsigned w[4];
#pragma unroll
                for (int n = 0; n < 2; ++n) {
                    const f32x4 ag = acc[ai][0][m][n], au = acc[ai][1][m][n];
#pragma unroll
                    for (int hh = 0; hh < 2; ++hh) {
                        const f32x2e g2 = (f32x2e){ag[2 * hh], ag[2 * hh + 1]}, u2 = (f32x2e){au[2 * hh], au[2 * hh + 1]};
                        const f32x2e e2 = g2 * rl; f32x2e d2 = (f32x2e){__builtin_amdgcn_exp2f(e2[0]), __builtin_amdgcn_exp2f(e2[1])} + 1.0f;
                        const f32x2e rc2 = (f32x2e){__builtin_amdgcn_rcpf(d2[0]), __builtin_amdgcn_rcpf(d2[1])};
                        const f32x2e v2 = (g2 * u2) * (rc2 * r2);
                        w[2 * n + hh] = cvt_pk_bf16(v2[0], v2[1]);
                    }
                }
                *(u32x4*)(H + (size_t)row * FF + col) = (u32x4){w[0], w[1], w[2], w[3]};
            }
    }
};

struct EpiRes {
    static constexpr bool PERM = true, AFTER_DRAIN = false, MIDSCALE = false, PREFETCH = false;
    bf16_t* XB; float* ssq_out; const float* rs_in; float rs_invn; float alpha;
    __device__ __forceinline__ void operator()(const f32x4 (&acc)[2][2][4][2], const Unit& u, int wr, int wc, int fr, int fq) const {
        const int col0 = u.pn * BM + wc * 32 + 8 * fq;
#pragma unroll
        for (int ai = 0; ai < 2; ++ai)
#pragma unroll
            for (int m = 0; m < 4; ++m) {
                const int row = u.pm * BM + ai * HALF + wr * 64 + m * 16 + fr;
                float sc = alpha; if (rs_in) sc *= __builtin_amdgcn_rsqf(rs_in[row] * rs_invn + EPS);
                typedef float f32x2r __attribute__((ext_vector_type(2)));
                f32x2r sq2 = (f32x2r){0.f, 0.f};
#pragma unroll
                for (int bj = 0; bj < 2; ++bj) {
                    bf16_t* p = XB + (size_t)row * DM + col0 + bj * HALF;
                    const u32x4 b = *(const u32x4*)p; f32x2r o2[4];
#pragma unroll
                    for (int k = 0; k < 4; ++k) {
                        const f32x2r x2 = (f32x2r){__builtin_bit_cast(float, b[k] << 16), __builtin_bit_cast(float, b[k] & 0xffff0000u)};
                        const f32x4 av = acc[ai][bj][m][k >> 1];
                        const f32x2r a2 = (k & 1) ? (f32x2r){av[2], av[3]} : (f32x2r){av[0], av[1]};
                        o2[k] = x2 + a2 * sc; sq2 += o2[k] * o2[k];
                    }
                    *(u32x4*)p = (u32x4){cvt_pk_bf16(o2[0][0], o2[0][1]), cvt_pk_bf16(o2[1][0], o2[1][1]), cvt_pk_bf16(o2[2][0], o2[2][1]), cvt_pk_bf16(o2[3][0], o2[3][1])};
                }
                float sq = sq2[0] + sq2[1];
                if (ssq_out) { sq += __shfl_xor(sq, 16); sq += __shfl_xor(sq, 32); if (fq == 0) atomic_addf(ssq_out + row, sq); }
            }
    }
};

struct EpiResMid : EpiRes {
    static constexpr bool MIDSCALE = true;
    const float* ssqa;
    __device__ __forceinline__ void midscale(f32x4 (&acc)[2][2][4][2], const Unit& u, int wr, int fr) const {
#pragma unroll
        for (int ai = 0; ai < 2; ++ai)
#pragma unroll
            for (int m = 0; m < 4; ++m) {
                const float f = __builtin_amdgcn_rsqf(ssqa[u.pm * BM + ai * HALF + wr * 64 + m * 16 + fr] * (1.0f / 512.0f) + EPS);
#pragma unroll
                for (int bj = 0; bj < 2; ++bj)
#pragma unroll
                    for (int n = 0; n < 2; ++n) acc[ai][bj][m][n] *= f;
            }
    }
};

struct EpiStore {
    static constexpr bool PERM = true, AFTER_DRAIN = false, MIDSCALE = false, PREFETCH = false;
    bf16_t* O; int ldc; const float* rs_in; float rs_invn; float scale;
    __device__ __forceinline__ void operator()(const f32x4 (&acc)[2][2][4][2], const Unit& u, int wr, int wc, int fr, int fq) const {
        const int col0 = u.pn * BM + wc * 32 + 8 * fq;
#pragma unroll
        for (int ai = 0; ai < 2; ++ai)
#pragma unroll
            for (int m = 0; m < 4; ++m) {
                const int row = u.pm * BM + ai * HALF + wr * 64 + m * 16 + fr;
                float sc = scale; if (rs_in) sc *= __builtin_amdgcn_rsqf(rs_in[row] * rs_invn + EPS);
#pragma unroll
                for (int bj = 0; bj < 2; ++bj) {
                    const f32x4 v0 = acc[ai][bj][m][0] * sc, v1 = acc[ai][bj][m][1] * sc;
                    *(u32x4*)(O + (size_t)row * ldc + col0 + bj * HALF) = (u32x4){cvt_pk_bf16(v0[0], v0[1]), cvt_pk_bf16(v0[2], v0[3]), cvt_pk_bf16(v1[0], v1[1]), cvt_pk_bf16(v1[2], v1[3])};
                }
            }
    }
};

struct EpiMem {
    static constexpr bool PERM = false, AFTER_DRAIN = false, MIDSCALE = false, PREFETCH = false;
    float* outk; float* outv; bf16_t* KB; bf16_t* VB;
    __device__ __forceinline__ void operator()(const f32x4 (&acc)[2][2][4][2], const Unit& u, int wr, int wc, int fr, int fq) const {
        const bool isv = u.pn >= 4; const int col0 = (u.pn & 3) * BM + wc * 32 + 4 * fq;
        float* of = isv ? outv : outk; bf16_t* ob = isv ? VB : KB;
#pragma unroll
        for (int ai = 0; ai < 2; ++ai)
#pragma unroll
            for (int m = 0; m < 4; ++m) {
                const int row = ai * HALF + wr * 64 + m * 16 + fr;
#pragma unroll
                for (int bj = 0; bj < 2; ++bj)
#pragma unroll
                    for (int n = 0; n < 2; ++n) {
                        const int col = col0 + bj * HALF + n * 16; const f32x4 o = acc[ai][bj][m][n];
                        *(f32x4*)(of + (size_t)row * DM + col) = o;
                        *(u32x2*)(ob + (size_t)row * DM + col) = (u32x2){cvt_pk_bf16(o[0], o[1]), cvt_pk_bf16(o[2], o[3])};
                    }
            }
    }
};

struct EpiQ {
    static constexpr bool PERM = false, AFTER_DRAIN = false, MIDSCALE = false, PREFETCH = false;
    bf16_t* Q; const float* ssqq;
    __device__ __forceinline__ void operator()(const f32x4 (&acc)[2][2][4][2], const Unit& u, int wr, int wc, int fr, int fq) const {
#pragma unroll
        for (int ai = 0; ai < 2; ++ai)
#pragma unroll
            for (int m = 0; m < 4; ++m) {
                const int row = u.pm * BM + ai * HALF + wr * 64 + m * 16 + fr;
                const float sc = QSCALE * __builtin_amdgcn_rsqf(ssqq[row] * (1.0f / 384.0f) + EPS);
                const int pos = row < TP ? row : PAST + ((row - TP) & 31);
#pragma unroll
                for (int bj = 0; bj < 2; ++bj) {
                    const int gidx = u.pn * 8 + bj * 4 + wc; const int c0 = gidx * 32 + 4 * fq;
                    f32x4 v0 = acc[ai][bj][m][0] * sc, v1 = acc[ai][bj][m][1] * sc;
                    if (gidx % 3 == 2) {
#pragma unroll
                        for (int i = 0; i < 4; ++i) { float c, s; rope_cs(pos, 4 * fq + i, c, s); const float a = v0[i], b = v1[i]; v0[i] = a * c - b * s; v1[i] = b * c + a * s; }
                    }
                    *(u32x2*)(Q + (size_t)row * 768 + c0) = (u32x2){cvt_pk_bf16(v0[0], v0[1]), cvt_pk_bf16(v0[2], v0[3])};
                    *(u32x2*)(Q + (size_t)row * 768 + c0 + 16) = (u32x2){cvt_pk_bf16(v1[0], v1[1]), cvt_pk_bf16(v1[2], v1[3])};
                }
            }
    }
};

struct EpiWin {
    static constexpr bool PERM = false, AFTER_DRAIN = false, MIDSCALE = false, PREFETCH = false;
    const float* ssq1; const float* kvg; float* out; bf16_t* CQ; float* ssqq; bf16_t* CKVP; bf16_t* CKVS; bf16_t* KPEP; bf16_t* KPES; bf16_t* XBR; bf16_t* GG; LAS float* P;
    __device__ __forceinline__ void operator()(const f32x4 (&acc)[2][2][4][2], const Unit& u, int wr, int wc, int fr, int fq) const {
        const int pn = u.pn;
        if (pn == 0) {
#pragma unroll
            for (int ai = 0; ai < 2; ++ai)
#pragma unroll
                for (int m = 0; m < 4; ++m) {
                    const int row = u.pm * BM + ai * HALF + wr * 64 + m * 16 + fr;
                    const float r = __builtin_amdgcn_rsqf(ssq1[row] * (1.0f / 1024.0f) + EPS);
                    float sq = 0.f;
#pragma unroll
                    for (int bj = 0; bj < 2; ++bj)
#pragma unroll
                        for (int n = 0; n < 2; ++n) { const f32x4 v = acc[ai][bj][m][n] * r; sq += (v[0] * v[0] + v[1] * v[1]) + (v[2] * v[2] + v[3] * v[3]); }
                    sq += __shfl_xor(sq, 16); sq += __shfl_xor(sq, 32);
                    if (fq == 0) P[(ai * HALF + wr * 64 + m * 16 + fr) * 4 + wc] = sq;
                }
            asm volatile("s_waitcnt lgkmcnt(0)" ::: "memory"); __builtin_amdgcn_s_barrier(); asm volatile("" ::: "memory");
#pragma unroll
            for (int ai = 0; ai < 2; ++ai)
#pragma unroll
                for (int m = 0; m < 4; ++m) {
                    const int rl = ai * HALF + wr * 64 + m * 16 + fr; const int row = u.pm * BM + rl;
                    const f32x4 pp = *(const LAS f32x4*)(P + rl * 4);
                    const float rk = __builtin_amdgcn_rsqf(((pp[0] + pp[1]) + (pp[2] + pp[3])) * (1.0f / 256.0f) + EPS) * __builtin_amdgcn_rsqf(ssq1[row] * (1.0f / 1024.0f) + EPS);
                    float* of; bf16_t* ob;
                    if (row < TP) { of = out + O_CKVP + (size_t)row * 256; ob = CKVP + (size_t)row * 256; }
                    else { const int rs = row - TP; of = out + O_CKVS + (size_t)rs * 256; ob = CKVS + (size_t)((rs >> 5) * SKV + PAST + (rs & 31)) * 256; }
#pragma unroll
                    for (int bj = 0; bj < 2; ++bj)
#pragma unroll
                        for (int n = 0; n < 2; ++n) {
                            const int col = bj * HALF + wc * 32 + n * 16 + 4 * fq;
                            const f32x4 o = acc[ai][bj][m][n] * rk * *(const f32x4*)(kvg + col);
                            *(f32x4*)(of + col) = o; *(u32x2*)(ob + col) = (u32x2){cvt_pk_bf16(o[0], o[1]), cvt_pk_bf16(o[2], o[3])};
                        }
                }
            asm volatile("s_waitcnt lgkmcnt(0)" ::: "memory"); __builtin_amdgcn_s_barrier(); asm volatile("" ::: "memory");
            return;
        }
#pragma unroll
        for (int ai = 0; ai < 2; ++ai)
#pragma unroll
            for (int m = 0; m < 4; ++m) {
                const int row = u.pm * BM + ai * HALF + wr * 64 + m * 16 + fr;
                const float r = __builtin_amdgcn_rsqf(ssq1[row] * (1.0f / 1024.0f) + EPS);
                if (pn == 1 || pn == 2) {
                    float sq = 0.f;
#pragma unroll
                    for (int bj = 0; bj < 2; ++bj) {
                        if (pn == 2 && bj == 1) {
                            if (wc == 0) {
                                const int pos = row < TP ? row : PAST + ((row - TP) & 31);
                                f32x4 v0 = acc[ai][1][m][0] * r, v1 = acc[ai][1][m][1] * r;
#pragma unroll
                                for (int i = 0; i < 4; ++i) { float c, s; rope_cs(pos, 4 * fq + i, c, s); const float a = v0[i], b = v1[i]; v0[i] = a * c - b * s; v1[i] = b * c + a * s; }
                                float* of; bf16_t* ob;
                                if (row < TP) { of = out + O_KPEP + (size_t)row * 32; ob = KPEP + (size_t)row * 32; }
                                else { const int rs = row - TP; of = out + O_KPES + (size_t)rs * 32; ob = KPES + (size_t)((rs >> 5) * SKV + PAST + (rs & 31)) * 32; }
                                *(f32x4*)(of + 4 * fq) = v0; *(f32x4*)(of + 16 + 4 * fq) = v1;
                                *(u32x2*)(ob + 4 * fq) = (u32x2){cvt_pk_bf16(v0[0], v0[1]), cvt_pk_bf16(v0[2], v0[3])};
                                *(u32x2*)(ob + 16 + 4 * fq) = (u32x2){cvt_pk_bf16(v1[0], v1[1]), cvt_pk_bf16(v1[2], v1[3])};
                            }
                        } else {
#pragma unroll
                            for (int n = 0; n < 2; ++n) {
                                const int col = (pn - 1) * 256 + bj * HALF + wc * 32 + n * 16 + 4 * fq;
                                const f32x4 v = acc[ai][bj][m][n] * r;
                                *(u32x2*)(CQ + (size_t)row * QL + col) = (u32x2){cvt_pk_bf16(v[0], v[1]), cvt_pk_bf16(v[2], v[3])};
                                sq += (v[0] * v[0] + v[1] * v[1]) + (v[2] * v[2] + v[3] * v[3]);
                            }
                        }
                    }
                    sq += __shfl_xor(sq, 16); sq += __shfl_xor(sq, 32); if (fq == 0) atomic_addf(ssqq + row, sq);
                } else if (pn <= 4) {
                    float* cs = nullptr;
                    if (row < TP) { if (row >= TP - 3) cs = out + O_CONVP + (size_t)(row - (TP - 3)) * 512; }
                    else { const int rs = row - TP, t = rs & 31; if (t >= 29) cs = out + O_CONVS + (size_t)((rs >> 5) * 3 + (t - 29)) * 512; }
#pragma unroll
                    for (int bj = 0; bj < 2; ++bj)
#pragma unroll
                        for (int n = 0; n < 2; ++n) {
                            const int col = (pn - 3) * 256 + bj * HALF + wc * 32 + n * 16 + 4 * fq;
                            const f32x4 v = acc[ai][bj][m][n] * r;
                            *(u32x2*)(XBR + (size_t)row * 512 + col) = (u32x2){cvt_pk_bf16(v[0], v[1]), cvt_pk_bf16(v[2], v[3])};
                            if (cs) *(f32x4*)(cs + col) = v;
                        }
                } else {
#pragma unroll
                    for (int bj = 0; bj < 2; ++bj)
#pragma unroll
                        for (int n = 0; n < 2; ++n) {
                            const int col = (pn - 5) * 256 + bj * HALF + wc * 32 + n * 16 + 4 * fq;
                            const f32x4 v = acc[ai][bj][m][n] * r;
                            *(u32x2*)(GG + (size_t)row * 512 + col) = (u32x2){cvt_pk_bf16(gelu_tanh(v[0]), gelu_tanh(v[1])), cvt_pk_bf16(gelu_tanh(v[2]), gelu_tanh(v[3]))};
                        }
                }
            }
    }
};

template <class Epi, class Sched, bool ALIGN_EPI = false, bool SP2 = false>
__device__ __forceinline__ void gemm_phase(PG8_LAS unsigned char* lds, const Gemm g, const Sched& S, const Epi& E) {
    const int tid = threadIdx.x, wid = __builtin_amdgcn_readfirstlane(tid >> 6), lane = tid & 63, wr = wid >> 2, wc = wid & 3, fr = lane & 15, fq = lane >> 4;
    const int K = g.K, nt = K / BK;
    unsigned voffA[2], voffB[2];
#pragma unroll
    for (int i = 0; i < 2; ++i) { int R, C; stage_rc(tid * 16 + i * 8192, R, C); const int Rb = Epi::PERM ? ((R & ~31) + perm32(R & 31)) : R;
        voffA[i] = (unsigned)(R * g.lda + C) * 2u; voffB[i] = (unsigned)(Rb * g.ldb + C) * 2u; }
    const size_t kstep = (size_t)(BK * 2);
    const size_t hstepA = (size_t)HALF * g.lda * 2, hstepB = (size_t)HALF * g.ldb * 2;
    const size_t tstepA = 2 * hstepA, tstepB = 2 * hstepB;
    const unsigned ldsw = (unsigned)wid * 1024u;
    const int aoff = lds_byte(wr * 64 + fr, fq * 8), boff = lds_byte(wc * 32 + fr, fq * 8);
#define PG8_SA(b, h) (((b) * 2 + (h)) * HTB)
#define PG8_SB(b, h) ((4 + (b) * 2 + (h)) * HTB)
#define PG8_STAGE(bufoff, gbase, voff) do { _Pragma("unroll") for (int _i = 0; _i < 2; ++_i) \
        __builtin_amdgcn_global_load_lds((const unsigned*)((const char*)(gbase) + (voff)[_i]), (PG8_LAS unsigned*)(lds + (bufoff) + ldsw + _i * 8192), 16, 0, 0); } while (0)
#define PG8_LDA(dst, b, h) do { _Pragma("unroll") for (int m = 0; m < 4; ++m) _Pragma("unroll") for (int k = 0; k < 2; ++k) dst[m][k] = *(const PG8_LAS bf16x8*)(lds + PG8_SA(b, h) + aoff + m * 2048 + k * 1024); } while (0)
#define PG8_LDB(dst, b, h) do { _Pragma("unroll") for (int n = 0; n < 2; ++n) _Pragma("unroll") for (int k = 0; k < 2; ++k) dst[n][k] = *(const PG8_LAS bf16x8*)(lds + PG8_SB(b, h) + boff + n * 2048 + k * 1024); } while (0)
#define PG8_MMA(ai, bj, At, Bt) do { __builtin_amdgcn_s_setprio(1); _Pragma("unroll") for (int m = 0; m < 4; ++m) _Pragma("unroll") for (int n = 0; n < 2; ++n) _Pragma("unroll") for (int k = 0; k < 2; ++k) \
        acc[ai][bj][m][n] = __builtin_amdgcn_mfma_f32_16x16x32_bf16(Bt[n][k], At[m][k], acc[ai][bj][m][n], 0, 0, 0); __builtin_amdgcn_s_setprio(0); } while (0)
#define PG8_WAIT_V(n) asm volatile("s_waitcnt vmcnt(" #n ")" ::: "memory")
#define PG8_WAIT_L(n) asm volatile("s_waitcnt lgkmcnt(" #n ")" ::: "memory")
#define PG8_BAR __builtin_amdgcn_s_barrier()
#define PG8_SCHED __builtin_amdgcn_sched_barrier(0)
    Unit cur, nxt; int ui = 0;
    if (!S.next(0, cur)) return;
    f32x4 acc[2][2][4][2];
#pragma unroll
    for (int a = 0; a < 2; ++a)
#pragma unroll
        for (int b = 0; b < 2; ++b)
#pragma unroll
            for (int m = 0; m < 4; ++m)
#pragma unroll
                for (int n = 0; n < 2; ++n) acc[a][b][m][n] = (f32x4){0.f, 0.f, 0.f, 0.f};
    bf16x8 At[4][2], B0[2][2], B1[2][2];
    const char* cA = (const char*)g.A + (size_t)cur.pm * tstepA + (size_t)cur.kc * g.kcb; const char* cB = (const char*)g.Bt + (size_t)cur.pn * tstepB + (size_t)cur.kc * g.kcb;
    S.a_ready(cur);
    if constexpr (SP2) {
        PG8_STAGE(PG8_SB(0, 0), cB, voffB); PG8_STAGE(PG8_SB(0, 1), cB + hstepB, voffB); PG8_STAGE(PG8_SA(0, 0), cA, voffA); PG8_STAGE(PG8_SA(0, 1), cA + hstepA, voffA);
        if (wr == 1) PG8_BAR;
        PG8_WAIT_V(2); PG8_BAR;
        PG8_STAGE(PG8_SB(1, 0), cB + kstep, voffB); PG8_STAGE(PG8_SA(1, 0), cA + kstep, voffA); PG8_STAGE(PG8_SB(1, 1), cB + hstepB + kstep, voffB);
        PG8_WAIT_V(6); PG8_BAR;
    } else {
        PG8_STAGE(PG8_SB(0, 0), cB, voffB); PG8_STAGE(PG8_SA(0, 0), cA, voffA); PG8_STAGE(PG8_SB(0, 1), cB + hstepB, voffB); PG8_STAGE(PG8_SA(0, 1), cA + hstepA, voffA);
        if (wr == 1) PG8_BAR;
        PG8_WAIT_V(4); PG8_BAR;
        PG8_STAGE(PG8_SB(1, 0), cB + kstep, voffB); PG8_STAGE(PG8_SA(1, 0), cA + kstep, voffA); PG8_STAGE(PG8_SB(1, 1), cB + hstepB + kstep, voffB);
        PG8_WAIT_V(6); PG8_BAR;
    }
    for (;;) {
        const bool has_next = S.next(ui + 1, nxt);
        float epre[8];
        if constexpr (Epi::PREFETCH) E.prefetch(epre, cur, wr, fr);
        const char* nA = has_next ? (const char*)g.A + (size_t)nxt.pm * tstepA + (size_t)nxt.kc * g.kcb : cA; const char* nB = has_next ? (const char*)g.Bt + (size_t)nxt.pn * tstepB + (size_t)nxt.kc * g.kcb : cB;
_Pragma("unroll 1")
        for (int t = 0; t < nt; t += 2) {
            if constexpr (Epi::MIDSCALE) { if (t == nt / 2) E.midscale(acc, cur, wr, fr); }
            const bool last = (t == nt - 2);
            const char* a1 = cA + (size_t)(t + 1) * kstep;
            const char* a2 = last ? nA : cA + (size_t)(t + 2) * kstep; const char* b2 = last ? nB : cB + (size_t)(t + 2) * kstep;
            const char* a3 = a2 + kstep; const char* b3 = b2 + kstep;
            if (last && has_next) S.a_ready(nxt);
            if constexpr (SP2) {
            PG8_LDB(B0, 0, 0); PG8_LDB(B1, 0, 1); PG8_SCHED; PG8_LDA(At, 0, 0); PG8_STAGE(PG8_SA(1, 1), a1 + hstepA, voffA);
            PG8_WAIT_V(8); PG8_WAIT_L(0); PG8_BAR; PG8_MMA(0, 0, At, B0); PG8_MMA(0, 1, At, B1); PG8_BAR; PG8_SCHED;
            PG8_LDA(At, 0, 1); PG8_STAGE(PG8_SB(0, 0), b2, voffB); PG8_STAGE(PG8_SB(0, 1), b2 + hstepB, voffB); PG8_STAGE(PG8_SA(0, 0), a2, voffA);
            PG8_WAIT_V(8); PG8_WAIT_L(0); PG8_BAR; PG8_MMA(1, 0, At, B0); PG8_MMA(1, 1, At, B1); PG8_BAR; PG8_SCHED;
            PG8_LDB(B0, 1, 0); PG8_LDB(B1, 1, 1); PG8_SCHED; PG8_LDA(At, 1, 0); PG8_STAGE(PG8_SA(0, 1), a2 + hstepA, voffA);
            PG8_WAIT_V(8); PG8_WAIT_L(0); PG8_BAR; PG8_MMA(0, 0, At, B0); PG8_MMA(0, 1, At, B1); PG8_BAR; PG8_SCHED;
            PG8_LDA(At, 1, 1); PG8_STAGE(PG8_SB(1, 0), b3, voffB); PG8_STAGE(PG8_SB(1, 1), b3 + hstepB, voffB); PG8_STAGE(PG8_SA(1, 0), a3, voffA);
            PG8_WAIT_V(8); PG8_WAIT_L(0); PG8_BAR; PG8_MMA(1, 0, At, B0); PG8_MMA(1, 1, At, B1); PG8_BAR; PG8_SCHED;
            } else {
            PG8_LDB(B0, 0, 0); PG8_SCHED; PG8_LDA(At, 0, 0); PG8_STAGE(PG8_SA(1, 1), a1 + hstepA, voffA);
            PG8_WAIT_L(8); PG8_BAR; PG8_WAIT_L(0); PG8_MMA(0, 0, At, B0); PG8_BAR; PG8_SCHED;
            PG8_LDB(B1, 0, 1); PG8_STAGE(PG8_SB(0, 0), b2, voffB);
            PG8_BAR; PG8_WAIT_L(0); PG8_MMA(0, 1, At, B1); PG8_BAR;
            PG8_LDA(At, 0, 1); PG8_STAGE(PG8_SA(0, 0), a2, voffA);
            PG8_BAR; PG8_WAIT_L(0); PG8_MMA(1, 0, At, B0); PG8_BAR; PG8_SCHED;
            PG8_STAGE(PG8_SB(0, 1), b2 + hstepB, voffB);
            PG8_WAIT_V(6); PG8_BAR; PG8_MMA(1, 1, At, B1); PG8_BAR;
            PG8_LDB(B0, 1, 0); PG8_SCHED; PG8_LDA(At, 1, 0); PG8_STAGE(PG8_SA(0, 1), a2 + hstepA, voffA);
            PG8_WAIT_L(8); PG8_BAR; PG8_WAIT_L(0); PG8_MMA(0, 0, At, B0); PG8_BAR; PG8_SCHED;
            PG8_LDB(B1, 1, 1); PG8_STAGE(PG8_SB(1, 0), b3, voffB);
            PG8_BAR; PG8_WAIT_L(0); PG8_MMA(0, 1, At, B1); PG8_BAR;
            PG8_LDA(At, 1, 1); PG8_STAGE(PG8_SA(1, 0), a3, voffA);
            PG8_BAR; PG8_WAIT_L(0); PG8_MMA(1, 0, At, B0); PG8_BAR; PG8_SCHED;
            PG8_STAGE(PG8_SB(1, 1), b3 + hstepB, voffB);
            PG8_WAIT_V(6); PG8_BAR; PG8_MMA(1, 1, At, B1); PG8_BAR;
            }
        }
        if constexpr (ALIGN_EPI) { if (wr == 0) PG8_BAR; }
        if constexpr (!Epi::AFTER_DRAIN) { if constexpr (Epi::PREFETCH) E(acc, cur, wr, wc, fr, fq, epre); else E(acc, cur, wr, wc, fr, fq); S.done(cur); }
        if (!has_next) break;
#pragma unroll
        for (int a = 0; a < 2; ++a)
#pragma unroll
            for (int b = 0; b < 2; ++b)
#pragma unroll
                for (int m = 0; m < 4; ++m)
#pragma unroll
                    for (int n = 0; n < 2; ++n) acc[a][b][m][n] = (f32x4){0.f, 0.f, 0.f, 0.f};
        cur = nxt; cA = nA; cB = nB; ++ui;
        if constexpr (ALIGN_EPI) { if (wr == 1) PG8_BAR; }
    }
    PG8_WAIT_V(0);
    if constexpr (!ALIGN_EPI) { if (wr == 0) PG8_BAR; }
    PG8_BAR;
    if constexpr (Epi::AFTER_DRAIN) { E.fused(acc, cur, wr, wc, fr, fq, lds, wid, lane); S.done(cur); }
#undef PG8_SA
#undef PG8_SB
#undef PG8_STAGE
#undef PG8_LDA
#undef PG8_LDB
#undef PG8_MMA
#undef PG8_WAIT_V
#undef PG8_WAIT_L
#undef PG8_BAR
#undef PG8_SCHED
}
}

#define MFMA32(a, b, c) __builtin_amdgcn_mfma_f32_32x32x16_bf16((a), (b), (c), 0, 0, 0)
__device__ __forceinline__ bf16x8 pack8(const f32x16& p, int b) {
    u32x4 w = (u32x4){pk2(p[b], p[b + 1]), pk2(p[b + 2], p[b + 3]), pk2(p[b + 4], p[b + 5]), pk2(p[b + 6], p[b + 7])};
    return __builtin_bit_cast(bf16x8, w);
}
__device__ __forceinline__ float max3f_(float a, float b, float c) { float r; asm("v_max3_f32 %0, %1, %2, %3" : "=v"(r) : "v"(a), "v"(b), "v"(c)); return r; }
__device__ __forceinline__ float max16(const f32x16& p) {
    float a = max3f_(p[0], p[1], p[2]), b = max3f_(p[3], p[4], p[5]);
    a = max3f_(a, p[6], p[7]); b = max3f_(b, p[8], p[9]); a = max3f_(a, p[10], p[11]); b = max3f_(b, p[12], p[13]);
    return max3f_(a, b, max3f_(p[14], p[15], p[15]));
}
__device__ __forceinline__ bf16x8 cat44(s16x4 a, s16x4 b) { return (bf16x8){a[0], a[1], a[2], a[3], b[0], b[1], b[2], b[3]}; }

struct MlaState { f32x16 o0, o1, negm; float l; };
typedef float f32x2p __attribute__((ext_vector_type(2)));
__device__ __forceinline__ void mla_softmax_pv_prep(MlaState& st, f32x16& p0, f32x16& p1, bf16x8 (&pb)[4], bool first) {
    float mx = fmaxf(max16(p0), max16(p1));
    { auto rr = __builtin_amdgcn_permlane32_swap(__builtin_bit_cast(unsigned, mx), __builtin_bit_cast(unsigned, mx), false, false);
      mx = fmaxf(__builtin_bit_cast(float, rr[0]), __builtin_bit_cast(float, rr[1])); }
    if (first || __any(mx > 8.0f)) {
        const float d = first ? mx : (mx > 8.0f ? mx : 0.f);
#pragma unroll
        for (int r = 0; r < 16; ++r) { p0[r] -= d; p1[r] -= d; st.negm[r] -= d; }
        if (!first) { const float f = __builtin_amdgcn_exp2f(-d); st.l *= f;
#pragma unroll
            for (int r = 0; r < 16; ++r) { st.o0[r] *= f; st.o1[r] *= f; } }
    }
    f32x2p ps = (f32x2p){0.f, 0.f};
#pragma unroll
    for (int r = 0; r < 16; r += 2) {
        p0[r] = __builtin_amdgcn_exp2f(p0[r]); p0[r + 1] = __builtin_amdgcn_exp2f(p0[r + 1]); p1[r] = __builtin_amdgcn_exp2f(p1[r]); p1[r + 1] = __builtin_amdgcn_exp2f(p1[r + 1]);
        ps += (f32x2p){p0[r], p0[r + 1]}; ps += (f32x2p){p1[r], p1[r + 1]};
    }
    st.l += ps[0] + ps[1];
    pb[0] = pack8(p0, 0); pb[1] = pack8(p0, 8); pb[2] = pack8(p1, 0); pb[3] = pack8(p1, 8);
}

constexpr int MLA_KROW = 208, MLA_VROW = 144, MLA_KT = 64 * MLA_KROW  , MLA_STAGE = MLA_KT + 64 * MLA_VROW  ;

__device__ __forceinline__ void mla_prompt_unit(LAS unsigned char* lds, int h, int qb, const bf16_t* __restrict__ Q, const bf16_t* __restrict__ KN, const bf16_t* __restrict__ KPE,
                                                const bf16_t* __restrict__ VT, bf16_t* MERGED, float* ssqa) {
    const int tid = threadIdx.x, lane = tid & 63, w = __builtin_amdgcn_readfirstlane(tid >> 6), r32 = lane & 31, hi = lane >> 5;
    const int q0 = qb * 256 + w * 32;
    bf16x8 qf[6];
    { const bf16_t* qp = Q + (size_t)(q0 + r32) * 768 + h * 96 + hi * 8;
#pragma unroll
      for (int s = 0; s < 6; ++s) qf[s] = *(const bf16x8*)(qp + 16 * s); }
    const int NT = 4 * qb + 4, mylast = 4 * qb + (w >> 1);
    MlaState st; st.l = 0.f;
#pragma unroll
    for (int r = 0; r < 16; ++r) { st.o0[r] = 0.f; st.o1[r] = 0.f; st.negm[r] = 0.f; }
    const int krow = tid >> 3, kch = tid & 7, prow = (tid & 255) >> 2, pch = tid & 3, vd = tid >> 3, vch = tid & 7;
    const bf16_t* ksrc = KN + (size_t)krow * 512 + h * 64 + kch * 8;
    const bf16_t* psrc = KPE + (size_t)prow * 32 + pch * 8;
    const bf16_t* vsrc = VT + (size_t)(h * 64 + vd) * VT_LD + vch * 8;
    const int kdst = krow * MLA_KROW + kch * 16, pdst = prow * MLA_KROW + 128 + pch * 16, vdst = MLA_KT + vd * MLA_VROW + (vch >> 1) * 32 + (vch & 1) * 8;
    u32x4 rk, rp, rv; rp = (u32x4){0, 0, 0, 0};
#define MLA_GLOAD(t) do { rk = *(const u32x4*)(ksrc + (size_t)(t) * 64 * 512); if (tid < 256) rp = *(const u32x4*)(psrc + (size_t)(t) * 64 * 32); rv = *(const u32x4*)(vsrc + (size_t)(t) * 64); } while (0)
#define MLA_LSTORE(b) do { LAS unsigned char* sb_ = lds + (b) * MLA_STAGE; *(LAS u32x4*)(sb_ + kdst) = rk; if (tid < 256) *(LAS u32x4*)(sb_ + pdst) = rp; \
        *(LAS u32x2*)(sb_ + vdst) = (u32x2){rv[0], rv[1]}; *(LAS u32x2*)(sb_ + vdst + 16) = (u32x2){rv[2], rv[3]}; } while (0)
    MLA_GLOAD(0); MLA_LSTORE(0); __syncthreads();
    for (int t = 0; t < NT; ++t) {
        const bool more = (t + 1 < NT);
        if (more) MLA_GLOAD(t + 1);
        if (t <= mylast) {
            const LAS unsigned char* sb = lds + (t & 1) * MLA_STAGE;
            const LAS unsigned char* kb = sb + r32 * MLA_KROW + hi * 16;
            bf16x8 ka[6], kc[6];
#pragma unroll
            for (int s = 0; s < 6; ++s) { ka[s] = *(const LAS bf16x8*)(kb + s * 32); kc[s] = *(const LAS bf16x8*)(kb + 32 * MLA_KROW + s * 32); }
            __builtin_amdgcn_sched_barrier(0);
            f32x16 p0 = st.negm, p1 = st.negm;
#pragma unroll
            for (int s = 0; s < 6; ++s) { p0 = MFMA32(ka[s], qf[s], p0); p1 = MFMA32(kc[s], qf[s], p1); }
            __builtin_amdgcn_sched_barrier(0);
            const LAS unsigned char* vb = sb + MLA_KT + r32 * MLA_VROW + hi * 16;
            bf16x8 va[4], vc[4];
#pragma unroll
            for (int s = 0; s < 4; ++s) {
                va[s] = *(const LAS bf16x8*)(vb + s * 32); vc[s] = *(const LAS bf16x8*)(vb + 32 * MLA_VROW + s * 32);
            }
            __builtin_amdgcn_sched_barrier(0);
            bf16x8 pb[4];
            mla_softmax_pv_prep(st, p0, p1, pb, t == 0);
#pragma unroll
            for (int s = 0; s < 4; ++s) { st.o0 = MFMA32(va[s], pb[s], st.o0); st.o1 = MFMA32(vc[s], pb[s], st.o1); }
        }
        if (more) MLA_LSTORE((t + 1) & 1);
        __syncthreads();
    }
#undef MLA_GLOAD
#undef MLA_LSTORE
    const float l = st.l + __shfl_xor(st.l, 32); const float inv = 1.f / l;
    const int row = q0 + r32; bf16_t* op = MERGED + (size_t)row * DM + h * 64 + 4 * hi; float sq = 0.f;
#pragma unroll
    for (int g = 0; g < 4; ++g) {
        const float a0 = st.o0[4 * g] * inv, a1 = st.o0[4 * g + 1] * inv, a2 = st.o0[4 * g + 2] * inv, a3 = st.o0[4 * g + 3] * inv;
        const float b0 = st.o1[4 * g] * inv, b1 = st.o1[4 * g + 1] * inv, b2 = st.o1[4 * g + 2] * inv, b3 = st.o1[4 * g + 3] * inv;
        *(u32x2*)(op + 8 * g) = (u32x2){pk2(a0, a1), pk2(a2, a3)}; *(u32x2*)(op + 32 + 8 * g) = (u32x2){pk2(b0, b1), pk2(b2, b3)};
        sq += (a0 * a0 + a1 * a1) + (a2 * a2 + a3 * a3) + (b0 * b0 + b1 * b1) + (b2 * b2 + b3 * b3);
    }
    sq += __shfl_xor(sq, 32); if (hi == 0) atomic_addf(ssqa + row, sq);
}

__device__ __forceinline__ void mla_sample_unit(LAS unsigned char* lds, int b, int h, const bf16_t* __restrict__ Q, const bf16_t* __restrict__ KN, const bf16_t* __restrict__ KPE,
                                                const bf16_t* __restrict__ VT, bf16_t* MERGED, float* ssqa) {
    const int tid = threadIdx.x, lane = tid & 63, w = __builtin_amdgcn_readfirstlane(tid >> 6), r32 = lane & 31, hi = lane >> 5;
    const int row = TP + b * 32 + r32;
    bf16x8 qf[6];
    { const bf16_t* qp = Q + (size_t)row * 768 + h * 96 + hi * 8;
#pragma unroll
      for (int s = 0; s < 6; ++s) qf[s] = *(const bf16x8*)(qp + 16 * s); }
    MlaState st; st.l = 0.f;
#pragma unroll
    for (int r = 0; r < 16; ++r) { st.o0[r] = 0.f; st.o1[r] = 0.f; st.negm[r] = 0.f; }
    bf16x8 ka[6], kc[6]; s16x4 va[8], vc[8];
#define MLS_LOAD(t_, KA, KC, VA, VC) do { const size_t kv0_ = (size_t)b * SKV + (t_) * 64; \
        const bf16_t* kp_ = KN + (kv0_ + r32) * 512 + h * 64 + hi * 8; const bf16_t* pp_ = KPE + (kv0_ + r32) * 32 + hi * 8; \
        _Pragma("unroll") for (int s_ = 0; s_ < 4; ++s_) { KA[s_] = *(const bf16x8*)(kp_ + 16 * s_); KC[s_] = *(const bf16x8*)(kp_ + 32 * 512 + 16 * s_); } \
        _Pragma("unroll") for (int s_ = 0; s_ < 2; ++s_) { KA[4 + s_] = *(const bf16x8*)(pp_ + 16 * s_); KC[4 + s_] = *(const bf16x8*)(pp_ + 32 * 32 + 16 * s_); } \
        const bf16_t* vp_ = VT + (size_t)(h * 64 + r32) * VTS_LD + kv0_ + 4 * hi; \
        _Pragma("unroll") for (int s_ = 0; s_ < 4; ++s_) { VA[2 * s_] = *(const s16x4*)(vp_ + 16 * s_); VA[2 * s_ + 1] = *(const s16x4*)(vp_ + 16 * s_ + 8); \
            VC[2 * s_] = *(const s16x4*)(vp_ + (size_t)32 * VTS_LD + 16 * s_); VC[2 * s_ + 1] = *(const s16x4*)(vp_ + (size_t)32 * VTS_LD + 16 * s_ + 8); } } while (0)
    for (int t = w; t < 33; t += 8) {
        MLS_LOAD(t, ka, kc, va, vc);
        __builtin_amdgcn_sched_barrier(0);
        f32x16 p0 = st.negm, p1 = st.negm;
        const bool tail = (t == 32);
#pragma unroll
        for (int s = 0; s < 6; ++s) { p0 = MFMA32(ka[s], qf[s], p0); if (!tail) p1 = MFMA32(kc[s], qf[s], p1); }
        if (tail) {
#pragma unroll
            for (int r = 0; r < 16; ++r) p1[r] = -1e30f;
        }
        bf16x8 pb[4];
        mla_softmax_pv_prep(st, p0, p1, pb, t == w);
#pragma unroll
        for (int s = 0; s < 4; ++s) {
            if (tail && s >= 2) break;
            st.o0 = MFMA32(cat44(va[2 * s], va[2 * s + 1]), pb[s], st.o0); st.o1 = MFMA32(cat44(vc[2 * s], vc[2 * s + 1]), pb[s], st.o1);
        }
    }
#undef MLS_LOAD
    LAS float* Lm = (LAS float*)lds; LAS float* Ll = Lm + 512; LAS float* LO = Lm + 1024;
    const float mref = -st.negm[0];
    Lm[w * 64 + lane] = mref;
    __syncthreads();
    float M = Lm[lane];
#pragma unroll
    for (int k = 1; k < 8; ++k) M = fmaxf(M, Lm[k * 64 + lane]);
    const float f = __builtin_amdgcn_exp2f(mref - M);
    Ll[w * 64 + lane] = st.l * f;
#pragma unroll
    for (int r = 0; r < 16; ++r) { LO[(w * 32 + r) * 64 + lane] = st.o0[r] * f; LO[(w * 32 + 16 + r) * 64 + lane] = st.o1[r] * f; }
    __syncthreads();
    float l = 0.f;
#pragma unroll
    for (int k = 0; k < 8; ++k) l += Ll[k * 64 + lane] + Ll[k * 64 + (lane ^ 32)];
    const float inv = 1.f / l;
    float v[4];
#pragma unroll
    for (int i = 0; i < 4; ++i) { float s = 0.f;
#pragma unroll
        for (int k = 0; k < 8; ++k) s += LO[(k * 32 + 4 * w + i) * 64 + lane];
        v[i] = s * inv; }
    *(u32x2*)(MERGED + (size_t)row * DM + h * 64 + 32 * (w >> 2) + 8 * (w & 3) + 4 * hi) = (u32x2){pk2(v[0], v[1]), pk2(v[2], v[3])};
    float sq = (v[0] * v[0] + v[1] * v[1]) + (v[2] * v[2] + v[3] * v[3]);
    sq += __shfl_xor(sq, 32); if (hi == 0) atomic_addf(ssqa + row, sq);
    __syncthreads();
}

template <class QF, class KF, class VF, class MID>
__device__ __forceinline__ void xattn_wave(QF qfrag, bf16_t* orow  , KF kfrag, VF vfrag, MID mid) {
    bf16x8 pb[16];
    float inv;
    {
        f32x16 S[4][2];
#pragma unroll
        for (int kt = 0; kt < 4; ++kt)
#pragma unroll
            for (int r = 0; r < 16; ++r) { S[kt][0][r] = 0.f; S[kt][1][r] = 0.f; }
#pragma unroll
        for (int s = 0; s < 16; ++s) {
            const bf16x8 qf = qfrag(s);
#pragma unroll
            for (int kt = 0; kt < 4; ++kt) { S[kt][0] = MFMA32(kfrag(kt, 0, s), qf, S[kt][0]); S[kt][1] = MFMA32(kfrag(kt, 1, s), qf, S[kt][1]); }
        }
        float mx = -1e30f;
#pragma unroll
        for (int kt = 0; kt < 4; ++kt) mx = fmaxf(mx, fmaxf(max16(S[kt][0]), max16(S[kt][1])));
        mx = fmaxf(mx, __shfl_xor(mx, 32));
        float l = 0.f;
#pragma unroll
        for (int kt = 0; kt < 4; ++kt) {
#pragma unroll
            for (int r = 0; r < 16; ++r) { S[kt][0][r] = __builtin_amdgcn_exp2f(S[kt][0][r] - mx); S[kt][1][r] = __builtin_amdgcn_exp2f(S[kt][1][r] - mx); l += S[kt][0][r] + S[kt][1][r]; }
            pb[4 * kt] = pack8(S[kt][0], 0); pb[4 * kt + 1] = pack8(S[kt][0], 8); pb[4 * kt + 2] = pack8(S[kt][1], 0); pb[4 * kt + 3] = pack8(S[kt][1], 8);
        }
        l += __shfl_xor(l, 32); inv = 1.f / l;
    }
    mid();
#pragma unroll 1
    for (int db = 0; db < 8; ++db) {
        f32x16 o;
#pragma unroll
        for (int r = 0; r < 16; ++r) o[r] = 0.f;
        bf16x8 vf[16];
#pragma unroll
        for (int s = 0; s < 16; ++s) vf[s] = vfrag(db, s);
        __builtin_amdgcn_sched_barrier(0);
#pragma unroll
        for (int s = 0; s < 16; ++s) o = MFMA32(vf[s], pb[s], o);
#pragma unroll
        for (int g = 0; g < 4; ++g)
            *(u32x2*)(orow + 32 * db + 8 * g) = (u32x2){pk2(o[4 * g] * inv, o[4 * g + 1] * inv), pk2(o[4 * g + 2] * inv, o[4 * g + 3] * inv)};
    }
}

constexpr int XA_KROW = 528, XA_VROW = 528;
__device__ __forceinline__ void xattn_unit(LAS unsigned char* lds, int rowbase, bool single, int h, bf16_t* QM, const bf16_t* __restrict__ MKB, const bf16_t* __restrict__ MVTB, const float* __restrict__ QACC, const float* __restrict__ ssq2) {
    const int tid = threadIdx.x, lane = tid & 63, w = __builtin_amdgcn_readfirstlane(tid >> 6), r32 = lane & 31, hi = lane >> 5;
#pragma unroll 4
    for (int it = 0; it < 16; ++it) { const int idx = it * 512 + tid, rw = idx >> 5, ch = idx & 31;
        *(LAS u32x4*)(lds + rw * XA_KROW + ch * 16) = *(const u32x4*)(MKB + (size_t)rw * DM + h * 256 + ch * 8); }
    __syncthreads();
    const int row = rowbase + (single ? 0 : w * 32) + r32;
    const LAS unsigned char* kb = lds + r32 * XA_KROW + hi * 16;
    const LAS unsigned char* vb = lds + r32 * XA_VROW + hi * 16;
    auto kfrag = [&](int kt, int half, int s) -> bf16x8 { return *(const LAS bf16x8*)(kb + (kt * 64 + half * 32) * XA_KROW + s * 32); };
    auto vfrag = [&](int db, int s) -> bf16x8 { return *(const LAS bf16x8*)(vb + db * 32 * XA_VROW + s * 32); };
    auto mid = [&]() {
        __syncthreads();
#pragma unroll 4
        for (int it = 0; it < 16; ++it) { const int idx = it * 512 + tid, d = idx >> 5, ch = idx & 31;
            const u32x4 v = *(const u32x4*)(MVTB + (size_t)(h * 256 + d) * 256 + ch * 8);
            LAS unsigned char* dp = lds + d * XA_VROW + (ch >> 1) * 32 + (ch & 1) * 8;
            *(LAS u32x2*)dp = (u32x2){v[0], v[1]}; *(LAS u32x2*)(dp + 16) = (u32x2){v[2], v[3]}; }
        __syncthreads();
    };
    if (!single) {
        const bf16_t* qrow = QM + (size_t)row * DM + h * 256 + hi * 8;
        auto qfrag = [&](int s) -> bf16x8 { return *(const bf16x8*)(qrow + 16 * s); };
        xattn_wave(qfrag, QM + (size_t)row * DM + h * 256 + 4 * hi, kfrag, vfrag, mid);
    } else if (w == 0) {
        const float* qrow = QACC + (size_t)(row - TP) * DM + h * 256 + hi * 8; const float sc = XSCALE * __builtin_amdgcn_rsqf(ssq2[row] * (1.0f / 1024.0f) + EPS);
        auto qfrag = [&](int s) -> bf16x8 { const f32x4 a = *(const f32x4*)(qrow + 16 * s) * sc, b = *(const f32x4*)(qrow + 16 * s + 4) * sc;
            return __builtin_bit_cast(bf16x8, (u32x4){pk2(a[0], a[1]), pk2(a[2], a[3]), pk2(b[0], b[1]), pk2(b[2], b[3])}); };
        xattn_wave(qfrag, QM + (size_t)row * DM + h * 256 + 4 * hi, kfrag, vfrag, mid);
    } else mid();
    __syncthreads();
}
struct LruArgs { const bf16_t* XBR; const float* conv_w; const float* conv_b; const float* wa; const float* ba; const float* wx; const float* bx; const float* lam;
                 const float* state_conv; const float* state_lru; bf16_t* HLOC; bf16_t* ACUM; float* ATOT; float* BTOT; float* out; };
__device__ __forceinline__ void lru_l1_unit(LAS unsigned char* lds, int unit, const LruArgs& A) {
    const int c = threadIdx.x, g = __builtin_amdgcn_readfirstlane(c >> 6), j = c & 63, r32 = j & 31, hi = j >> 5;
    const bool samp = unit >= 256; const int b = unit - 256;
    const int row0 = samp ? TP + b * 32 : unit * 64; const int nt = samp ? 32 : 64;
    constexpr int XROW = 1040;
    LAS unsigned char* XCB = lds;
    LAS unsigned* PRE = (LAS unsigned*)(lds + 64 * XROW);
    const float w0 = A.conv_w[c], w1 = A.conv_w[512 + c], w2 = A.conv_w[1024 + c], w3 = A.conv_w[1536 + c], cb = A.conv_b[c];
    float xm3, xm2, xm1;
    if (samp) { xm3 = A.state_conv[(b * 3 + 0) * 512 + c]; xm2 = A.state_conv[(b * 3 + 1) * 512 + c]; xm1 = A.state_conv[(b * 3 + 2) * 512 + c]; }
    else if (unit > 0) { xm3 = bf2f(A.XBR[(size_t)(row0 - 3) * 512 + c]); xm2 = bf2f(A.XBR[(size_t)(row0 - 2) * 512 + c]); xm1 = bf2f(A.XBR[(size_t)(row0 - 1) * 512 + c]); }
    else { xm3 = 0.f; xm2 = 0.f; xm1 = 0.f; }
    {
        unsigned short xraw[64];
#pragma unroll
        for (int t = 0; t < 64; ++t) xraw[t] = (t < nt) ? A.XBR[(size_t)(row0 + t) * 512 + c] : (unsigned short)0;
#pragma unroll
        for (int t = 0; t < 64; ++t) {
            if (t < nt) {
                const float x0 = bf2f(xraw[t]);
                *(LAS bf16_t*)(XCB + t * XROW + c * 2) = (bf16_t)f2bf(cb + w0 * xm3 + w1 * xm2 + w2 * xm1 + w3 * x0);
                xm3 = xm2; xm2 = xm1; xm1 = x0;
            }
        }
    }
    bf16x8 bw[4][4];
#pragma unroll
    for (int nb = 0; nb < 4; ++nb)
#pragma unroll
        for (int ks = 0; ks < 4; ++ks) {
            const float* W = ((nb < 2) ? A.wa : A.wx) + g * 4096 + (16 * ks) * 64 + (nb & 1) * 32;
            const float* Wl = W + (8 * hi) * 64 + r32;
            bw[nb][ks] = __builtin_bit_cast(bf16x8, (u32x4){pk2(Wl[0], Wl[64]), pk2(Wl[128], Wl[192]), pk2(Wl[256], Wl[320]), pk2(Wl[384], Wl[448])});
        }
    const float bav = A.ba[c], bxv = A.bx[c];
    const float lamv = A.lam[c]; const float sp = log1pf(__expf(-lamv));
    float h = samp ? A.state_lru[b * 512 + c] : 0.f, Ac = 1.f;
    asm volatile("s_waitcnt lgkmcnt(0)" ::: "memory");
    for (int mb = 0; mb < (nt >> 5); ++mb) {
        f32x16 C0, C1, C2, C3;
#pragma unroll
        for (int r = 0; r < 16; ++r) { C0[r] = 0.f; C1[r] = 0.f; C2[r] = 0.f; C3[r] = 0.f; }
#pragma unroll
        for (int ks = 0; ks < 4; ++ks) {
            const bf16x8 a = *(const LAS bf16x8*)(XCB + (32 * mb + r32) * XROW + (g * 64 + 16 * ks + 8 * hi) * 2);
            C0 = MFMA32(a, bw[0][ks], C0); C1 = MFMA32(a, bw[1][ks], C1); C2 = MFMA32(a, bw[2][ks], C2); C3 = MFMA32(a, bw[3][ks], C3);
        }
#pragma unroll
        for (int r = 0; r < 16; ++r) { const int tl = (r & 3) + 8 * (r >> 2) + 4 * hi;
            PRE[tl * 512 + g * 64 + r32] = f2bf(C0[r]) | (f2bf(C2[r]) << 16); PRE[tl * 512 + g * 64 + 32 + r32] = f2bf(C1[r]) | (f2bf(C3[r]) << 16); }
        asm volatile("s_waitcnt lgkmcnt(0)" ::: "memory");
#pragma unroll 4
        for (int tl = 0; tl < 32; ++tl) {
            const int t = 32 * mb + tl;
            const unsigned u = PRE[tl * 512 + c];
            const float ra = __builtin_bit_cast(float, u << 16) + bav, ri = __builtin_bit_cast(float, u & 0xffff0000u) + bxv;
            const float xcv = bf2f(*(const LAS bf16_t*)(XCB + t * XROW + c * 2));
            const float rg = __builtin_amdgcn_rcpf(1.f + __builtin_amdgcn_exp2f(-LOG2E * ra)), ig = __builtin_amdgcn_rcpf(1.f + __builtin_amdgcn_exp2f(-LOG2E * ri));
            const float a = __builtin_amdgcn_exp2f((-8.0f * LOG2E) * rg * sp);
            const float bt = __builtin_amdgcn_sqrtf(fmaxf(1.f - a * a, 0.f)) * ig * xcv;
            h = a * h + bt; Ac *= a;
            A.HLOC[(size_t)(row0 + t) * 512 + c] = (bf16_t)f2bf(h); A.ACUM[(size_t)(row0 + t) * 512 + c] = (bf16_t)f2bf(Ac);
        }
        asm volatile("s_waitcnt lgkmcnt(0)" ::: "memory");
    }
    A.ATOT[unit * 512 + c] = Ac; A.BTOT[unit * 512 + c] = h;
    if (samp) A.out[O_LRUS + b * 512 + c] = h;
    __syncthreads();
}
__device__ __forceinline__ void lru_l3_unit(LAS unsigned char* lds, int unit, const bf16_t* __restrict__ HLOC, const bf16_t* __restrict__ ACUM, const bf16_t* __restrict__ GG,
                                            const float* __restrict__ ATOT, const float* __restrict__ BTOT, const float* __restrict__ gain, bf16_t* MERGED, float* out) {
    const int c = threadIdx.x, lane = c & 63, w = __builtin_amdgcn_readfirstlane(c >> 6);
    const bool samp = unit >= 256; const int row0 = samp ? TP + (unit - 256) * 32 : unit * 64; const int nt = samp ? 32 : 64;
    LAS float* HIN = (LAS float*)lds;
    float H = 0.f;
    if (!samp) {
#pragma unroll 32
        for (int k = 0; k < unit; ++k) H = ATOT[k * 512 + c] * H + BTOT[k * 512 + c];
        if (unit == 255) out[O_LRUP + c] = ATOT[255 * 512 + c] * H + BTOT[255 * 512 + c];
    }
    HIN[c] = H;
    __syncthreads();
    float hin[8], gn[8];
#pragma unroll
    for (int k = 0; k < 8; ++k) { hin[k] = HIN[lane * 8 + k]; gn[k] = gain[lane * 8 + k]; }
    for (int t0 = w; t0 < nt; t0 += 32) {
        u32x4 hl[4], ac[4], gg[4];
#pragma unroll
        for (int q = 0; q < 4; ++q) { const size_t off = (size_t)(row0 + t0 + 8 * q) * 512 + lane * 8;
            hl[q] = *(const u32x4*)(HLOC + off); ac[q] = *(const u32x4*)(ACUM + off); gg[q] = *(const u32x4*)(GG + off); }
#pragma unroll
        for (int q = 0; q < 4; ++q) {
            float v[8]; float sq = 0.f;
#pragma unroll
            for (int k = 0; k < 4; ++k) {
                const float h0 = __builtin_bit_cast(float, hl[q][k] << 16) + __builtin_bit_cast(float, ac[q][k] << 16) * hin[2 * k];
                const float h1 = __builtin_bit_cast(float, hl[q][k] & 0xffff0000u) + __builtin_bit_cast(float, ac[q][k] & 0xffff0000u) * hin[2 * k + 1];
                v[2 * k] = __builtin_bit_cast(float, gg[q][k] << 16) * h0; v[2 * k + 1] = __builtin_bit_cast(float, gg[q][k] & 0xffff0000u) * h1;
                sq += v[2 * k] * v[2 * k] + v[2 * k + 1] * v[2 * k + 1];
            }
            const float rs = __builtin_amdgcn_rsqf(wave_sum(sq) * (1.0f / 512.0f) + EPS);
            *(u32x4*)(MERGED + (size_t)(row0 + t0 + 8 * q) * DM + 512 + lane * 8) =
                (u32x4){pk2(v[0] * rs * gn[0], v[1] * rs * gn[1]), pk2(v[2] * rs * gn[2], v[3] * rs * gn[3]), pk2(v[4] * rs * gn[4], v[5] * rs * gn[5]), pk2(v[6] * rs * gn[6], v[7] * rs * gn[7])};
        }
    }
    __syncthreads();
}

__device__ __forceinline__ void sample_finalize_part(int part, const float* __restrict__ xs_old, const float* __restrict__ ACC, float* xs_new, bf16_t* XBs, float* ssq_s, unsigned* flag) {
    const int lane = threadIdx.x & 63, w = __builtin_amdgcn_readfirstlane(threadIdx.x >> 6);
    const int r0 = part * 32 + w * 4;
    f32x4 v[4][4];
#pragma unroll
    for (int q = 0; q < 4; ++q)
#pragma unroll
        for (int j = 0; j < 4; ++j) v[q][j] = *((const f32x4*)(xs_old + (size_t)(r0 + q) * DM) + lane + 64 * j) + *((const f32x4*)(ACC + (size_t)(r0 + q) * DM) + lane + 64 * j);
#pragma unroll
    for (int q = 0; q < 4; ++q) {
        float s = 0.f;
#pragma unroll
        for (int j = 0; j < 4; ++j) s += (v[q][j][0] * v[q][j][0] + v[q][j][1] * v[q][j][1]) + (v[q][j][2] * v[q][j][2] + v[q][j][3] * v[q][j][3]);
        s = wave_sum(s); if (lane == 0) ssq_s[r0 + q] = s;
#pragma unroll
        for (int j = 0; j < 4; ++j) { *((f32x4*)(xs_new + (size_t)(r0 + q) * DM) + lane + 64 * j) = v[q][j]; *((u32x2*)(XBs + (size_t)(r0 + q) * DM) + lane + 64 * j) = (u32x2){pk2(v[q][j][0], v[q][j][1]), pk2(v[q][j][2], v[q][j][3])}; }
    }
    asm volatile("s_waitcnt vmcnt(0)" ::: "memory");
    __syncthreads();
    if (threadIdx.x == 0) { __builtin_amdgcn_fence(__ATOMIC_RELEASE, "agent"); asm volatile("s_waitcnt vmcnt(0)" ::: "memory"); __hip_atomic_fetch_add(flag, 1u, __ATOMIC_RELAXED, __HIP_MEMORY_SCOPE_AGENT); }
}
__device__ __forceinline__ void sample_wait(unsigned* flag, unsigned want) {
    if (threadIdx.x == 0) { while (__hip_atomic_load(flag, __ATOMIC_RELAXED, __HIP_MEMORY_SCOPE_AGENT) < want) __builtin_amdgcn_s_sleep(2);
        __builtin_amdgcn_fence(__ATOMIC_ACQUIRE, "agent"); asm volatile("s_waitcnt vmcnt(0)" ::: "memory"); }
    __syncthreads();
}

__device__ __forceinline__ void tr_item(const float* __restrict__ W, int N, int k0, int n0, bf16_t* WT, int drow0, int ldd, const float* gain, LAS float* scr, int lane) {
    float tv[32];
#pragma unroll
    for (int i = 0; i < 32; ++i) tv[i] = W[(size_t)(k0 + 2 * i + (lane >> 5)) * N + n0 + (lane & 31)];
#pragma unroll
    for (int i = 0; i < 32; ++i) { const int kk = 2 * i + (lane >> 5); float v = tv[i]; if (gain) v *= gain[k0 + kk]; scr[kk * 33 + (lane & 31)] = v; }
    asm volatile("s_waitcnt lgkmcnt(0)" ::: "memory");
    const int cc = lane & 7;
#pragma unroll
    for (int jj = 0; jj < 4; ++jj) { const int n = (lane >> 3) + 8 * jj; const LAS float* s = scr + (8 * cc) * 33 + n;
        u32x4 o; o.x = pk2(s[0 * 33], s[1 * 33]); o.y = pk2(s[2 * 33], s[3 * 33]); o.z = pk2(s[4 * 33], s[5 * 33]); o.w = pk2(s[6 * 33], s[7 * 33]);
        *(u32x4*)(WT + (size_t)(drow0 + n) * ldd + k0 + 8 * cc) = o; }
    asm volatile("s_waitcnt lgkmcnt(0)" ::: "memory");
}

#define XB_TMO      128
#define XB_XCNT(j)  (256  + 64 * (j))
#define XB_XSUB(j)  (1280 + 64 * (j))
#define XB_XGEN(j)  (2304 + 64 * (j))
#define XB_TOP      3328
#define XB_TOPGEN   3392
#define XCD_BAR_WORDS 3456
#define XB_SPIN_CAP (1u << 18)

__device__ __forceinline__ unsigned xb_ld(unsigned* p)              { return __hip_atomic_load(p, __ATOMIC_RELAXED, __HIP_MEMORY_SCOPE_AGENT); }
__device__ __forceinline__ unsigned xb_add(unsigned* p, unsigned v) { return __hip_atomic_fetch_add(p, v, __ATOMIC_RELAXED, __HIP_MEMORY_SCOPE_AGENT); }
__device__ __forceinline__ unsigned xb_xcc_id() { return (unsigned)__builtin_amdgcn_s_getreg((3 << 11) | 20) & 0xFu; }
#define XB_SPIN(cond, bar) do { unsigned _sp = 0; while (cond) { __builtin_amdgcn_s_sleep(1); \
    if ((++_sp & 255u) == 0u) { if (xb_ld(&(bar)[XB_TMO])) break; if (_sp > XB_SPIN_CAP) { atomicAdd(&(bar)[XB_TMO], 1u); break; } } } } while (0)

struct XcdBarrier {
    unsigned* bar; unsigned x;
    volatile LAS unsigned* st;
};

__device__ __forceinline__ XcdBarrier xcd_barrier_post(unsigned* bar, volatile LAS unsigned* st) {
    XcdBarrier b; b.bar = bar; b.x = xb_xcc_id(); b.st = st;
    if (threadIdx.x == 0) (void)xb_add(&bar[XB_XCNT(b.x)], 1u);
    return b;
}
__device__ __forceinline__ void xcd_barrier_complete(unsigned* bar, unsigned x, unsigned& nloc, unsigned& nx) {
    const unsigned G = gridDim.x * gridDim.y * gridDim.z;
    unsigned sum, cnt, mine, sp = 0u;
    for (;;) {
        sum = 0u; cnt = 0u; mine = 0u;
#pragma unroll
        for (unsigned j = 0; j < 16; ++j) { const unsigned c = xb_ld(&bar[XB_XCNT(j)]); sum += c; cnt += (c > 0u) ? 1u : 0u; mine = (j == x) ? c : mine; }
        if (sum == G) break;
        __builtin_amdgcn_s_sleep(1);
        if ((++sp & 255u) == 0u) { if (xb_ld(&bar[XB_TMO])) break; if (sp > XB_SPIN_CAP) { atomicAdd(&bar[XB_TMO], 1u); break; } }
    }
    nloc = mine > 0u ? mine : 1u; nx = cnt > 0u ? cnt : 1u;
}

__device__ __forceinline__ void xcd_barrier(const XcdBarrier& b) {
    asm volatile("s_waitcnt vmcnt(0)" ::: "memory");
    __syncthreads();
    if (threadIdx.x == 0) {
        unsigned* bar = b.bar;
        __builtin_amdgcn_s_waitcnt(0);
        unsigned nloc = b.st[0], nx = b.st[1];
        if (nloc == 0u) { xcd_barrier_complete(bar, b.x, nloc, nx); b.st[0] = nloc; b.st[1] = nx; }
        const unsigned old = xb_add(&bar[XB_XSUB(b.x)], 1u);
        const unsigned gen = old / nloc;
        if (old + 1u == (gen + 1u) * nloc) {
            __builtin_amdgcn_fence(__ATOMIC_RELEASE, "agent");
            asm volatile("s_waitcnt vmcnt(0)" ::: "memory");
            const unsigned og = xb_add(&bar[XB_TOP], 1u);
            const unsigned tg = og / nx;
            if (og + 1u == (tg + 1u) * nx) xb_add(&bar[XB_TOPGEN], 1u);
            else XB_SPIN(xb_ld(&bar[XB_TOPGEN]) == tg, bar);
            __builtin_amdgcn_fence(__ATOMIC_ACQUIRE, "agent");
            xb_add(&bar[XB_XGEN(b.x)], 1u);
            asm volatile("s_waitcnt vmcnt(0)" ::: "memory");
        } else {
            XB_SPIN(xb_ld(&bar[XB_XGEN(b.x)]) == gen, bar);
            __builtin_amdgcn_fence(__ATOMIC_ACQUIRE, "agent");
            asm volatile("s_waitcnt vmcnt(0)" ::: "memory");
        }
    }
    __syncthreads();
}

constexpr int NPHASE = 13;
struct Args { const float* in[40]; float* out; unsigned char* ws; int ph_lo, ph_hi; };
enum { I_XP = 0, I_XS, I_MEM, I_CCKV, I_CKPE, I_SCONV, I_SLRU, I_CMK, I_CMV, I_F1N, I_F1W1, I_F1W3, I_F1W2, I_MIXN, I_WIN, I_QN, I_WUQ, I_KVN, I_WUKV, I_CONVW, I_CONVB,
       I_LWA, I_LBA, I_LWX, I_LBX, I_LAM, I_AON, I_LON, I_WOUT, I_MEMN, I_XAN, I_WMQ, I_WMK, I_WMV, I_WMO, I_F2N, I_F2W1, I_F2W3, I_F2W2, I_FINN };

#define ssq0 ((float*)(ws + WS_SSQ))
#define ssq1 ((float*)(ws + WS_SSQ) + 1 * MT)
#define ssq2 ((float*)(ws + WS_SSQ) + 2 * MT)
#define ssq3 ((float*)(ws + WS_SSQ) + 3 * MT)
#define ssq4 ((float*)(ws + WS_SSQ) + 4 * MT)
#define ssqq ((float*)(ws + WS_SSQ) + 5 * MT)
#define ssqa ((float*)(ws + WS_SSQ) + 6 * MT)
#define W13_1 ((bf16_t*)(ws + WS_W13_1))
#define W2_1 ((bf16_t*)(ws + WS_W2_1))
#define W13_2 ((bf16_t*)(ws + WS_W13_2))
#define W2_2 ((bf16_t*)(ws + WS_W2_2))
#define WIN ((bf16_t*)(ws + WS_WIN))
#define WUQ ((bf16_t*)(ws + WS_WUQ))
#define WK ((bf16_t*)(ws + WS_WK))
#define WV ((bf16_t*)(ws + WS_WV))
#define WOUT ((bf16_t*)(ws + WS_WOUT))
#define WMQ ((bf16_t*)(ws + WS_WMQ))
#define WMKV ((bf16_t*)(ws + WS_WMKV))
#define WMO ((bf16_t*)(ws + WS_WMO))
#define MEMB ((bf16_t*)(ws + WS_MEMB))
#define MKB ((bf16_t*)(ws + WS_MKB))
#define MVTB ((bf16_t*)(ws + WS_MVTB))
#define MVB ((bf16_t*)(ws + WS_MVB))
#define CMKB ((bf16_t*)(ws + WS_CMKB))
#define CMVTB ((bf16_t*)(ws + WS_CMVTB))
#define XB ((bf16_t*)(ws + WS_XB))
#define HLOC ((bf16_t*)(out + O_Y))
#define ACUM ((bf16_t*)(out + O_Y) + (size_t)MT * 512)
#define HID ((bf16_t*)(ws + WS_HID))
#define CQ ((bf16_t*)(ws + WS_CQ))
#define CKVP ((bf16_t*)(ws + WS_CKVP))
#define CKVS ((bf16_t*)(ws + WS_CKVS))
#define XBR ((bf16_t*)(ws + WS_XBR))
#define MERGED ((bf16_t*)(ws + WS_MERGED))
#define GG ((bf16_t*)(ws + WS_GG))
#define Q ((bf16_t*)(ws + WS_Q))
#define KNP ((bf16_t*)(ws + WS_KNP))
#define KNS ((bf16_t*)(ws + WS_KNS))
#define VTP ((bf16_t*)(ws + WS_VTP))
#define VTS (((bf16_t*)(ws + WS_VTP)) + TP)
#define KPEP ((bf16_t*)(ws + WS_KPEP))
#define KPES ((bf16_t*)(ws + WS_KPES))
#define QM ((bf16_t*)(ws + WS_QM))
#define ATOT ((float*)(ws + WS_ATOT))
#define ACCB(i) ((float*)(ws + WS_ACC) + (size_t)(i) * TS * DM)
#define FLAGW(i) ((unsigned*)(ws + WS_BAR) + 3584 + 64 * (i))
#define XSA ((float*)(ws + WS_XSA))
#define XSB ((float*)(ws + WS_XSB))
#define BTOT ((float*)(ws + WS_BTOT))
__global__ void __launch_bounds__(NTHR, 2) mk_fwd(Args a) {
    extern __shared__ __attribute__((aligned(16))) unsigned char lds_raw[];
    LAS unsigned char* lds = (LAS unsigned char*)lds_raw;
    cg::grid_group grid = cg::this_grid();
    const int wave = __builtin_amdgcn_readfirstlane((int)threadIdx.x >> 6);
#define tid ((int)threadIdx.x)
#define lane ((int)threadIdx.x & 63)
    const __attribute__((address_space(4))) char* kargp = (const __attribute__((address_space(4))) char*)__builtin_amdgcn_kernarg_segment_ptr();
#define INP(i) (*(const float* const volatile __attribute__((address_space(4)))*)(kargp + 8 * (i)))
#define out (*(float* const volatile __attribute__((address_space(4)))*)(kargp + 320))
#define ws (*(unsigned char* const volatile __attribute__((address_space(4)))*)(kargp + 328))
#define lo (*(const volatile int __attribute__((address_space(4)))*)(kargp + 336))
#define hi (*(const volatile int __attribute__((address_space(4)))*)(kargp + 340))
#define G ((int)gridDim.x)
#define blk ((int)blockIdx.x)
#define vcu ((G % 8 == 0) ? (blk % 8) * (G / 8) + blk / 8 : blk)
#define gw (blk * NWAVE + wave)
#define NGW (G * NWAVE)
#define gtid ((size_t)blk * NTHR + tid)
#define NGT ((size_t)G * NTHR)
#define X (out + O_Y)
#ifndef PHMASK
#define PHMASK 0x1FFF
#endif
#define IN(k) (((PHMASK >> (k)) & 1) && lo <= (k) && (k) < hi)
    volatile LAS unsigned* xst = (volatile LAS unsigned*)(lds + LDS_EPI + 8192);
    if (tid == 0) { xst[0] = 0u; xst[1] = 0u; }
    __syncthreads();
    { XcdBarrier b0 = xcd_barrier_post((unsigned*)(ws + WS_BAR), xst); (void)b0; }
    if (hi > 1000) grid.sync();
#define SEAM(k) do { if (IN(k) && IN((k) + 1)) { XcdBarrier b_; b_.bar = (unsigned*)(ws + WS_BAR); b_.x = xb_xcc_id(); b_.st = xst; xcd_barrier(b_); } } while (0)

    constexpr int I_FFN = 16 * 88, I_W2 = 44 * 32, I_IN = 16 * 53, I_UQ = 6 * 24, I_UKV = 4 * 32, I_SQ = 16 * 32, I_CMVI = 8 * 128;
    constexpr int NITEMS = 4 * I_FFN + 2 * I_W2 + I_IN + I_UQ + I_UKV + 5 * I_SQ + I_CMVI, NA = 2 * I_FFN + 2 * I_SQ;
    auto do_item = [&](int it) {
        LAS float* scr = (LAS float*)(lds + wave * 16384);
        int r = it;
#define TRJ(NI, W, K_, N_, DST, LDD, GAIN, MAP) if (r < (NI)) { const int nb_ = (N_) / 32, kb = r / nb_, n0 = (r % nb_) * 32; tr_item((W), (N_), kb * 64, n0, (DST), (MAP), (LDD), (GAIN), scr, lane); return; } r -= (NI)
        TRJ(I_FFN, INP(I_F1W1), 1024, FF, W13_1, 1024, INP(I_F1N), (n0 >> 7) * 256 + (n0 & 127));
        TRJ(I_FFN, INP(I_F1W3), 1024, FF, W13_1, 1024, INP(I_F1N), (n0 >> 7) * 256 + 128 + (n0 & 127));
        TRJ(I_SQ, INP(I_WMK), 1024, 1024, WMKV, 1024, (const float*)nullptr, n0);
        TRJ(I_SQ, INP(I_WMV), 1024, 1024, WMKV, 1024, (const float*)nullptr, 1024 + n0);
        TRJ(I_W2, INP(I_F1W2), FF, 1024, W2_1, FF, (const float*)nullptr, n0);
        TRJ(I_IN, INP(I_WIN), 1024, 1696, WIN, 1024, INP(I_MIXN), (n0 < 384 ? 256 + n0 : (n0 < 640 ? n0 - 384 : (n0 < 672 ? n0 : n0 + 96))));
        TRJ(I_UQ, INP(I_WUQ), 384, 768, WUQ, 384, INP(I_QN), n0);
        TRJ(I_UKV, INP(I_WUKV), 256, 1024, WK, 256, (const float*)nullptr, ((n0 & 127) < 64 ? (n0 >> 7) * 64 + (n0 & 127) : 512 + (n0 >> 7) * 64 + (n0 & 127) - 64));
        TRJ(I_SQ, INP(I_WOUT), 1024, 1024, WOUT, 1024, (kb < 8 ? INP(I_AON) : (const float*)nullptr), n0);
        TRJ(I_SQ, INP(I_WMQ), 1024, 1024, WMQ, 1024, INP(I_XAN), n0);
        TRJ(I_SQ, INP(I_WMO), 1024, 1024, WMO, 1024, (const float*)nullptr, n0);
        TRJ(I_FFN, INP(I_F2W1), 1024, FF, W13_2, 1024, INP(I_F2N), (n0 >> 7) * 256 + (n0 & 127));
        TRJ(I_FFN, INP(I_F2W3), 1024, FF, W13_2, 1024, INP(I_F2N), (n0 >> 7) * 256 + 128 + (n0 & 127));
        TRJ(I_W2, INP(I_F2W2), FF, 1024, W2_2, FF, (const float*)nullptr, n0);
        { const int bb = r >> 7, rr = r & 127, kb = rr >> 5, n0 = (rr & 31) * 32;
          tr_item(INP(I_CMV) + (size_t)bb * 256 * 1024, 1024, kb * 64, n0, CMVTB + (size_t)bb * 1024 * 256, n0, 256, (const float*)nullptr, scr, lane); }
#undef TRJ
    };
    if (IN(0)) {
        { const int ngw0_ = NGW; const int nfirst = (G == 256) ? NA : NITEMS;
          for (int it = gw; it < nfirst; it += ngw0_) do_item(it); }
        const float* xp_ = INP(I_XP); const float* xs_ = INP(I_XS); const float* mem_ = INP(I_MEM); const float* cmk_ = INP(I_CMK); const float* memn_ = INP(I_MEMN);
        bf16_t* xb_ = XB; bf16_t* memb_ = MEMB; bf16_t* cmkb_ = CMKB; float* ssq0_ = ssq0; const int ngw_ = NGW;
        for (int m = gw; m < MT + 256 + 2048; m += ngw_) {
            const float* src; bf16_t* dst; int kind;
            if (m < TP) { src = xp_ + (size_t)m * DM; dst = xb_ + (size_t)m * DM; kind = 0; }
            else if (m < MT) { src = xs_ + (size_t)(m - TP) * DM; dst = xb_ + (size_t)m * DM; kind = 0; }
            else if (m < MT + 256) { src = mem_ + (size_t)(m - MT) * DM; dst = memb_ + (size_t)(m - MT) * DM; kind = 1; }
            else { src = cmk_ + (size_t)(m - MT - 256) * DM; dst = cmkb_ + (size_t)(m - MT - 256) * DM; kind = 2; }
            f32x4 v[4]; float s = 0.f;
#pragma unroll
            for (int j = 0; j < 4; ++j) { v[j] = *((const f32x4*)src + lane + 64 * j); s += (v[j][0] * v[j][0] + v[j][1] * v[j][1]) + (v[j][2] * v[j][2] + v[j][3] * v[j][3]); }
            if (kind != 2) s = wave_sum(s);
            if (kind == 0 && lane == 0) ssq0_[m] = s;
            if (kind == 1) { const float rs = __builtin_amdgcn_rsqf(s * (1.0f / 1024.0f) + EPS);
#pragma unroll
                for (int j = 0; j < 4; ++j) v[j] = v[j] * rs * *((const f32x4*)memn_ + lane + 64 * j); }
#pragma unroll
            for (int j = 0; j < 4; ++j) *((u32x2*)dst + lane + 64 * j) = (u32x2){pk2(v[j][0], v[j][1]), pk2(v[j][2], v[j][3])};
        }
        { float* z_ = ssq1; u32x4* wz_ = (u32x4*)(WIN + (size_t)672 * 1024); const size_t ngt_ = NGT;
          for (size_t i = gtid; i < (size_t)6 * MT; i += ngt_) z_[i] = 0.f;
          { f32x4* za_ = (f32x4*)ACCB(0); for (size_t i = gtid; i < (size_t)5 * TS * DM / 4; i += ngt_) za_[i] = (f32x4){0.f, 0.f, 0.f, 0.f}; }
          for (size_t i = gtid; i < (size_t)96 * 1024 / 8; i += ngt_) wz_[i] = (u32x4){0, 0, 0, 0}; }
    }
    SEAM(0);

    if (IN(1)) {
        { pg8::Gemm g{XB, W13_1, MT, 2 * FF, 1024, 1024, 1024}; pg8::Order S; S.init(MT, 2 * FF, G, blk, 0); pg8::EpiUp E{HID, ssq0};
          pg8::gemm_phase<pg8::EpiUp, pg8::Order, true, true>(lds, g, S, E); }
        { pg8::Gemm g{MEMB, WMKV, 256, 2048, 1024, 1024, 1024}; pg8::Order S; S.init(256, 2048, G, blk, 144); pg8::EpiMem E{out + O_MKP, out + O_MVP, MKB, MVB};
          pg8::gemm_phase<pg8::EpiMem, pg8::Order, true, true>(lds, g, S, E); }
        if (G == 256 && blk >= 152) { for (int it = NA + (blk - 152) * NWAVE + wave; it < NITEMS; it += (256 - 152) * NWAVE) do_item(it); }
    }
    SEAM(1);
    if (IN(2)) {
        { pg8::Gemm g{HID, W2_1, TP, 1024, FF, FF, FF}; pg8::Order S; S.init(TP, 1024, G, blk, 0);
          pg8::EpiRes E{XB, ssq1, nullptr, 0.f, 0.5f};
          pg8::gemm_phase<pg8::EpiRes, pg8::Order, true, true>(lds, g, S, E); }
        { pg8::Gemm g{HID, W2_1, TS, 1024, 256, FF, FF, 512}; pg8::Order S; S.init(TS, 1024, G, blk, 0, 64, 11);
          pg8::EpiAcc E{ACCB(0), nullptr, 0.f, 0, 0.5f};
          pg8::gemm_phase<pg8::EpiAcc, pg8::Order, true, true>(lds, g, S, E); }
    }
    SEAM(2);
    if (IN(3)) {
        if (blk >= G - 8) sample_finalize_part(blk - (G - 8), INP(I_XS), ACCB(0), XSA, XB + (size_t)TP * DM, ssq1 + TP, FLAGW(0));
        pg8::EpiWin E{ssq1, INP(I_KVN), out, CQ, ssqq, CKVP, CKVS, KPEP, KPES, XBR, GG, (LAS float*)(lds + LDS_EPI)};
        { pg8::Gemm g{XB, WIN, TP, 1792, 1024, 1024, 1024}; pg8::Order S; S.init(TP, 1792, G, blk, 0);
          pg8::gemm_phase<pg8::EpiWin, pg8::Order, true, true>(lds, g, S, E); }
        { pg8::Gemm g{XB, WIN, TS, 1792, 1024, 1024, 1024}; pg8::Order S; S.init(TS, 1792, G, blk, 192, 64); pg8::Unit u_;
          if (S.next(0, u_)) sample_wait(FLAGW(0), 8u);
          pg8::gemm_phase<pg8::EpiWin, pg8::Order, true, true>(lds, g, S, E); }
        if (G != 256 || blk >= 200) {
        { const f32x4* cckv_ = (const f32x4*)INP(I_CCKV); const f32x4* ckpe_ = (const f32x4*)INP(I_CKPE); bf16_t* ckvs_ = CKVS; bf16_t* kpes_ = KPES; bf16_t* mvtb_ = MVTB; const bf16_t* mvb_ = MVB; const bool idl_ = (G == 256); const size_t ngt_ = idl_ ? (size_t)(256 - 200) * NTHR : NGT; const size_t g0_ = idl_ ? (size_t)(blk - 200) * NTHR + tid : gtid;
          for (size_t i = g0_; i < (size_t)NBAT * PAST * 64; i += ngt_) { const size_t rw = i >> 6; const int c4 = (int)(i & 63); const int b = (int)(rw / PAST), t = (int)(rw % PAST);
              const f32x4 v = cckv_[i]; *(u32x2*)(ckvs_ + ((size_t)b * SKV + t) * 256 + c4 * 4) = (u32x2){pk2(v[0], v[1]), pk2(v[2], v[3])}; }
          for (size_t i = g0_; i < (size_t)NBAT * PAST * 8; i += ngt_) { const size_t rw = i >> 3; const int c4 = (int)(i & 7); const int b = (int)(rw / PAST), t = (int)(rw % PAST);
              const f32x4 v = ckpe_[i]; *(u32x2*)(kpes_ + ((size_t)b * SKV + t) * 32 + c4 * 4) = (u32x2){pk2(v[0], v[1]), pk2(v[2], v[3])}; }
          for (size_t i = g0_; i < (size_t)1024 * 256; i += ngt_) { const int d = (int)(i >> 8), k = (int)(i & 255); mvtb_[i] = mvb_[(size_t)k * DM + d]; } }
        }
    }
    SEAM(3);
    if (IN(4)) {
        { pg8::Gemm g{CQ, WUQ, MT, 768, QL, QL, QL}; pg8::Order S; S.init(MT, 768, G, blk, 0); pg8::EpiQ E{Q, ssqq};
          pg8::gemm_phase<pg8::EpiQ, pg8::Order, true, true>(lds, g, S, E); }
        { pg8::Gemm g{CKVP, WK, TP + MT, 512, 256, 256, 256}; pg8::Order S; S.init(TP + MT, 512, G, blk, 192); pg8::EpiStore E{KNP, 512, nullptr, 0.f, 1.f};
          pg8::gemm_phase<pg8::EpiStore, pg8::Order, true, true>(lds, g, S, E); }
        { pg8::Gemm g{WV, CKVP, 512, TP + MT, 256, 256, 256}; pg8::Order S; S.init(512, TP + MT, G, blk, 192); pg8::EpiStore E{VTP, VT_LD, nullptr, 0.f, 1.f};
          pg8::gemm_phase<pg8::EpiStore, pg8::Order, true, true>(lds, g, S, E); }
        const LruArgs LA{XBR, INP(I_CONVW), INP(I_CONVB), INP(I_LWA), INP(I_LBA), INP(I_LWX), INP(I_LBX), INP(I_LAM), INP(I_SCONV), INP(I_SLRU), HLOC, ACUM, ATOT, BTOT, out};
        { const int g_ = G; for (int u = (blk + g_ - (199 % g_)) % g_; u < 256; u += g_) lru_l1_unit(lds, u, LA); }
    }
    SEAM(4);
    if (IN(5)) {
        const int g_ = G; bf16_t* merged_ = MERGED; float* ssqa_ = ssqa; float* out_ = out;
        { const bf16_t* hloc_ = HLOC; const bf16_t* acum_ = ACUM; const bf16_t* gg_ = GG; const float* atot_ = ATOT; const float* btot_ = BTOT; const float* lon_ = INP(I_LON);
          for (int u = blk; u < 256; u += g_) lru_l3_unit(lds, u, hloc_, acum_, gg_, atot_, btot_, lon_, merged_, out_);
          const LruArgs LA{XBR, INP(I_CONVW), INP(I_CONVB), INP(I_LWA), INP(I_LBA), INP(I_LWX), INP(I_LBX), INP(I_LAM), INP(I_SCONV), INP(I_SLRU), HLOC, ACUM, ATOT, BTOT, out};
          for (int u = (blk + g_ - (64 % g_)) % g_; u < 8; u += g_) { lru_l1_unit(lds, 256 + u, LA); asm volatile("s_waitcnt vmcnt(0)" ::: "memory"); __syncthreads();
              lru_l3_unit(lds, 256 + u, hloc_, acum_, gg_, atot_, btot_, lon_, merged_, out_); } }
        { const bf16_t* q_ = Q; const bf16_t* knp_ = KNP; const bf16_t* kpep_ = KPEP; const bf16_t* vtp_ = VTP;
          for (int p = vcu; p < 256; p += g_) {
              const int h = p >> 5, s = p & 31;
              mla_prompt_unit(lds, h, 63 - s, q_, knp_, kpep_, vtp_, merged_, ssqa_);
              mla_prompt_unit(lds, h, s, q_, knp_, kpep_, vtp_, merged_, ssqa_);
          }
          const bf16_t* kns_ = KNS; const bf16_t* kpes_ = KPES; const bf16_t* vts_ = VTS;
          for (int u = blk; u < 64; u += g_) mla_sample_unit(lds, u >> 3, u & 7, q_, kns_, kpes_, vts_, merged_, ssqa_); }
    }
    SEAM(5);
    if (IN(6)) {
        { pg8::Gemm g{MERGED, WOUT, TP, 1024, 1024, 1024, 1024}; pg8::Order S; S.init(TP, 1024, G, blk, 0);
          pg8::EpiResMid E{{XB, ssq2, nullptr, 0.f, 1.f}, ssqa};
          pg8::gemm_phase<pg8::EpiResMid, pg8::Order, true, true>(lds, g, S, E); }
        { pg8::Gemm g{MERGED, WOUT, TS, 1024, 256, 1024, 1024, 512}; pg8::Order Ss; Ss.init(TS, 1024, G, blk, 0, 64, 4);
          pg8::EpiAcc E{ACCB(1), ssqa, 1.0f / 512.0f, 2, 1.f};
          pg8::gemm_phase<pg8::EpiAcc, pg8::Order, true, true>(lds, g, Ss, E); }
    }
    SEAM(6);
    if (IN(7)) {
        if (blk >= G - 8) sample_finalize_part(blk - (G - 8), XSA, ACCB(1), XSB, XB + (size_t)TP * DM, ssq2 + TP, FLAGW(1));
        { pg8::Gemm g{XB, WMQ, TP, 1024, 1024, 1024, 1024}; pg8::Order S; S.init(TP, 1024, G, blk, 0); pg8::EpiStore E{QM, 1024, ssq2, 1.0f / 1024.0f, XSCALE};
          pg8::gemm_phase<pg8::EpiStore, pg8::Order, true, true>(lds, g, S, E);
          asm volatile("s_waitcnt vmcnt(0)" ::: "memory"); __syncthreads();
          bf16_t* qm_ = QM; const bf16_t* mkb_ = MKB; const bf16_t* mvtb_ = MVTB; pg8::Unit u_;
          for (int i = 0; S.next(i, u_); ++i) xattn_unit(lds, u_.pm * 256, false, u_.pn, qm_, mkb_, mvtb_, nullptr, nullptr); }
        { pg8::Gemm g{XB, WMQ, TS, 1024, 256, 1024, 1024, 512}; pg8::Order S; S.init(TS, 1024, G, blk, 0, 64, 4); pg8::Unit u_;
          if (S.next(0, u_)) sample_wait(FLAGW(1), 8u);
          pg8::EpiAcc E{ACCB(2), nullptr, 0.f, 0, 1.f};
          pg8::gemm_phase<pg8::EpiAcc, pg8::Order, true, true>(lds, g, S, E); }
    }
    SEAM(7);
    if (IN(9)) {
        { const int g_ = G; bf16_t* qm_ = QM; const bf16_t* cmkb_ = CMKB; const bf16_t* cmvtb_ = CMVTB; const float* qacc_ = ACCB(2); const float* ssq2_ = ssq2;
          for (int u = g_ - 1 - blk; u < 32; u += g_) { const int b = u >> 2;
              xattn_unit(lds, TP + b * 32, true, u & 3, qm_, cmkb_ + (size_t)b * 256 * DM, cmvtb_ + (size_t)b * 1024 * 256, qacc_, ssq2_);
              asm volatile("s_waitcnt vmcnt(0)" ::: "memory"); __syncthreads();
              if (tid == 0) { __builtin_amdgcn_fence(__ATOMIC_RELEASE, "agent"); asm volatile("s_waitcnt vmcnt(0)" ::: "memory"); __hip_atomic_fetch_add(FLAGW(3), 1u, __ATOMIC_RELAXED, __HIP_MEMORY_SCOPE_AGENT); } } }
        { pg8::Gemm g{QM, WMO, TP, 1024, 1024, 1024, 1024}; pg8::Order S; S.init(TP, 1024, G, blk, 0);
          pg8::EpiRes E{XB, ssq3, nullptr, 0.f, 1.f};
          pg8::gemm_phase<pg8::EpiRes, pg8::Order, true, true>(lds, g, S, E); }
        { pg8::Gemm g{QM, WMO, TS, 1024, 256, 1024, 1024, 512}; pg8::Order S; S.init(TS, 1024, G, blk, 0, 64, 4); pg8::Unit u_;
          if (S.next(0, u_)) sample_wait(FLAGW(3), 32u);
          pg8::EpiAcc E{ACCB(3), nullptr, 0.f, 0, 1.f};
          pg8::gemm_phase<pg8::EpiAcc, pg8::Order, true, true>(lds, g, S, E); }
    }
    SEAM(9);
    if (IN(10)) {
        if (blk >= G - 8) sample_finalize_part(blk - (G - 8), XSB, ACCB(3), XSA, XB + (size_t)TP * DM, ssq3 + TP, FLAGW(2));
        pg8::EpiUp E{HID, ssq3};
        { pg8::Gemm g{XB, W13_2, TP, 2 * FF, 1024, 1024, 1024}; pg8::Order S; S.init(TP, 2 * FF, G, blk, 0);
          pg8::gemm_phase<pg8::EpiUp, pg8::Order, true, true>(lds, g, S, E); }
        { pg8::Gemm g{XB, W13_2, TS, 2 * FF, 1024, 1024, 1024}; pg8::Order S; S.init(TS, 2 * FF, G, blk, 128, 64); pg8::Unit u_;
          if (S.next(0, u_)) sample_wait(FLAGW(2), 8u);
          pg8::gemm_phase<pg8::EpiUp, pg8::Order, true, true>(lds, g, S, E); }
    }
    SEAM(10);
    if (IN(11)) {
        { pg8::Gemm g{HID, W2_2, TP, 1024, FF, FF, FF}; pg8::Order S; S.init(TP, 1024, G, blk, 0);
          pg8::EpiRes E{XB, ssq4, nullptr, 0.f, 0.5f};
          pg8::gemm_phase<pg8::EpiRes, pg8::Order, true, true>(lds, g, S, E); }
        { pg8::Gemm g{HID, W2_2, TS, 1024, 256, FF, FF, 512}; pg8::Order S; S.init(TS, 1024, G, blk, 0, 64, 11);
          pg8::EpiAcc E{ACCB(4), nullptr, 0.f, 0, 0.5f};
          pg8::gemm_phase<pg8::EpiAcc, pg8::Order, true, true>(lds, g, S, E); }
    }
    SEAM(11);
    if (IN(12)) {
        float* x_ = X; const float* s4_ = ssq4; const f32x4* fn_ = (const f32x4*)INP(I_FINN); const int ngw_ = NGW; const float* xs_ = XSA; const float* acc_ = ACCB(4); const bf16_t* xb12_ = XB;
        for (int m = gw; m < MT; m += ngw_) {
            f32x4* xr = (f32x4*)(x_ + (size_t)m * DM);
            if (m < TP) {
                const float rs = __builtin_amdgcn_rsqf(s4_[m] * (1.0f / 1024.0f) + EPS);
                const u32x2* xbr = (const u32x2*)(xb12_ + (size_t)m * DM);
#pragma unroll
                for (int j = 0; j < 4; ++j) { const u32x2 b = xbr[lane + 64 * j]; const f32x4 v = (f32x4){__builtin_bit_cast(float, b[0] << 16), __builtin_bit_cast(float, b[0] & 0xffff0000u), __builtin_bit_cast(float, b[1] << 16), __builtin_bit_cast(float, b[1] & 0xffff0000u)};
                    xr[lane + 64 * j] = v * rs * fn_[lane + 64 * j]; }
            } else {
                const size_t r = (size_t)(m - TP) * DM; f32x4 v[4]; float s = 0.f;
#pragma unroll
                for (int j = 0; j < 4; ++j) { v[j] = *((const f32x4*)(xs_ + r) + lane + 64 * j) + *((const f32x4*)(acc_ + r) + lane + 64 * j);
                    s += (v[j][0] * v[j][0] + v[j][1] * v[j][1]) + (v[j][2] * v[j][2] + v[j][3] * v[j][3]); }
                const float rs = __builtin_amdgcn_rsqf(wave_sum(s) * (1.0f / 1024.0f) + EPS);
#pragma unroll
                for (int j = 0; j < 4; ++j) xr[lane + 64 * j] = v[j] * rs * fn_[lane + 64 * j];
            }
        }
    }
#undef IN
#undef SEAM
}

#undef INP
#undef X
#undef tid
#undef lane
#undef out
#undef ws
#undef lo
#undef hi
#undef G
#undef blk
#undef vcu
#undef gw
#undef NGW
#undef gtid
#undef NGT
#ifndef MK_N_LAUNCHES
#define MK_N_LAUNCHES 1
#endif
extern "C" void kernel_launch(void* const* d_in, const int* in_sizes, int n_in, void* d_out, int out_size, void* d_ws, size_t ws_size, hipStream_t stream) {
    static int grid = 0;
    if (grid == 0) {
        int dev = 0, cus = 0, per_cu = 0;
        hipGetDevice(&dev);
        hipDeviceGetAttribute(&cus, hipDeviceAttributeMultiprocessorCount, dev);
        if (hipFuncSetAttribute((const void*)mk_fwd, hipFuncAttributeMaxDynamicSharedMemorySize, LDS_BYTES) != hipSuccess) fprintf(stderr, "kernel_launch: hipFuncSetAttribute failed\n");
        if (hipOccupancyMaxActiveBlocksPerMultiprocessor(&per_cu, (const void*)mk_fwd, NTHR, LDS_BYTES) != hipSuccess || per_cu < 1) { fprintf(stderr, "kernel_launch: occupancy query gave %d\n", per_cu); per_cu = 1; }
        (void)hipGetLastError();
        grid = cus * per_cu;
        if (n_in != 40 || ws_size < WS_END) { fprintf(stderr, "kernel_launch: unexpected n_in %d / ws %zu\n", n_in, ws_size); }
    }
    (void)hipMemsetAsync((unsigned char*)d_ws + WS_BAR, 0, 16384, stream);
    Args a{};
    for (int i = 0; i < 40; ++i) a.in[i] = (const float*)d_in[i];
    a.out = (float*)d_out; a.ws = (unsigned char*)d_ws;
#if MK_N_LAUNCHES == 1
    a.ph_lo = 0; a.ph_hi = NPHASE;
    void* args[] = {&a};
    hipError_t e = hipLaunchCooperativeKernel((const void*)mk_fwd, dim3(grid), dim3(NTHR), args, LDS_BYTES, stream);
    if (e != hipSuccess) fprintf(stderr, "kernel_launch: cooperative launch failed: %s (grid %d)\n", hipGetErrorString(e), grid);
#else
    for (int p = 0; p < NPHASE; ++p) { a.ph_lo = p; a.ph_hi = p + 1; hipLaunchKernelGGL(mk_fwd, dim3(grid), dim3(NTHR), LDS_BYTES, stream, a); }
#endif
}
```
